# Optimizing an MI355X kernel written in HIP

```python
import jax, jax.numpy as jnp
from jax import lax
import numpy as np

D_MODEL = 2048
BATCH = 2
SEQ = 8192
DEPTH = 4

GRID_W = 64
CTX_LEN = 256
HEAD_DIM = 128
ATTN_SCALE = HEAD_DIM ** -0.5
ROPE_THETA = 10000.0
NEG_INF = -1e30

A_Q_HEADS = 8
A_KV_HEADS = 2
A_GROUP = A_Q_HEADS // A_KV_HEADS
A_WINDOW = 128
A_BLOCK = 128
B_HEADS = 8
B_WIN_ROWS = 8
B_WIN_COLS = 16
B_QCOLS = 16
B_KCOLS = 32
C_Q_HEADS = 16
C_KV_HEADS = 4
C_GROUP = C_Q_HEADS // C_KV_HEADS
C_BLOCK = 128

MIX_WIDTH = (A_Q_HEADS + B_HEADS) * HEAD_DIM
AB_SIZES = (A_Q_HEADS * HEAD_DIM, A_KV_HEADS * HEAD_DIM, A_KV_HEADS * HEAD_DIM,
            B_HEADS * HEAD_DIM, B_HEADS * HEAD_DIM, B_HEADS * HEAD_DIM)
AB_IN = sum(AB_SIZES)
C_SIZES = (C_Q_HEADS * HEAD_DIM, C_KV_HEADS * HEAD_DIM, C_KV_HEADS * HEAD_DIM)
C_IN = sum(C_SIZES)

PEER_HEADS = 8
PEER_N_KEYS = 128
PEER_N_EXPERTS = PEER_N_KEYS ** 2
PEER_KEY_DIM = 128
PEER_TOPK = 16
PEER_CHUNK = 128

N_MOD = 6
DEEPNORM_ALPHA = (2 * DEPTH) ** 0.25
DEEPNORM_BETA = (8 * DEPTH) ** -0.25
N_EVEN = (DEPTH + 1) // 2
N_ODD = DEPTH // 2

kernel_name = 'hybrid_dit_window_natten_qknorm_peer'


def split_points(sizes):
    return [int(s) for s in np.cumsum(sizes)[:-1]]


def heads(t, n):
    return t.reshape(t.shape[:2] + (n, HEAD_DIM))


def layer_norm(x, g, b, eps=1e-5):
    xf = x.astype(jnp.float32)
    mu = jnp.mean(xf, -1, keepdims=True)
    var = jnp.mean(jnp.square(xf - mu), -1, keepdims=True)
    return ((xf - mu) * lax.rsqrt(var + eps)).astype(x.dtype) * g + b


def rms_norm(x, g, eps=1e-6):
    xf = x.astype(jnp.float32)
    return (xf * lax.rsqrt(jnp.mean(jnp.square(xf), -1, keepdims=True) + eps)).astype(x.dtype) * g


def axial_rope(n_tokens):
    t = jnp.arange(n_tokens, dtype=jnp.int32)
    row = (t // GRID_W).astype(jnp.float32)
    col = (t % GRID_W).astype(jnp.float32)
    n_freq = HEAD_DIM // 4
    inv_freq = ROPE_THETA ** (-jnp.arange(n_freq, dtype=jnp.float32) / n_freq)
    ang_r = row[:, None] * inv_freq[None, :]
    ang_c = col[:, None] * inv_freq[None, :]
    ang = jnp.concatenate([ang_r, ang_r, ang_c, ang_c], axis=-1)[:, None, :]
    return jnp.cos(ang), jnp.sin(ang)


def apply_rope(x, cos, sin):
    x1, x2, x3, x4 = jnp.split(x, 4, axis=-1)
    rot = jnp.concatenate([-x2, x1, -x4, x3], axis=-1)
    return (x.astype(jnp.float32) * cos + rot.astype(jnp.float32) * sin).astype(x.dtype)


def context_attention(q, k, v, sink=None):
    B, C, hkv, g = q.shape[:4]
    s = jnp.einsum('bqhgd,bkhd->bhgqk', q, k).astype(jnp.float32) * ATTN_SCALE
    if sink is not None:
        s_sink = jnp.broadcast_to(sink.astype(jnp.float32).reshape(1, hkv, g, 1, 1), s.shape[:-1] + (1,))
        s = jnp.concatenate([s, s_sink], axis=-1)
    p = jax.nn.softmax(s, axis=-1)
    if sink is not None:
        p = p[..., :-1]
    out = jnp.einsum('bhgqk,bkhd->bqhgd', p.astype(v.dtype), v)
    return out.reshape(B, C, hkv * g * HEAD_DIM)


def window_attention(q, k, v, k_ctx, v_ctx, sink):
    B, L = q.shape[:2]
    nb = L // A_BLOCK
    qb = q.reshape(B, nb, A_BLOCK, A_KV_HEADS, A_GROUP, HEAD_DIM)

    def band(t):
        tp = jnp.pad(t, ((0, 0), (A_BLOCK, A_BLOCK), (0, 0), (0, 0)))
        tp = tp.reshape(B, nb + 2, A_BLOCK, A_KV_HEADS, HEAD_DIM)
        return jnp.concatenate([tp[:, :-2], tp[:, 1:-1], tp[:, 2:]], axis=2)

    kb, vb = band(k), band(v)
    s_loc = jnp.einsum('bnqhgd,bnkhd->bnhgqk', qb, kb).astype(jnp.float32) * ATTN_SCALE
    s_ctx = jnp.einsum('bnqhgd,bchd->bnhgqc', qb, k_ctx).astype(jnp.float32) * ATTN_SCALE
    qi = np.arange(A_BLOCK)[:, None]
    kk = np.arange(3 * A_BLOCK)[None, :]
    in_window = np.abs(kk - A_BLOCK - qi) <= A_WINDOW
    kpos = (np.arange(nb)[:, None] - 1) * A_BLOCK + np.arange(3 * A_BLOCK)[None, :]
    in_range = (kpos >= 0) & (kpos < L)
    mask = in_window[None] & in_range[:, None, :]
    s_loc = jnp.where(mask[None, :, None, None], s_loc, NEG_INF)
    s_sink = jnp.broadcast_to(sink.astype(jnp.float32).reshape(1, 1, A_KV_HEADS, A_GROUP, 1, 1),
                              s_loc.shape[:-1] + (1,))
    p = jax.nn.softmax(jnp.concatenate([s_loc, s_ctx, s_sink], axis=-1), axis=-1).astype(v.dtype)
    n_loc = 3 * A_BLOCK
    n_ctx = k_ctx.shape[1]
    out = (jnp.einsum('bnhgqk,bnkhd->bnqhgd', p[..., :n_loc], vb)
           + jnp.einsum('bnhgqc,bchd->bnqhgd', p[..., n_loc:n_loc + n_ctx], v_ctx))
    return out.reshape(B, L, A_Q_HEADS * HEAD_DIM)


def neighborhood_attention(q, k, v, k_ctx, v_ctx, rpb):
    B, L = q.shape[:2]
    rows = L // GRID_W
    kr = min(B_WIN_ROWS, rows)
    n_cb = GRID_W // B_QCOLS
    qcol = np.arange(GRID_W).reshape(n_cb, B_QCOLS)
    kstart = np.clip(np.arange(n_cb) * B_QCOLS - B_WIN_COLS // 2, 0, GRID_W - B_KCOLS)
    kcol = kstart[:, None] + np.arange(B_KCOLS)[None, :]
    wstart = np.clip(qcol - B_WIN_COLS // 2, 0, GRID_W - B_WIN_COLS)
    col_ok = (kcol[:, None, :] >= wstart[:, :, None]) & (kcol[:, None, :] < wstart[:, :, None] + B_WIN_COLS)
    dcol = np.clip(kcol[:, None, :] - qcol[:, :, None] + B_WIN_COLS - 1, 0, 2 * B_WIN_COLS - 2)
    bias_c = jnp.transpose(rpb[:, :, dcol], (0, 2, 3, 1, 4)).astype(jnp.float32)
    bias_c = jnp.where(col_ok[None, :, :, None, :], bias_c, NEG_INF)
    rstart = np.clip(np.arange(rows) - kr // 2, 0, rows - kr)
    drow = rstart[:, None] + np.arange(kr)[None, :] - np.arange(rows)[:, None] + B_WIN_ROWS - 1
    k_g = k.reshape(B, rows, GRID_W, B_HEADS, HEAD_DIM)
    v_g = v.reshape(B, rows, GRID_W, B_HEADS, HEAD_DIM)
    q_rows = jnp.moveaxis(q.reshape(B, rows, n_cb, B_QCOLS, B_HEADS, HEAD_DIM), 1, 0)
    n_loc = kr * B_KCOLS

    def row_block(args):
        q_r, r0, dr = args
        k_r = lax.dynamic_slice_in_dim(k_g, r0, kr, axis=1)[:, :, kcol]
        v_r = lax.dynamic_slice_in_dim(v_g, r0, kr, axis=1)[:, :, kcol]
        s_loc = jnp.einsum('bnqhd,brnkhd->bhnqrk', q_r, k_r).astype(jnp.float32) * ATTN_SCALE
        s_loc = s_loc + bias_c[:, :, :, dr][None]
        s_loc = s_loc.reshape(B, B_HEADS, n_cb, B_QCOLS, n_loc)
        s_ctx = jnp.einsum('bnqhd,bchd->bhnqc', q_r, k_ctx).astype(jnp.float32) * ATTN_SCALE
        p = jax.nn.softmax(jnp.concatenate([s_loc, s_ctx], axis=-1), axis=-1).astype(v.dtype)
        p_loc = p[..., :n_loc].reshape(B, B_HEADS, n_cb, B_QCOLS, kr, B_KCOLS)
        return (jnp.einsum('bhnqrk,brnkhd->bnqhd', p_loc, v_r)
                + jnp.einsum('bhnqc,bchd->bnqhd', p[..., n_loc:], v_ctx))

    out = lax.map(row_block, (q_rows, jnp.asarray(rstart, jnp.int32), jnp.asarray(drow, jnp.int32)))
    return jnp.moveaxis(out, 0, 1).reshape(B, L, B_HEADS * HEAD_DIM)


def block_dense_attention(q, k, v):
    B, L = q.shape[:2]
    nb = L // C_BLOCK
    qb = jnp.moveaxis(q.reshape(B, nb, C_BLOCK, C_KV_HEADS, C_GROUP, HEAD_DIM), 1, 0)

    def one_block(q_i):
        s = jnp.einsum('bqhgd,bshd->bhgqs', q_i, k).astype(jnp.float32) * ATTN_SCALE
        p = jax.nn.softmax(s, axis=-1).astype(v.dtype)
        return jnp.einsum('bhgqs,bshd->bqhgd', p, v)

    out = lax.map(one_block, qb)
    return jnp.moveaxis(out, 0, 1).reshape(B, L, C_Q_HEADS * HEAD_DIM)


def mixer_ab(h_lat, h_ctx, w_in, w_out, sink, rpb, cos, sin, ctx_out):
    B, L = h_lat.shape[:2]
    C = h_ctx.shape[1]
    pts = split_points(AB_SIZES)
    qa, ka, va, qb, kb, vb = jnp.split(h_lat @ w_in, pts, axis=-1)
    qa_c, ka_c, va_c, qb_c, kb_c, vb_c = jnp.split(h_ctx @ w_in, pts, axis=-1)
    ka_c, va_c = heads(ka_c, A_KV_HEADS), heads(va_c, A_KV_HEADS)
    kb_c, vb_c = heads(kb_c, B_HEADS), heads(vb_c, B_HEADS)
    qa = apply_rope(heads(qa, A_Q_HEADS), cos, sin).reshape(B, L, A_KV_HEADS, A_GROUP, HEAD_DIM)
    ka = apply_rope(heads(ka, A_KV_HEADS), cos, sin)
    out_a = window_attention(qa, ka, heads(va, A_KV_HEADS), ka_c, va_c, sink)
    out_b = neighborhood_attention(heads(qb, B_HEADS), heads(kb, B_HEADS), heads(vb, B_HEADS), kb_c, vb_c, rpb)
    y_lat = jnp.concatenate([out_a, out_b], axis=-1) @ w_out
    y_ctx = None
    if ctx_out:
        oa_c = context_attention(heads(qa_c, A_Q_HEADS).reshape(B, C, A_KV_HEADS, A_GROUP, HEAD_DIM), ka_c, va_c, sink)
        ob_c = context_attention(heads(qb_c, B_HEADS)[:, :, :, None, :], kb_c, vb_c)
        y_ctx = jnp.concatenate([oa_c, ob_c], axis=-1) @ w_out
    return y_lat, y_ctx


def mixer_c(h_lat, h_ctx, w_in, w_out, q_gain, k_gain, cos, sin, ctx_out):
    B, L = h_lat.shape[:2]
    C = h_ctx.shape[1]
    pts = split_points(C_SIZES)

    def qkv(h):
        q, k, v = jnp.split(h @ w_in, pts, axis=-1)
        return (rms_norm(heads(q, C_Q_HEADS), q_gain), rms_norm(heads(k, C_KV_HEADS), k_gain), heads(v, C_KV_HEADS))

    q, k, v = qkv(h_lat)
    q_c, k_c, v_c = qkv(h_ctx)
    q = apply_rope(q, cos, sin).reshape(B, L, C_KV_HEADS, C_GROUP, HEAD_DIM)
    k = apply_rope(k, cos, sin)
    k_all = jnp.concatenate([k_c, k], axis=1)
    v_all = jnp.concatenate([v_c, v], axis=1)
    y_lat = block_dense_attention(q, k_all, v_all) @ w_out
    y_ctx = None
    if ctx_out:
        y_ctx = context_attention(q_c.reshape(B, C, C_KV_HEADS, C_GROUP, HEAD_DIM), k_c, v_c) @ w_out
    return y_lat, y_ctx


def peer(h, wq, subkeys, u, v):
    T, D = h.shape
    hc = h.reshape(T // PEER_CHUNK, PEER_CHUNK, D)

    def chunk(xi):
        q = (xi @ wq).reshape(PEER_CHUNK, PEER_HEADS, 2, PEER_KEY_DIM)
        s = jnp.einsum('thpk,hpnk->thpn', q, subkeys).astype(jnp.float32)
        s_top, i_top = lax.top_k(s, PEER_TOPK)
        cand = s_top[:, :, 0, :, None] + s_top[:, :, 1, None, :]
        cand_idx = i_top[:, :, 0, :, None] * PEER_N_KEYS + i_top[:, :, 1, None, :]
        best, pos = lax.top_k(cand.reshape(PEER_CHUNK, PEER_HEADS, PEER_TOPK * PEER_TOPK), PEER_TOPK)
        idx = jnp.take_along_axis(cand_idx.reshape(PEER_CHUNK, PEER_HEADS, PEER_TOPK * PEER_TOPK), pos, axis=-1)
        g = jax.nn.softmax(best, axis=-1)
        act = jax.nn.gelu(jnp.einsum('thkd,td->thk', u[idx], xi).astype(jnp.float32), approximate=False)
        return jnp.einsum('thk,thkd->td', (g * act).astype(v.dtype), v[idx])

    return lax.map(chunk, hc).reshape(T, D)


def setup_inputs(seed: int = 0) -> dict:
    key = jax.random.key(seed)
    ks = jax.random.split(key, 20)
    D = D_MODEL

    def nrm(k, shape, s):
        return jax.random.normal(k, shape, jnp.float32) * s

    return {
        'x': nrm(ks[0], (BATCH, SEQ, D), 1.0),
        'c': nrm(ks[1], (BATCH, D), 1.0),
        'ctx': nrm(ks[2], (BATCH, CTX_LEN, D), 1.0),
        'c_ctx': nrm(ks[3], (D,), 1.0),
        'mod_w': nrm(ks[4], (DEPTH, D, N_MOD * D), 0.5 * D ** -0.5),
        'mod_b': nrm(ks[5], (DEPTH, N_MOD * D), 0.02),
        'ln_g': 1.0 + nrm(ks[6], (DEPTH, 2, D), 0.05),
        'ln_b': nrm(ks[7], (DEPTH, 2, D), 0.02),
        'ab_w_in': nrm(ks[8], (N_EVEN, D, AB_IN), D ** -0.5),
        'ab_w_out': nrm(ks[9], (N_EVEN, MIX_WIDTH, D), DEEPNORM_BETA * MIX_WIDTH ** -0.5),
        'a_sink': nrm(ks[10], (N_EVEN, A_Q_HEADS), 0.5),
        'b_rpb': nrm(ks[11], (N_EVEN, B_HEADS, 2 * B_WIN_ROWS - 1, 2 * B_WIN_COLS - 1), 0.1),
        'c_w_in': nrm(ks[12], (N_ODD, D, C_IN), D ** -0.5),
        'c_w_out': nrm(ks[13], (N_ODD, MIX_WIDTH, D), DEEPNORM_BETA * MIX_WIDTH ** -0.5),
        'c_q_gain': 1.0 + nrm(ks[14], (N_ODD, HEAD_DIM), 0.05),
        'c_k_gain': 1.0 + nrm(ks[15], (N_ODD, HEAD_DIM), 0.05),
        'peer_wq': nrm(ks[16], (DEPTH, D, PEER_HEADS * 2 * PEER_KEY_DIM), D ** -0.5),
        'peer_subkeys': nrm(ks[17], (DEPTH, PEER_HEADS, 2, PEER_N_KEYS, PEER_KEY_DIM), PEER_KEY_DIM ** -0.5),
        'peer_u': nrm(ks[18], (DEPTH, PEER_N_EXPERTS, D), D ** -0.5),
        'peer_v': nrm(ks[19], (DEPTH, PEER_N_EXPERTS, D), DEEPNORM_BETA),
    }


def reference(x, c, ctx, c_ctx, mod_w, mod_b, ln_g, ln_b, ab_w_in, ab_w_out, a_sink, b_rpb,
              c_w_in, c_w_out, c_q_gain, c_k_gain, peer_wq, peer_subkeys, peer_u, peer_v):
    B, L, D = x.shape
    C = ctx.shape[1]
    cos, sin = axial_rope(L)
    xc = ctx
    for layer in range(DEPTH):
        last = layer == DEPTH - 1
        i = layer // 2
        mod_lat = (jax.nn.silu(c) @ mod_w[layer] + mod_b[layer])[:, None, :]
        mod_ctx = jax.nn.silu(c_ctx) @ mod_w[layer] + mod_b[layer]
        sh1, sc1, g1, sh2, sc2, g2 = jnp.split(mod_lat, N_MOD, axis=-1)
        csh1, csc1, cg1, csh2, csc2, cg2 = jnp.split(mod_ctx, N_MOD, axis=-1)
        h_lat = x * (1 + sc1) + sh1
        h_ctx = xc * (1 + csc1) + csh1
        if layer % 2 == 0:
            y_lat, y_ctx = mixer_ab(h_lat, h_ctx, ab_w_in[i], ab_w_out[i], a_sink[i], b_rpb[i], cos, sin, not last)
        else:
            y_lat, y_ctx = mixer_c(h_lat, h_ctx, c_w_in[i], c_w_out[i], c_q_gain[i], c_k_gain[i], cos, sin, not last)
        x = layer_norm(DEEPNORM_ALPHA * x + g1 * y_lat, ln_g[layer, 0], ln_b[layer, 0])
        h_lat = x * (1 + sc2) + sh2
        if last:
            y = peer(h_lat.reshape(B * L, D), peer_wq[layer], peer_subkeys[layer], peer_u[layer], peer_v[layer])
            x = layer_norm(DEEPNORM_ALPHA * x + g2 * y.reshape(B, L, D), ln_g[layer, 1], ln_b[layer, 1])
        else:
            xc = layer_norm(DEEPNORM_ALPHA * xc + cg1 * y_ctx, ln_g[layer, 0], ln_b[layer, 0])
            h_ctx = xc * (1 + csc2) + csh2
            tokens = jnp.concatenate([h_lat.reshape(B * L, D), h_ctx.reshape(B * C, D)], axis=0)
            y = peer(tokens, peer_wq[layer], peer_subkeys[layer], peer_u[layer], peer_v[layer])
            x = layer_norm(DEEPNORM_ALPHA * x + g2 * y[:B * L].reshape(B, L, D), ln_g[layer, 1], ln_b[layer, 1])
            xc = layer_norm(DEEPNORM_ALPHA * xc + cg2 * y[B * L:].reshape(B, C, D), ln_g[layer, 1], ln_b[layer, 1])
    return x
```

```cpp
#include <hip/hip_runtime.h>
#include <cstdio>
#include <cstdint>

#ifndef MK_ONE_LAUNCH
#define MK_ONE_LAUNCH 0
#endif

#define XB_TMO      128
#define XB_XCNT(j)  (256  + 64 * (j))
#define XB_XSUB(j)  (1280 + 64 * (j))
#define XB_XGEN(j)  (2304 + 64 * (j))
#define XB_TOP      3328
#define XB_TOPGEN   3392
#define XCD_BAR_WORDS 3456
#define XB_SPIN_CAP (1u << 22)
#define LAS __attribute__((address_space(3)))

__device__ __forceinline__ unsigned xb_ld(unsigned* p)              { return __hip_atomic_load(p, __ATOMIC_RELAXED, __HIP_MEMORY_SCOPE_AGENT); }
__device__ __forceinline__ unsigned xb_add(unsigned* p, unsigned v) { return __hip_atomic_fetch_add(p, v, __ATOMIC_RELAXED, __HIP_MEMORY_SCOPE_AGENT); }
__device__ __forceinline__ unsigned xb_xcc_id() { return (unsigned)__builtin_amdgcn_s_getreg((3 << 11) | 20) & 0xFu; }
#define XB_SPIN(cond, bar) do { unsigned _sp = 0; while (cond) { __builtin_amdgcn_s_sleep(1); \
    if ((++_sp & 255u) == 0u) { if (xb_ld(&(bar)[XB_TMO])) break; if (_sp > XB_SPIN_CAP) { atomicAdd(&(bar)[XB_TMO], 1u); break; } } } } while (0)

struct XcdBarrier {
    unsigned* bar; unsigned x;
    volatile LAS unsigned* st;
};

__device__ __forceinline__ XcdBarrier xcd_barrier_post(unsigned* bar, volatile LAS unsigned* st) {
    XcdBarrier b; b.bar = bar; b.x = xb_xcc_id(); b.st = st;
    if (threadIdx.x == 0) (void)xb_add(&bar[XB_XCNT(b.x)], 1u);
    return b;
}
__device__ __forceinline__ void xcd_barrier_complete(unsigned* bar, unsigned x, unsigned& nloc, unsigned& nx) {
    const unsigned G = gridDim.x * gridDim.y * gridDim.z;
    unsigned sum, cnt, mine, sp = 0u;
    for (;;) {
        sum = 0u; cnt = 0u; mine = 0u;
#pragma unroll
        for (unsigned j = 0; j < 16; ++j) { const unsigned c = xb_ld(&bar[XB_XCNT(j)]); sum += c; cnt += (c > 0u) ? 1u : 0u; mine = (j == x) ? c : mine; }
        if (sum == G) break;
        __builtin_amdgcn_s_sleep(1);
        if ((++sp & 255u) == 0u) { if (xb_ld(&bar[XB_TMO])) break; if (sp > XB_SPIN_CAP) { atomicAdd(&bar[XB_TMO], 1u); break; } }
    }
    nloc = mine > 0u ? mine : 1u; nx = cnt > 0u ? cnt : 1u;
}

__device__ __forceinline__ void xcd_barrier(const XcdBarrier& b) {
    asm volatile("s_waitcnt vmcnt(0)" ::: "memory");
    __syncthreads();
    if (threadIdx.x == 0) {
        unsigned* bar = b.bar;
        __builtin_amdgcn_s_waitcnt(0);
        unsigned nloc = b.st[0], nx = b.st[1];
        if (nloc == 0u) { xcd_barrier_complete(bar, b.x, nloc, nx); b.st[0] = nloc; b.st[1] = nx; }
        const unsigned old = xb_add(&bar[XB_XSUB(b.x)], 1u);
        const unsigned gen = old / nloc;
        if (old + 1u == (gen + 1u) * nloc) {
            __builtin_amdgcn_fence(__ATOMIC_RELEASE, "agent");
            asm volatile("s_waitcnt vmcnt(0)" ::: "memory");
            const unsigned og = xb_add(&bar[XB_TOP], 1u);
            const unsigned tg = og / nx;
            if (og + 1u == (tg + 1u) * nx) xb_add(&bar[XB_TOPGEN], 1u);
            else XB_SPIN(xb_ld(&bar[XB_TOPGEN]) == tg, bar);
            __builtin_amdgcn_fence(__ATOMIC_ACQUIRE, "agent");
            xb_add(&bar[XB_XGEN(b.x)], 1u);
            asm volatile("s_waitcnt vmcnt(0)" ::: "memory");
        } else {
            XB_SPIN(xb_ld(&bar[XB_XGEN(b.x)]) == gen, bar);
            __builtin_amdgcn_fence(__ATOMIC_ACQUIRE, "agent");
            asm volatile("s_waitcnt vmcnt(0)" ::: "memory");
        }
    }
    __syncthreads();
}


namespace pg8 {
#define PG8_LAS __attribute__((address_space(3)))
typedef unsigned short bf16_t;
typedef short bf16x8 __attribute__((ext_vector_type(8)));
typedef float f32x4 __attribute__((ext_vector_type(4)));
typedef unsigned u32x4 __attribute__((ext_vector_type(4)));
constexpr int BM = 256, BK = 64, HALF = 128, HTB = HALF * BK * 2  , STAGE_BYTES = 8 * HTB, NXCD = 8, WGM = 8;

__host__ __device__ __forceinline__ int lds_byte(int r, int c) { const int st = (r >> 4) * 2 + (c >> 5), rr = r & 15, cc = c & 31, ob = rr * 64 + cc * 2; return st * 1024 + (ob ^ (((ob >> 9) & 1) << 5)); }
__host__ __device__ __forceinline__ void stage_rc(int b, int& R, int& C) { const int st = b / 1024, sb = b % 1024, swz = sb ^ (((sb >> 9) & 1) << 5); R = (st >> 1) * 16 + swz / 64; C = (st & 1) * 32 + (swz % 64) / 2; }
__host__ __device__ __forceinline__ int perm32(int rho) { const int n = rho >> 4, i = rho & 15; return 8 * (i >> 2) + 4 * n + (i & 3); }

struct Unit { int pm, pn; };
struct Gemm { const bf16_t* A; const bf16_t* Bt; int M, N, K; };

struct StaticOrder {
    int nM, nN, nwg, G, c;
    __host__ __device__ void init(int M, int N, int G_, int c_) { nM = M / BM; nN = N / BM; nwg = nM * nN; G = G_; c = c_; }
    __host__ __device__ bool next(int i, Unit& u) const {
        const long L = (long)i * G + c; if (L >= nwg) return false;
        int wgid = (int)L; { const int q = nwg / NXCD, r = nwg % NXCD, xcd = wgid % NXCD, off = wgid / NXCD; wgid = (xcd < r ? xcd * (q + 1) : r * (q + 1) + (xcd - r) * q) + off; }
        const int nig = WGM * nN, gid = wgid / nig, fm = gid * WGM, gsz = (nM - fm) < WGM ? (nM - fm) : WGM;
        u.pm = fm + ((wgid % nig) % gsz); u.pn = (wgid % nig) / gsz; return true;
    }
    __device__ __forceinline__ void a_ready(const Unit&) const {}
    __device__ __forceinline__ void done(const Unit&) const {}
};
__device__ __forceinline__ unsigned cvt_pk_bf16(float lo, float hi) { unsigned r; asm volatile("v_cvt_pk_bf16_f32 %0, %1, %2" : "=v"(r) : "v"(lo), "v"(hi)); return r; }
typedef float f32x2 __attribute__((ext_vector_type(2)));
__device__ __forceinline__ f32x2 gelu_pk(f32x2 v) {
    const f32x2 av = __builtin_elementwise_abs(v), d = av * 0.2316418882f + 1.0f;
    f32x2 t; t.x = __builtin_amdgcn_rcpf(d.x); t.y = __builtin_amdgcn_rcpf(d.y);
    f32x2 q = t * 0.5307027145f + (-0.7265760135f); q = q * t + 0.7107068705f; q = q * t + (-0.142248368f); q = q * t + 0.127414796f; q = q * t;
    const f32x2 s = (v * v) * (-0.72134752044f);
    f32x2 e; e.x = __builtin_amdgcn_exp2f(s.x); e.y = __builtin_amdgcn_exp2f(s.y);
    const f32x2 m = v * (q * e), r = v - m;
    f32x2 o; o.x = v.x < 0.f ? m.x : r.x; o.y = v.y < 0.f ? m.y : r.y; return o;
}

struct EpiF32 {
    static constexpr bool PERM = false, AFTER_DRAIN = false;
    float* C; int ldc; const float* bias;
    __device__ __forceinline__ void operator()(const f32x4 (&acc)[2][2][4][2], const Unit& u, int wr, int wc, int fr, int fq) const {
        const int row0 = u.pm * BM + wr * 64 + fr, col0 = u.pn * BM + wc * 32 + 4 * fq;
        f32x4 bv[2][2];
#pragma unroll
        for (int bj = 0; bj < 2; ++bj)
#pragma unroll
            for (int n = 0; n < 2; ++n) bv[bj][n] = bias ? *(const f32x4*)(bias + col0 + bj * HALF + n * 16) : (f32x4){0.f, 0.f, 0.f, 0.f};
#pragma unroll
        for (int ai = 0; ai < 2; ++ai)
#pragma unroll
            for (int m = 0; m < 4; ++m) { float* rowp = C + (size_t)(row0 + ai * HALF + m * 16) * ldc + col0;
#pragma unroll
                for (int bj = 0; bj < 2; ++bj)
#pragma unroll
                    for (int n = 0; n < 2; ++n) *(f32x4*)(rowp + bj * HALF + n * 16) = acc[ai][bj][m][n] + bv[bj][n]; }
    }
};
template <int ACT  > struct EpiBf16 {
    static constexpr bool PERM = true, AFTER_DRAIN = false;
    bf16_t* O; int ldc; const float* bias; int split_cols; size_t split_stride;
    __device__ __forceinline__ void operator()(const f32x4 (&acc)[2][2][4][2], const Unit& u, int wr, int wc, int fr, int fq) const {
        const int row0 = u.pm * BM + wr * 64 + fr; int colt = u.pn * BM; bf16_t* base = O;
        if (split_cols) { const int t = colt / split_cols; base += (size_t)t * split_stride; colt -= t * split_cols; }
        const int col0 = colt + wc * 32 + 8 * fq, bcol0 = u.pn * BM + wc * 32 + 8 * fq;
        f32x4 bv[2][2];
#pragma unroll
        for (int bj = 0; bj < 2; ++bj)
#pragma unroll
            for (int n = 0; n < 2; ++n) bv[bj][n] = bias ? *(const f32x4*)(bias + bcol0 + bj * HALF + 4 * n) : (f32x4){0.f, 0.f, 0.f, 0.f};
#pragma unroll
        for (int ai = 0; ai < 2; ++ai)
#pragma unroll
            for (int m = 0; m < 4; ++m) { bf16_t* rowp = base + (size_t)(row0 + ai * HALF + m * 16) * ldc + col0;
#pragma unroll
                for (int bj = 0; bj < 2; ++bj) { f32x4 v0 = acc[ai][bj][m][0] + bv[bj][0], v1 = acc[ai][bj][m][1] + bv[bj][1];
                    if (ACT == 1) { f32x2 a = gelu_pk((f32x2){v0[0], v0[1]}), b = gelu_pk((f32x2){v0[2], v0[3]}), c = gelu_pk((f32x2){v1[0], v1[1]}), d = gelu_pk((f32x2){v1[2], v1[3]});
                        v0 = (f32x4){a.x, a.y, b.x, b.y}; v1 = (f32x4){c.x, c.y, d.x, d.y}; }
                    if (ACT == 2) {
#pragma unroll
                        for (int j = 0; j < 4; ++j) { v0[j] = 0.5f * v0[j] * (1.0f + erff(v0[j] * 0.70710678f)); v1[j] = 0.5f * v1[j] * (1.0f + erff(v1[j] * 0.70710678f)); } }
                    u32x4 w; w.x = cvt_pk_bf16(v0[0], v0[1]); w.y = cvt_pk_bf16(v0[2], v0[3]); w.z = cvt_pk_bf16(v1[0], v1[1]); w.w = cvt_pk_bf16(v1[2], v1[3]);
                    *(u32x4*)(rowp + bj * HALF) = w; } }
    }
};

template <class Epi, class Sched, bool STAMP = false>
__device__ __forceinline__ void gemm_phase(PG8_LAS unsigned char* lds, const Gemm g, const Sched& S, const Epi& E, unsigned long long* stamps) {
    const int tid = threadIdx.x, wid = __builtin_amdgcn_readfirstlane(tid >> 6), lane = tid & 63, wr = wid >> 2, wc = wid & 3, fr = lane & 15, fq = lane >> 4;
    const int K = g.K, nt = K / BK;
    int ts_lo = 0, ts_hi = 0, nts = 0; const unsigned long long rt_entry = STAMP ? (unsigned long long)wall_clock64() : 0ull;
#define PG8_STAMP() do { if (STAMP && wid == 0 && nts < 64) { const unsigned long long _c = (unsigned long long)clock64(); \
        ts_lo = (lane == nts) ? (int)(unsigned)_c : ts_lo; ts_hi = (lane == nts) ? (int)(unsigned)(_c >> 32) : ts_hi; ++nts; } } while (0)
    PG8_STAMP();
    unsigned voffA[2], voffB[2];
#pragma unroll
    for (int i = 0; i < 2; ++i) { int R, C; stage_rc(tid * 16 + i * 8192, R, C); const int Rb = Epi::PERM ? ((R & ~31) + perm32(R & 31)) : R;
        voffA[i] = (unsigned)(R * K + C) * 2u; voffB[i] = (unsigned)(Rb * K + C) * 2u; }
    const size_t kstep = (size_t)(BK * 2);
    const size_t hstep = (size_t)HALF * K * 2;
    const size_t tstep = 2 * hstep;
    const unsigned ldsw = (unsigned)wid * 1024u;
    const int aoff = lds_byte(wr * 64 + fr, fq * 8), boff = lds_byte(wc * 32 + fr, fq * 8);
#define PG8_SA(b, h) (((b) * 2 + (h)) * HTB)
#define PG8_SB(b, h) ((4 + (b) * 2 + (h)) * HTB)
#define PG8_STAGE(bufoff, gbase, voff) do { _Pragma("unroll") for (int _i = 0; _i < 2; ++_i) \
        __builtin_amdgcn_global_load_lds((const unsigned*)((const char*)(gbase) + (voff)[_i]), (PG8_LAS unsigned*)(lds + (bufoff) + ldsw + _i * 8192), 16, 0, 0); } while (0)
#define PG8_LDA(dst, b, h) do { _Pragma("unroll") for (int m = 0; m < 4; ++m) _Pragma("unroll") for (int k = 0; k < 2; ++k) dst[m][k] = *(const PG8_LAS bf16x8*)(lds + PG8_SA(b, h) + aoff + m * 2048 + k * 1024); } while (0)
#define PG8_LDB(dst, b, h) do { _Pragma("unroll") for (int n = 0; n < 2; ++n) _Pragma("unroll") for (int k = 0; k < 2; ++k) dst[n][k] = *(const PG8_LAS bf16x8*)(lds + PG8_SB(b, h) + boff + n * 2048 + k * 1024); } while (0)
#define PG8_MMA(ai, bj, At, Bt) do { __builtin_amdgcn_s_setprio(1); _Pragma("unroll") for (int m = 0; m < 4; ++m) _Pragma("unroll") for (int n = 0; n < 2; ++n) _Pragma("unroll") for (int k = 0; k < 2; ++k) \
        acc[ai][bj][m][n] = __builtin_amdgcn_mfma_f32_16x16x32_bf16(Bt[n][k], At[m][k], acc[ai][bj][m][n], 0, 0, 0); __builtin_amdgcn_s_setprio(0); } while (0)
#define PG8_WAIT_V(n) asm volatile("s_waitcnt vmcnt(" #n ")" ::: "memory")
#define PG8_WAIT_L(n) asm volatile("s_waitcnt lgkmcnt(" #n ")" ::: "memory")
#define PG8_BAR __builtin_amdgcn_s_barrier()
#define PG8_SCHED __builtin_amdgcn_sched_barrier(0)
    Unit cur, nxt; int ui = 0;
    if (!S.next(0, cur)) return;
    f32x4 acc[2][2][4][2];
#pragma unroll
    for (int a = 0; a < 2; ++a)
#pragma unroll
        for (int b = 0; b < 2; ++b)
#pragma unroll
            for (int m = 0; m < 4; ++m)
#pragma unroll
                for (int n = 0; n < 2; ++n) acc[a][b][m][n] = (f32x4){0.f, 0.f, 0.f, 0.f};
    bf16x8 At[4][2], B0[2][2], B1[2][2];
    const char* cA = (const char*)g.A + (size_t)cur.pm * tstep; const char* cB = (const char*)g.Bt + (size_t)cur.pn * tstep;
    S.a_ready(cur);
    PG8_STAGE(PG8_SB(0, 0), cB, voffB); PG8_STAGE(PG8_SA(0, 0), cA, voffA); PG8_STAGE(PG8_SB(0, 1), cB + hstep, voffB); PG8_STAGE(PG8_SA(0, 1), cA + hstep, voffA);
    if (wr == 1) PG8_BAR;
    PG8_WAIT_V(4); PG8_BAR;
    PG8_STAGE(PG8_SB(1, 0), cB + kstep, voffB); PG8_STAGE(PG8_SA(1, 0), cA + kstep, voffA); PG8_STAGE(PG8_SB(1, 1), cB + hstep + kstep, voffB);
    PG8_WAIT_V(6); PG8_BAR;
    PG8_STAMP();
    for (;;) {
        const bool has_next = S.next(ui + 1, nxt);
        const char* nA = has_next ? (const char*)g.A + (size_t)nxt.pm * tstep : cA; const char* nB = has_next ? (const char*)g.Bt + (size_t)nxt.pn * tstep : cB;
        for (int t = 0; t < nt; t += 2) {
            const bool last = (t == nt - 2);
            const char* a1 = cA + (size_t)(t + 1) * kstep;
            const char* a2 = last ? nA : cA + (size_t)(t + 2) * kstep; const char* b2 = last ? nB : cB + (size_t)(t + 2) * kstep;
            const char* a3 = a2 + kstep; const char* b3 = b2 + kstep;
            if (last && has_next) S.a_ready(nxt);
            PG8_LDB(B0, 0, 0); PG8_SCHED; PG8_LDA(At, 0, 0); PG8_STAGE(PG8_SA(1, 1), a1 + hstep, voffA);
            PG8_WAIT_L(8); PG8_BAR; PG8_WAIT_L(0); PG8_MMA(0, 0, At, B0); PG8_BAR; PG8_SCHED;
            PG8_LDB(B1, 0, 1); PG8_STAGE(PG8_SB(0, 0), b2, voffB);
            PG8_BAR; PG8_WAIT_L(0); PG8_MMA(0, 1, At, B1); PG8_BAR;
            PG8_LDA(At, 0, 1); PG8_STAGE(PG8_SA(0, 0), a2, voffA);
            PG8_BAR; PG8_WAIT_L(0); PG8_MMA(1, 0, At, B0); PG8_BAR; PG8_SCHED;
            PG8_STAGE(PG8_SB(0, 1), b2 + hstep, voffB);
            PG8_WAIT_V(6); PG8_BAR; PG8_MMA(1, 1, At, B1); PG8_BAR;
            PG8_LDB(B0, 1, 0); PG8_SCHED; PG8_LDA(At, 1, 0); PG8_STAGE(PG8_SA(0, 1), a2 + hstep, voffA);
            PG8_WAIT_L(8); PG8_BAR; PG8_WAIT_L(0); PG8_MMA(0, 0, At, B0); PG8_BAR; PG8_SCHED;
            PG8_LDB(B1, 1, 1); PG8_STAGE(PG8_SB(1, 0), b3, voffB);
            PG8_BAR; PG8_WAIT_L(0); PG8_MMA(0, 1, At, B1); PG8_BAR;
            PG8_LDA(At, 1, 1); PG8_STAGE(PG8_SA(1, 0), a3, voffA);
            PG8_BAR; PG8_WAIT_L(0); PG8_MMA(1, 0, At, B0); PG8_BAR; PG8_SCHED;
            PG8_STAGE(PG8_SB(1, 1), b3 + hstep, voffB);
            PG8_WAIT_V(6); PG8_BAR; PG8_MMA(1, 1, At, B1); PG8_BAR;
        }
        PG8_STAMP();
        if constexpr (!Epi::AFTER_DRAIN) { E(acc, cur, wr, wc, fr, fq); S.done(cur); }
        PG8_STAMP();
        if (!has_next) break;
#pragma unroll
        for (int a = 0; a < 2; ++a)
#pragma unroll
            for (int b = 0; b < 2; ++b)
#pragma unroll
                for (int m = 0; m < 4; ++m)
#pragma unroll
                    for (int n = 0; n < 2; ++n) acc[a][b][m][n] = (f32x4){0.f, 0.f, 0.f, 0.f};
        cur = nxt; cA = nA; cB = nB; ++ui;
    }
    PG8_WAIT_V(0);
    if (wr == 0) PG8_BAR;
    PG8_BAR;
    if constexpr (Epi::AFTER_DRAIN) { E.fused(acc, cur, wr, wc, fr, fq, lds, wid, lane); S.done(cur); }
    PG8_STAMP();
    if (STAMP && wid == 0) { stamps[lane] = lane < nts ? (((unsigned long long)(unsigned)ts_hi << 32) | (unsigned)ts_lo) : 0ull;
        if (lane == 62) stamps[62] = rt_entry; if (lane == 63) stamps[63] = (unsigned long long)wall_clock64(); }
#undef PG8_STAMP
#undef PG8_SA
#undef PG8_SB
#undef PG8_STAGE
#undef PG8_LDA
#undef PG8_LDB
#undef PG8_MMA
#undef PG8_WAIT_V
#undef PG8_WAIT_L
#undef PG8_BAR
#undef PG8_SCHED
}
}

namespace att {
typedef unsigned short bf16;
constexpr int   D = 128, NW = 8, QBLK = 32, KVBLK = 64;
constexpr float SCALE = 0.088388347648318440f;
constexpr float THR = 8.f;
constexpr int SDEPTH = 2;
constexpr size_t SHM_V = KVBLK * D * 2, SHM_K = KVBLK * D * 2, SHM_ATTN = 2 * SHM_V + 2 * SHM_K + NW * 64 * 4;
using bf16x8 = __attribute__((ext_vector_type(8))) short;
using s16x4  = __attribute__((ext_vector_type(4))) short;
using f32x16 = __attribute__((ext_vector_type(16))) float;
using u32x4  = __attribute__((ext_vector_type(4))) unsigned;
#define KSWZ(row, colB) ((row) * 256 + ((colB) ^ (((row) & 7) << 4)))
#define SBAR() __builtin_amdgcn_sched_barrier(0)
__device__ __forceinline__ int crow(int r, int hi) { return (r & 3) + 8 * (r >> 2) + 4 * hi; }
__device__ __forceinline__ unsigned cvtpk(float lo, float hi) {
  unsigned r; asm volatile("v_cvt_pk_bf16_f32 %0, %1, %2" : "=v"(r) : "v"(lo), "v"(hi)); return r;
}
__device__ __forceinline__ bf16x8 ld8(const bf16* p) { return *reinterpret_cast<const bf16x8*>(p); }

__device__ __forceinline__ void partialSM(f32x16& p0, f32x16& p1, float& m_reg, float& mn, float& alpha) {
  constexpr float C = SCALE * 1.4426950408889634f;
  float pmax = p0[0]; for (int r = 1; r < 16; ++r) pmax = fmaxf(pmax, p0[r]); for (int r = 0; r < 16; ++r) pmax = fmaxf(pmax, p1[r]);
  { auto rr = __builtin_amdgcn_permlane32_swap(__float_as_uint(pmax), __float_as_uint(pmax), false, false);
    pmax = fmaxf(__uint_as_float(rr[0]), __uint_as_float(rr[1])); }
  if (__builtin_expect(__all(pmax - m_reg <= THR / SCALE), 1)) { mn = m_reg; alpha = 1.f; }
  else { mn = fmaxf(m_reg, pmax); alpha = __builtin_amdgcn_exp2f((m_reg - mn) * C); m_reg = mn; }
  float mnC = -mn * C;
  for (int r = 0; r < 16; ++r) p0[r] = fmaf(p0[r], C, mnC); for (int r = 0; r < 16; ++r) p1[r] = fmaf(p1[r], C, mnC);
  for (int r = 0; r < 16; ++r) p0[r] = __builtin_amdgcn_exp2f(p0[r]);
}
__device__ __forceinline__ void finishSM(f32x16& p0, f32x16& p1, float alpha, float& l_reg, bf16x8& pa0, bf16x8& pa1, bf16x8& pa2, bf16x8& pa3) {
  for (int r = 0; r < 16; ++r) p1[r] = __builtin_amdgcn_exp2f(p1[r]);
  float ps = 0; for (int r = 0; r < 16; ++r) ps += p0[r]; for (int r = 0; r < 16; ++r) ps += p1[r];
  { auto rr = __builtin_amdgcn_permlane32_swap(__float_as_uint(ps), __float_as_uint(ps), false, false);
    ps = __uint_as_float(rr[0]) + __uint_as_float(rr[1]); }
  l_reg = l_reg * alpha + ps;
#define PK4(P, BASE, OUT) do { unsigned a0 = cvtpk(P[BASE + 0], P[BASE + 1]), a1 = cvtpk(P[BASE + 2], P[BASE + 3]);   \
    unsigned b0 = cvtpk(P[BASE + 4], P[BASE + 5]), b1 = cvtpk(P[BASE + 6], P[BASE + 7]);                              \
    auto r0 = __builtin_amdgcn_permlane32_swap(a0, b0, false, false); auto r1 = __builtin_amdgcn_permlane32_swap(a1, b1, false, false); \
    u32x4 w = {r0[0], r1[0], r0[1], r1[1]}; OUT = *reinterpret_cast<bf16x8*>(&w); } while (0)
  PK4(p0, 0, pa0); PK4(p0, 8, pa1); PK4(p1, 0, pa2); PK4(p1, 8, pa3);
#undef PK4
}
__device__ __forceinline__ void qkt(f32x16& p0, f32x16& p1, const bf16* Ks, const bf16x8* qr, int r32, int hi) {
  p0 = f32x16{}; p1 = f32x16{};
  for (int d0 = 0; d0 < 8; ++d0) { int cb = (d0 * 16 + hi * 8) * 2;
    bf16x8 b0 = *reinterpret_cast<const bf16x8*>((const char*)Ks + KSWZ(r32, cb));
    bf16x8 b1 = *reinterpret_cast<const bf16x8*>((const char*)Ks + KSWZ(32 + r32, cb));
    p0 = __builtin_amdgcn_mfma_f32_32x32x16_bf16(b0, qr[d0], p0, 0, 0, 0);
    p1 = __builtin_amdgcn_mfma_f32_32x32x16_bf16(b1, qr[d0], p1, 0, 0, 0); }
}
__device__ __forceinline__ int v_st(int k, int c) { const int kk = (k & ~0xC) | ((k & 4) << 1) | ((k & 8) >> 1); return ((kk >> 3) * 4 + (c >> 5)) * 512 + ((kk & 7) * 32 + (c & 31)) * 2; }
__device__ __forceinline__ int v_rd_base(int lane) { return ((lane & 3) << 3) | (((lane >> 2) & 3) << 6) | (((lane >> 4) & 1) << 5) | (((lane >> 5) & 1) << 8); }
constexpr int v_rd_off(int d0, int ks, int half) { return d0 * 512 + ks * 4096 + half * 2048; }
template <int OFF> __device__ __forceinline__ s16x4 tr_read(int vb) {
  s16x4 r; asm volatile("ds_read_b64_tr_b16 %0, %1 offset:%2" : "=&v"(r) : "v"(vb), "i"(OFF) : "memory"); return r;
}
template <int D0> __device__ __forceinline__ void pv_one(f32x16& od, int vb, bf16x8 pa0, bf16x8 pa1, bf16x8 pa2, bf16x8 pa3) {
  const s16x4 l0 = tr_read<v_rd_off(D0, 0, 0)>(vb), h0 = tr_read<v_rd_off(D0, 0, 1)>(vb), l1 = tr_read<v_rd_off(D0, 1, 0)>(vb), h1 = tr_read<v_rd_off(D0, 1, 1)>(vb);
  const s16x4 l2 = tr_read<v_rd_off(D0, 2, 0)>(vb), h2 = tr_read<v_rd_off(D0, 2, 1)>(vb), l3 = tr_read<v_rd_off(D0, 3, 0)>(vb), h3 = tr_read<v_rd_off(D0, 3, 1)>(vb);
  asm volatile("s_waitcnt lgkmcnt(0)" ::: "memory"); SBAR();
#define PK(L, H) (bf16x8){L[0], L[1], L[2], L[3], H[0], H[1], H[2], H[3]}
  od = __builtin_amdgcn_mfma_f32_32x32x16_bf16(pa0, PK(l0, h0), od, 0, 0, 0);
  od = __builtin_amdgcn_mfma_f32_32x32x16_bf16(pa1, PK(l1, h1), od, 0, 0, 0);
  od = __builtin_amdgcn_mfma_f32_32x32x16_bf16(pa2, PK(l2, h2), od, 0, 0, 0);
  od = __builtin_amdgcn_mfma_f32_32x32x16_bf16(pa3, PK(l3, h3), od, 0, 0, 0);
#undef PK
}
__device__ __forceinline__ void pv_d0(f32x16* o, int vb, bf16x8 pa0, bf16x8 pa1, bf16x8 pa2, bf16x8 pa3) {
  pv_one<0>(o[0], vb, pa0, pa1, pa2, pa3); pv_one<1>(o[1], vb, pa0, pa1, pa2, pa3); pv_one<2>(o[2], vb, pa0, pa1, pa2, pa3); pv_one<3>(o[3], vb, pa0, pa1, pa2, pa3);
}

template <int LDQ, int LDK, int LDO>
__device__ __forceinline__ void attn_dense_body(const bf16* __restrict__ Qb, const bf16* __restrict__ Kc, const bf16* __restrict__ Kl, int voff, int nct,
                                                bf16* __restrict__ Ob, int NT, char* lds) {
  const int tid = threadIdx.x, wid = tid >> 6, lane = tid & 63, r32 = lane & 31, hi = lane >> 5;
  bf16* V_lds = (bf16*)lds; bf16* K_lds = (bf16*)(lds + 2 * SHM_V);
  float* ws = (float*)(lds + 2 * SHM_V + 2 * SHM_K) + wid * 64; float* li_l = ws; float* al_l = ws + 32;
  float m_reg = -1e30f, l_reg = 0; f32x16 o[4] = {}; bf16x8 qr[8];
  const bf16* Qw = Qb + (long)(wid * QBLK + r32) * LDQ + hi * 8;
#pragma unroll
  for (int d0 = 0; d0 < 8; ++d0) qr[d0] = ld8(Qw + d0 * 16);
  const int sr = tid >> 4, sc = (tid & 15) * 8, vst0 = v_st(sr, sc), vst1 = v_st(32 + sr, sc);
  const int vb0 = (int)(uintptr_t)V_lds + v_rd_base(lane);
  struct { bf16x8 vs0, vs1, ks0, ks1; } sr_[SDEPTH];
#define TBASE(t) (((t) < nct) ? (Kc + (long)(t) * KVBLK * LDK) : (Kl + (long)((t) - nct) * KVBLK * LDK))
#define SLOAD(i, t) do { const bf16* kb_ = TBASE(t); sr_[i].vs0 = ld8(&kb_[(long)(sr) * LDK + sc + voff]); sr_[i].vs1 = ld8(&kb_[(long)(32 + sr) * LDK + sc + voff]); \
    sr_[i].ks0 = ld8(&kb_[(long)(sr) * LDK + sc]); sr_[i].ks1 = ld8(&kb_[(long)(32 + sr) * LDK + sc]); } while (0)
#define SWRITE(b, i) do { *(bf16x8*)((char*)V_lds + (b) * SHM_V + vst0) = sr_[i].vs0;          \
    *(bf16x8*)((char*)V_lds + (b) * SHM_V + vst1) = sr_[i].vs1; int kc = sc * 2;               \
    *(bf16x8*)((char*)K_lds + (b) * SHM_K + KSWZ(sr, kc)) = sr_[i].ks0;                       \
    *(bf16x8*)((char*)K_lds + (b) * SHM_K + KSWZ(32 + sr, kc)) = sr_[i].ks1; } while (0)
#define SWAIT() do { asm volatile("s_waitcnt vmcnt(4)" ::: "memory"); } while (0)
#define RESC(a) do { if (__any((a) < 1.f)) { if (hi == 0) al_l[r32] = (a); asm volatile("s_waitcnt lgkmcnt(0)" ::: "memory"); \
    for (int d = 0; d < 4; ++d) for (int r = 0; r < 16; ++r) o[d][r] *= al_l[crow(r, hi)]; } } while (0)
  f32x16 pA0, pA1, pB0, pB1; float mnA, mnB, alA, alB; bf16x8 pa0, pa1, pa2, pa3;
  constexpr int SE = 0, SO = SDEPTH - 1;
  SLOAD(SE, 0); asm volatile("s_waitcnt vmcnt(0)" ::: "memory"); SWRITE(0, SE); __syncthreads();
  qkt(pA0, pA1, K_lds, qr, r32, hi); partialSM(pA0, pA1, m_reg, mnA, alA);
  SLOAD(SO, 1); if (2 < NT) SLOAD(SE, 2);
  SWAIT(); SWRITE(1, SO); __syncthreads();
  for (int j = 1; j + 1 < NT; j += 2) {
    SBAR(); qkt(pB0, pB1, (bf16*)((char*)K_lds + SHM_K), qr, r32, hi);
    finishSM(pA0, pA1, alA, l_reg, pa0, pa1, pa2, pa3); SBAR();
    SLOAD(SO, (j + SDEPTH)); SBAR();
    pv_d0(o, vb0, pa0, pa1, pa2, pa3); partialSM(pB0, pB1, m_reg, mnB, alB);
    __syncthreads(); SWAIT(); SWRITE(0, SE);
    RESC(alB); __syncthreads();
    SBAR(); qkt(pA0, pA1, K_lds, qr, r32, hi);
    finishSM(pB0, pB1, alB, l_reg, pa0, pa1, pa2, pa3); SBAR();
    if (j + 3 < NT) SLOAD(SE, (j + 1 + SDEPTH)); SBAR();
    pv_d0(o, vb0 + (int)SHM_V, pa0, pa1, pa2, pa3); partialSM(pA0, pA1, m_reg, mnA, alA);
    __syncthreads(); SWAIT(); SWRITE(1, SO);
    RESC(alA); __syncthreads();
  }
  SBAR(); qkt(pB0, pB1, (bf16*)((char*)K_lds + SHM_K), qr, r32, hi);
  finishSM(pA0, pA1, alA, l_reg, pa0, pa1, pa2, pa3); SBAR();
  pv_d0(o, vb0, pa0, pa1, pa2, pa3); partialSM(pB0, pB1, m_reg, mnB, alB);
  __syncthreads(); RESC(alB);
  finishSM(pB0, pB1, alB, l_reg, pa0, pa1, pa2, pa3); SBAR();
  pv_d0(o, vb0 + (int)SHM_V, pa0, pa1, pa2, pa3);
  if (hi == 0) li_l[r32] = l_reg; asm volatile("s_waitcnt lgkmcnt(0)" ::: "memory");
  float rli[16];
#pragma unroll
  for (int r = 0; r < 16; ++r) rli[r] = __builtin_amdgcn_rcpf(li_l[crow(r, hi)]);
  bf16* Ow = Ob + (long)(wid * QBLK) * LDO;
#pragma unroll
  for (int r = 0; r < 16; ++r) { int orow = crow(r, hi);
#pragma unroll
    for (int d0 = 0; d0 < 4; d0 += 1) { const float f = o[d0][r] * rli[r]; unsigned u = __float_as_uint(f); u += 0x7FFFu + ((u >> 16) & 1u);
      Ow[(long)orow * LDO + d0 * 32 + r32] = (bf16)(u >> 16); } }
#undef TBASE
#undef SLOAD
#undef SWRITE
#undef SWAIT
#undef RESC
}
#undef KSWZ
#undef SBAR
}

namespace mk {
typedef unsigned short bf16;
typedef unsigned u32x4v __attribute__((ext_vector_type(4)));
typedef float f32x4v __attribute__((ext_vector_type(4)));
constexpr int D = 2048, NB = 2, L = 8192, CL = 256, TL = NB * L, TC = NB * CL, T = TL + TC, HD = 128, DEPTH = 4;
constexpr int NQ_AB = 4608, NQ_C = 3072, NE = 16384, NMOD = 6 * D;
constexpr float ALPHA = 1.6817928305074290f;
constexpr float SCALE = 0.088388347648318440f;
constexpr float NEG = -1e30f;

constexpr size_t al256(size_t x) { return (x + 255) & ~(size_t)255; }
constexpr size_t WS_CTL    = 0;
constexpr size_t WS_MOD    = 16384;
constexpr size_t WS_ROPE   = al256(WS_MOD + (size_t)DEPTH * 3 * NMOD * 4);
constexpr size_t WS_WIN_AB = al256(WS_ROPE + 2 * 128 * 32 * 4);
constexpr size_t WS_WOUT_AB= al256(WS_WIN_AB + (size_t)2 * NQ_AB * D * 2);
constexpr size_t WS_WIN_C  = al256(WS_WOUT_AB + (size_t)2 * D * D * 2);
constexpr size_t WS_WOUT_C = al256(WS_WIN_C + (size_t)2 * NQ_C * D * 2);
constexpr size_t WS_WPQ    = al256(WS_WOUT_C + (size_t)2 * D * D * 2);
constexpr size_t WS_SK     = al256(WS_WPQ + (size_t)4 * D * D * 2);
constexpr size_t WS_U      = al256(WS_SK + (size_t)4 * 16 * 128 * 128 * 2);
constexpr size_t WS_V      = al256(WS_U + (size_t)4 * NE * D * 2);
constexpr size_t WS_X      = al256(WS_V + (size_t)4 * NE * D * 2);
constexpr size_t WS_H      = al256(WS_X + (size_t)T * D * 4);
constexpr size_t WS_QKV    = al256(WS_H + (size_t)T * D * 2);
constexpr size_t WS_ATT    = al256(WS_QKV + (size_t)T * NQ_AB * 2);
constexpr size_t WS_Y      = al256(WS_ATT + (size_t)T * D * 2);
constexpr size_t WS_PQ     = al256(WS_Y + (size_t)T * D * 4);
constexpr size_t WS_TOPV   = al256(WS_PQ + (size_t)T * D * 2);
constexpr size_t WS_TOPI   = al256(WS_TOPV + (size_t)T * 256 * 4);
constexpr size_t WS_IDX    = al256(WS_TOPI + (size_t)T * 256 * 4);
constexpr size_t WS_GATE   = al256(WS_IDX + (size_t)T * 128 * 4);
constexpr size_t WS_END    = al256(WS_GATE + (size_t)T * 128 * 4);

constexpr int LDS_GEMM = 131072, LDS_MISC = LDS_GEMM, LDS_BYTES = LDS_GEMM + 256;

struct Params {
    const float *x, *c, *ctx, *c_ctx, *mod_w, *mod_b, *ln_g, *ln_b, *ab_w_in, *ab_w_out, *a_sink, *b_rpb, *c_w_in, *c_w_out, *c_q_gain, *c_k_gain, *peer_wq, *peer_sk, *peer_u, *peer_v;
    float* out; unsigned char* ws; int ph_lo, ph_hi;
};

__device__ __forceinline__ float bflo(unsigned u) { return __uint_as_float(u << 16); }
__device__ __forceinline__ float bfhi(unsigned u) { return __uint_as_float(u & 0xffff0000u); }
__device__ __forceinline__ unsigned pk2(float lo, float hi) { return pg8::cvt_pk_bf16(lo, hi); }
__device__ __forceinline__ float wave_sum(float v) {
#pragma unroll
    for (int o = 32; o >= 1; o >>= 1) v += __shfl_xor(v, o); return v; }
__device__ __forceinline__ float wave_max(float v) {
#pragma unroll
    for (int o = 32; o >= 1; o >>= 1) v = fmaxf(v, __shfl_xor(v, o)); return v; }

__device__ __forceinline__ void tr_tile(const float* __restrict__ W, bf16* __restrict__ Wt, int K, int N, int tile, float* lds) {
    const int ntn = N >> 6, tk = tile / ntn, tn = tile - tk * ntn, tid = threadIdx.x;
#pragma unroll
    for (int i = tid; i < 1024; i += 512) { const int r = i >> 4, c4 = i & 15; const f32x4v v = *(const f32x4v*)(W + (size_t)(tk * 64 + r) * N + tn * 64 + c4 * 4);
        float* p = lds + r * 65 + c4 * 4; p[0] = v[0]; p[1] = v[1]; p[2] = v[2]; p[3] = v[3]; }
    __syncthreads();
    { const int n = tid >> 3, kc = tid & 7; float f[8];
#pragma unroll
      for (int i = 0; i < 8; ++i) f[i] = lds[(kc * 8 + i) * 65 + n];
      u32x4v w; w[0] = pk2(f[0], f[1]); w[1] = pk2(f[2], f[3]); w[2] = pk2(f[4], f[5]); w[3] = pk2(f[6], f[7]);
      *(u32x4v*)(Wt + (size_t)(tn * 64 + n) * K + tk * 64 + kc * 8) = w; }
    __syncthreads();
}
__device__ __forceinline__ void cvt_stream(const float* __restrict__ src, bf16* __restrict__ dst, size_t n8) {
    for (size_t i = (size_t)blockIdx.x * 512 + threadIdx.x; i < n8; i += (size_t)gridDim.x * 512) {
        const f32x4v a = *(const f32x4v*)(src + i * 8), b = *(const f32x4v*)(src + i * 8 + 4);
        u32x4v w; w[0] = pk2(a[0], a[1]); w[1] = pk2(a[2], a[3]); w[2] = pk2(b[0], b[1]); w[3] = pk2(b[2], b[3]);
        *(u32x4v*)(dst + i * 8) = w; }
}
__device__ __forceinline__ void sincos_d(double a, double& s, double& c) {
    const double k = __builtin_rint(a * 0.63661977236758134308);
    double r = __builtin_fma(-k, 1.57079632679489655800, a); r = __builtin_fma(-k, 6.12323399573676603587e-17, r);
    const double r2 = r * r;
    double sp = -7.6471637318198164759e-13; sp = sp * r2 + 1.6059043836821614599e-10; sp = sp * r2 - 2.5052108385441718775e-08; sp = sp * r2 + 2.7557319223985890653e-06;
    sp = sp * r2 - 1.9841269841269841270e-04; sp = sp * r2 + 8.3333333333333333333e-03; sp = sp * r2 - 1.6666666666666666667e-01; const double sr = r + r * r2 * sp;
    double cp = 4.7794773323873852974e-14; cp = cp * r2 - 1.1470745597729724714e-11; cp = cp * r2 + 2.0876756987868098979e-09; cp = cp * r2 - 2.7557319223985890653e-07;
    cp = cp * r2 + 2.4801587301587301587e-05; cp = cp * r2 - 1.3888888888888888889e-03; cp = cp * r2 + 4.1666666666666666667e-02; cp = cp * r2 - 0.5; const double cr = 1.0 + r2 * cp;
    const int q = ((int)k) & 3;
    s = (q == 0) ? sr : (q == 1) ? cr : (q == 2) ? -sr : -cr;
    c = (q == 0) ? cr : (q == 1) ? -sr : (q == 2) ? -cr : sr;
}

__device__ __forceinline__ void phase_prologue(const Params& p, unsigned char* lds_raw) {
    float* lds = (float*)lds_raw; unsigned char* ws = p.ws; const int tid = threadIdx.x;
    { const int nt_inab = 32 * (NQ_AB / 64), nt_sq = 32 * 32, nt_inc = 32 * (NQ_C / 64);
      const int o1 = 2 * nt_inab, o2 = o1 + 2 * nt_sq, o3 = o2 + 2 * nt_inc, o4 = o3 + 2 * nt_sq, o5 = o4 + 4 * nt_sq;
      for (int t = blockIdx.x; t < o5; t += gridDim.x) {
          const float* W; bf16* Wt; int N, tile;
          if (t < o1)      { const int i = t / nt_inab; tile = t - i * nt_inab; N = NQ_AB; W = p.ab_w_in + (size_t)i * D * NQ_AB; Wt = (bf16*)(ws + WS_WIN_AB) + (size_t)i * NQ_AB * D; }
          else if (t < o2) { const int u = t - o1, i = u / nt_sq; tile = u - i * nt_sq; N = D; W = p.ab_w_out + (size_t)i * D * D; Wt = (bf16*)(ws + WS_WOUT_AB) + (size_t)i * D * D; }
          else if (t < o3) { const int u = t - o2, i = u / nt_inc; tile = u - i * nt_inc; N = NQ_C; W = p.c_w_in + (size_t)i * D * NQ_C; Wt = (bf16*)(ws + WS_WIN_C) + (size_t)i * NQ_C * D; }
          else if (t < o4) { const int u = t - o3, i = u / nt_sq; tile = u - i * nt_sq; N = D; W = p.c_w_out + (size_t)i * D * D; Wt = (bf16*)(ws + WS_WOUT_C) + (size_t)i * D * D; }
          else             { const int u = t - o4, i = u / nt_sq; tile = u - i * nt_sq; N = D; W = p.peer_wq + (size_t)i * D * D; Wt = (bf16*)(ws + WS_WPQ) + (size_t)i * D * D; }
          tr_tile(W, Wt, D, N, tile, lds);
      } }
    cvt_stream(p.peer_u, (bf16*)(ws + WS_U), (size_t)4 * NE * D / 8);
    cvt_stream(p.peer_v, (bf16*)(ws + WS_V), (size_t)4 * NE * D / 8);
    cvt_stream(p.peer_sk, (bf16*)(ws + WS_SK), (size_t)4 * 16 * 128 * 128 / 8);
    for (int i = blockIdx.x * 512 + tid; i < 128 * 32; i += gridDim.x * 512) {
        const int pp = i >> 5, j = i & 31;
        double fd = 1.0; for (int q = 0; q < j; ++q) fd *= 0.74989420933245582730;
        const float invf = (float)fd;
        const float ang = (float)pp * invf; double s, c; sincos_d((double)ang, s, c);
        ((float*)(ws + WS_ROPE))[i] = (float)c; ((float*)(ws + WS_ROPE))[128 * 32 + i] = (float)s; }
    { float* sv = lds;
      float* part = lds + 3 * D;
      for (int i = tid; i < 3 * D; i += 512) { const int r = i / D, k = i - r * D; const float v = (r < 2) ? p.c[r * D + k] : p.c_ctx[k]; sv[i] = v / (1.f + __expf(-v)); }
      __syncthreads();
      const int kq = tid >> 4, nq = tid & 15;
      for (int t = blockIdx.x; t < DEPTH * (NMOD / 64); t += gridDim.x) {
          const int l = t / (NMOD / 64), n0 = (t - l * (NMOD / 64)) * 64;
          const float* Wp = p.mod_w + (size_t)l * D * NMOD + (size_t)(kq * 64) * NMOD + n0 + nq * 4;
          f32x4v a0 = {0.f, 0.f, 0.f, 0.f}, a1 = a0, a2 = a0;
#pragma unroll 8
          for (int k = 0; k < 64; ++k) { const f32x4v w = *(const f32x4v*)(Wp + (size_t)k * NMOD); const int kk = kq * 64 + k;
              a0 += w * sv[kk]; a1 += w * sv[D + kk]; a2 += w * sv[2 * D + kk]; }
          float* pp = part + (kq * 3) * 64 + nq * 4;
#pragma unroll
          for (int e = 0; e < 4; ++e) { pp[e] = a0[e]; pp[64 + e] = a1[e]; pp[128 + e] = a2[e]; }
          __syncthreads();
          if (tid < 192) { const int r = tid >> 6, n = tid & 63; float s = 0.f;
#pragma unroll 8
              for (int q = 0; q < 32; ++q) s += part[(q * 3 + r) * 64 + n];
              ((float*)(ws + WS_MOD))[((size_t)l * 3 + r) * NMOD + n0 + n] = s + p.mod_b[(size_t)l * NMOD + n0 + n]; }
          __syncthreads();
      } }
}

__device__ __forceinline__ void phase_mod0(const Params& p) {
    const int wave = threadIdx.x >> 6, lane = threadIdx.x & 63; const float* MOD = (const float*)(p.ws + WS_MOD); bf16* H = (bf16*)(p.ws + WS_H);
    for (int row = blockIdx.x * 8 + wave; row < T; row += gridDim.x * 8) {
        const float* xr = (row < TL) ? p.x + (size_t)row * D : p.ctx + (size_t)(row - TL) * D;
        const int b = (row < TL) ? (row / L) : 2; const float* m = MOD + (size_t)b * NMOD;
#pragma unroll
        for (int i = 0; i < 8; ++i) { const int col = i * 256 + lane * 4;
            const f32x4v xv = *(const f32x4v*)(xr + col), sh = *(const f32x4v*)(m + col), sc = *(const f32x4v*)(m + D + col);
            const f32x4v h = xv * (1.f + sc) + sh; uint2 w; w.x = pk2(h[0], h[1]); w.y = pk2(h[2], h[3]);
            *(uint2*)(H + (size_t)row * D + col) = w; }
    }
}
__device__ __forceinline__ void phase_ln(const float* xl, const float* xc, const float* __restrict__ y, const float* __restrict__ modg, int gidx,
                         const float* __restrict__ lng, const float* __restrict__ lnb, float* xol, float* xoc,
                         bf16* __restrict__ H, const float* __restrict__ modn, int shi, int sci, int nrows) {
    const int wave = threadIdx.x >> 6, lane = threadIdx.x & 63;
    for (int row = blockIdx.x * 8 + wave; row < nrows; row += gridDim.x * 8) {
        const bool lat = row < TL; const int b = lat ? (row / L) : 2;
        const float* xr = lat ? xl + (size_t)row * D : xc + (size_t)(row - TL) * D;
        float* xo = lat ? xol + (size_t)row * D : xoc + (size_t)(row - TL) * D;
        const float* yr = y + (size_t)row * D; const float* gv = modg + (size_t)b * NMOD + (size_t)gidx * D;
        f32x4v z[8]; float s = 0.f;
#pragma unroll
        for (int i = 0; i < 8; ++i) { const int col = i * 256 + lane * 4;
            const f32x4v xv = *(const f32x4v*)(xr + col), yv = *(const f32x4v*)(yr + col), g = *(const f32x4v*)(gv + col);
            z[i] = xv * ALPHA + g * yv; s += (z[i][0] + z[i][1]) + (z[i][2] + z[i][3]); }
        const float mean = wave_sum(s) * (1.f / D); float q = 0.f;
#pragma unroll
        for (int i = 0; i < 8; ++i) { const f32x4v d = z[i] - mean; q += (d[0] * d[0] + d[1] * d[1]) + (d[2] * d[2] + d[3] * d[3]); }
        const float rstd = rsqrtf(wave_sum(q) * (1.f / D) + 1e-5f);
#pragma unroll
        for (int i = 0; i < 8; ++i) { const int col = i * 256 + lane * 4;
            const f32x4v g = *(const f32x4v*)(lng + col), bb = *(const f32x4v*)(lnb + col);
            const f32x4v o = (z[i] - mean) * rstd * g + bb; *(f32x4v*)(xo + col) = o;
            if (H) { const float* m = modn + (size_t)b * NMOD; const f32x4v sh = *(const f32x4v*)(m + (size_t)shi * D + col), sc = *(const f32x4v*)(m + (size_t)sci * D + col);
                const f32x4v h = o * (1.f + sc) + sh; uint2 w; w.x = pk2(h[0], h[1]); w.y = pk2(h[2], h[3]); *(uint2*)(H + (size_t)row * D + col) = w; } }
    }
}

__device__ __forceinline__ void phase_prep(bf16* __restrict__ QKV, int ld, int nheads, int nqh, bool isC, const float* __restrict__ qg, const float* __restrict__ kg, const float* __restrict__ rope, int ntok) {
    const long total = (long)ntok * nheads * 4;
    for (long task = (long)blockIdx.x * 512 + threadIdx.x; task < total; task += (long)gridDim.x * 512) {
        const int j = (int)(task & 3); const long th = task >> 2; const int hh = (int)(th % nheads); const int t = (int)(th / nheads);
        bf16* base = QKV + (size_t)t * ld + hh * 128 + j * 8;
        float x[4][8];
#pragma unroll
        for (int s = 0; s < 4; ++s) { const u32x4v w = *(const u32x4v*)(base + s * 32);
#pragma unroll
            for (int e = 0; e < 4; ++e) { x[s][2 * e] = bflo(w[e]); x[s][2 * e + 1] = bfhi(w[e]); } }
        if (isC) {
            float ss = 0.f;
#pragma unroll
            for (int s = 0; s < 4; ++s)
#pragma unroll
                for (int e = 0; e < 8; ++e) ss += x[s][e] * x[s][e];
            ss += __shfl_xor(ss, 1); ss += __shfl_xor(ss, 2);
            const float r = rsqrtf(ss * (1.f / 128.f) + 1e-6f); const float* gn = (hh < nqh) ? qg : kg;
#pragma unroll
            for (int s = 0; s < 4; ++s)
#pragma unroll
                for (int e = 0; e < 8; ++e) x[s][e] = x[s][e] * r * gn[s * 32 + j * 8 + e];
        }
        if (t < TL) {
            const int pos = t & (L - 1), prow = pos >> 6, pcol = pos & 63;
            const float* cr = rope + prow * 32 + j * 8; const float* sr = rope + 128 * 32 + prow * 32 + j * 8;
            const float* cc = rope + pcol * 32 + j * 8; const float* sc = rope + 128 * 32 + pcol * 32 + j * 8;
#pragma unroll
            for (int e = 0; e < 8; ++e) {
                const float a = x[0][e], b = x[1][e], c = x[2][e], d = x[3][e];
                x[0][e] = a * cr[e] - b * sr[e]; x[1][e] = b * cr[e] + a * sr[e];
                x[2][e] = c * cc[e] - d * sc[e]; x[3][e] = d * cc[e] + c * sc[e]; }
        }
#pragma unroll
        for (int s = 0; s < 4; ++s) { u32x4v w;
#pragma unroll
            for (int e = 0; e < 4; ++e) w[e] = pk2(x[s][2 * e], x[s][2 * e + 1]);
            *(u32x4v*)(base + s * 32) = w; }
    }
}

struct NaiveQ { const bf16* q; bf16* o; float sink; bool has_sink; };
__device__ __forceinline__ float dot128(const u32x4v (&qv)[16], const bf16* __restrict__ kp) {
    float acc = 0.f;
#pragma unroll
    for (int i = 0; i < 16; ++i) { const u32x4v kv = *(const u32x4v*)(kp + i * 8);
#pragma unroll
        for (int e = 0; e < 4; ++e) { acc = fmaf(bflo(qv[i][e]), bflo(kv[e]), acc); acc = fmaf(bfhi(qv[i][e]), bfhi(kv[e]), acc); } }
    return acc;
}
struct SoftState { float m, l, o0, o1; };
__device__ __forceinline__ void naive_step(SoftState& st, const u32x4v (&qv)[16], const bf16* __restrict__ base, int off, bool valid, float bias, int voff, int lane) {
    float s = valid ? dot128(qv, base + off) * SCALE + bias : NEG;
    const float bm = wave_max(s), mn = fmaxf(st.m, bm);
    const float pr = valid ? __expf(s - mn) : 0.f, alpha = __expf(st.m - mn);
    st.l = st.l * alpha + wave_sum(pr); st.o0 *= alpha; st.o1 *= alpha; st.m = mn;
    for (int kk = 0; kk < 64; ++kk) {
        const float pk = __shfl(pr, kk); const int ok = __shfl(off, kk);
        const unsigned w = *(const unsigned*)(base + ok + voff + 2 * lane);
        st.o0 = fmaf(pk, bflo(w), st.o0); st.o1 = fmaf(pk, bfhi(w), st.o1); }
}
__device__ __forceinline__ void naive_finish(const SoftState& st, bool has_sink, float sink, bf16* op, int lane) {
    float l = st.l; if (has_sink) l += __expf(sink - st.m);
    const float inv = 1.f / l; *(unsigned*)(op + 2 * lane) = pk2(st.o0 * inv, st.o1 * inv);
}
__device__ __forceinline__ void load_q(u32x4v (&qv)[16], const bf16* qp) {
#pragma unroll
    for (int i = 0; i < 16; ++i) qv[i] = *(const u32x4v*)(qp + i * 8);
}

__device__ __forceinline__ void phase_attn_ab_naive(const bf16* __restrict__ QKV, bf16* __restrict__ ATT, const float* __restrict__ sinkv, const float* __restrict__ rpb, bool with_ctx) {
    constexpr int LD = NQ_AB; const int wave = threadIdx.x >> 6, lane = threadIdx.x & 63;
    const long ntask = (long)(with_ctx ? T : TL) * 16;
    for (long task = (long)blockIdx.x * 8 + wave; task < ntask; task += (long)gridDim.x * 8) {
        const int t = (int)(task >> 4), hd = (int)(task & 15); const bool isA = hd < 8; const int h = hd & 7;
        const bool lat = t < TL; const int b = lat ? (t >> 13) : ((t - TL) >> 8);
        const int qcol = isA ? h * 128 : 1536 + h * 128, kcol = isA ? 1024 + (h >> 2) * 128 : 2560 + h * 128, voff = isA ? 256 : 1024;
        u32x4v qv[16]; load_q(qv, QKV + (size_t)t * LD + qcol);
        SoftState st{NEG, 0.f, 0.f, 0.f};
        const bf16* kc0 = QKV + (size_t)(TL + b * CL) * LD + kcol;
        if (lat) {
            const int pos = t & (L - 1); const bf16* kl0 = QKV + (size_t)(b * L) * LD + kcol;
            if (isA) {
                for (int s = 0; s < 5; ++s) { const int kp = pos - 128 + s * 64 + lane; const bool valid = kp >= 0 && kp < L && kp <= pos + 128;
                    naive_step(st, qv, kl0, (valid ? kp : 0) * LD, valid, 0.f, voff, lane); }
            } else {
                const int r = pos >> 6, c = pos & 63;
                const int rs = min(max(r - 4, 0), 120), wsx = min(max(c - 8, 0), 48);
                for (int s = 0; s < 2; ++s) { const int e = s * 64 + lane, kr = rs + (e >> 4), kcx = wsx + (e & 15);
                    const int dr = kr - r + 7, dc = min(max(kcx - c + 15, 0), 30);
                    const float bias = rpb[(h * 15 + dr) * 31 + dc];
                    naive_step(st, qv, kl0, (kr * 64 + kcx) * LD, true, bias, voff, lane); }
            }
        }
        for (int s = 0; s < 4; ++s) naive_step(st, qv, kc0, (s * 64 + lane) * LD, true, 0.f, voff, lane);
        naive_finish(st, isA, isA ? sinkv[h] : 0.f, ATT + (size_t)t * D + (isA ? h * 128 : 1024 + h * 128), lane);
    }
}
__device__ __forceinline__ void phase_attn_c_ctx_naive(const bf16* __restrict__ QKV, bf16* __restrict__ ATT) {
    constexpr int LD = NQ_C; const int wave = threadIdx.x >> 6, lane = threadIdx.x & 63;
    for (int task = blockIdx.x * 8 + wave; task < TC * 16; task += gridDim.x * 8) {
        const int t = TL + (task >> 4), h = task & 15, b = (t - TL) >> 8;
        u32x4v qv[16]; load_q(qv, QKV + (size_t)t * LD + h * 128);
        SoftState st{NEG, 0.f, 0.f, 0.f};
        const bf16* kc0 = QKV + (size_t)(TL + b * CL) * LD + 2048 + (h >> 2) * 128;
        for (int s = 0; s < 4; ++s) naive_step(st, qv, kc0, (s * 64 + lane) * LD, true, 0.f, 512, lane);
        naive_finish(st, false, 0.f, ATT + (size_t)t * D + h * 128, lane);
    }
}
__device__ __forceinline__ void phase_attn_c_dense(const bf16* __restrict__ QKV, bf16* __restrict__ ATT, char* lds) {
    for (int u = blockIdx.x; u < NB * 16 * (L / 256); u += gridDim.x) {
        const int g = u & 7, rest = u >> 3, b = g >> 2, kvh = g & 3, hq = kvh * 4 + (rest >> 5), qb = rest & 31;
        const bf16* Qb = QKV + (size_t)(b * L + qb * 256) * NQ_C + hq * 128;
        const bf16* Kc = QKV + (size_t)(TL + b * CL) * NQ_C + 2048 + kvh * 128;
        const bf16* Kl = QKV + (size_t)(b * L) * NQ_C + 2048 + kvh * 128;
        att::attn_dense_body<NQ_C, NQ_C, D>(Qb, Kc, Kl, 512, CL / 64, ATT + (size_t)(b * L + qb * 256) * D + hq * 128, (CL + L) / 64, lds);
        __syncthreads();
    }
}

#define MK_INSERT16(tv, ti, v_, id_) do { float v__ = (v_); int id__ = (id_); _Pragma("unroll") for (int k_ = 0; k_ < 16; ++k_) { const bool gt_ = v__ > tv[k_]; \
    const float ov_ = tv[k_]; const int oi_ = ti[k_]; tv[k_] = gt_ ? v__ : ov_; ti[k_] = gt_ ? id__ : oi_; v__ = gt_ ? ov_ : v__; id__ = gt_ ? oi_ : id__; } } while (0)
__device__ __forceinline__ void phase_sel1_naive(const bf16* __restrict__ PQ, const bf16* __restrict__ SK, float* __restrict__ TOPV, int* __restrict__ TOPI, int ntok) {
    const int wave = threadIdx.x >> 6, lane = threadIdx.x & 63; const int ntile = ntok >> 6;
    for (int wt = blockIdx.x * 8 + wave; wt < ntile * 16; wt += gridDim.x * 8) {
        const int hp = __builtin_amdgcn_readfirstlane(wt & 15), t = (wt >> 4) * 64 + lane;
        u32x4v qv[16]; load_q(qv, PQ + (size_t)t * D + hp * 128);
        float tv[16]; int ti[16];
#pragma unroll
        for (int k = 0; k < 16; ++k) { tv[k] = -3.0e38f; ti[k] = 0; }
        const bf16* skb = SK + (size_t)hp * 128 * 128;
        for (int n = 0; n < 128; ++n) { const float s = dot128(qv, skb + n * 128); MK_INSERT16(tv, ti, s, n); }
        float* ov = TOPV + ((size_t)t * 16 + hp) * 16; int* oi = TOPI + ((size_t)t * 16 + hp) * 16;
#pragma unroll
        for (int k = 0; k < 16; ++k) { ov[k] = tv[k]; oi[k] = ti[k]; }
    }
}
__device__ __forceinline__ void phase_sel2_naive(const float* __restrict__ TOPV, const int* __restrict__ TOPI, int* __restrict__ IDX, float* __restrict__ GATE, int ntok) {
    for (int task = blockIdx.x * 512 + threadIdx.x; task < ntok * 8; task += gridDim.x * 512) {
        const float* av = TOPV + (size_t)task * 32; const int* ai = TOPI + (size_t)task * 32;
        float bv[16]; int bi[16];
#pragma unroll
        for (int k = 0; k < 16; ++k) { bv[k] = av[16 + k]; bi[k] = ai[16 + k]; }
        float tv[16]; int ti[16];
#pragma unroll
        for (int k = 0; k < 16; ++k) { tv[k] = -3.0e38f; ti[k] = 0; }
#pragma unroll 1
        for (int i = 0; i < 16; ++i) { const float a = av[i]; const int ia = ai[i] * 128;
#pragma unroll
            for (int j = 0; j < 16; ++j) MK_INSERT16(tv, ti, a + bv[j], ia + bi[j]); }
        float e[16], sum = 0.f;
#pragma unroll
        for (int k = 0; k < 16; ++k) { e[k] = __expf(tv[k] - tv[0]); sum += e[k]; }
        const float inv = 1.f / sum;
#pragma unroll
        for (int k = 0; k < 16; ++k) { IDX[(size_t)task * 16 + k] = ti[k]; GATE[(size_t)task * 16 + k] = e[k] * inv; }
    }
}

__device__ __forceinline__ void phase_experts(const bf16* __restrict__ H, const bf16* __restrict__ U, const bf16* __restrict__ V, const int* __restrict__ IDX, const float* __restrict__ GATE,
                              float* __restrict__ Y, int ntok, unsigned char* lds_raw) {
    const int wave = threadIdx.x >> 6, lane = threadIdx.x & 63;
    int* widx = (int*)lds_raw + wave * 256; float* wsm = (float*)lds_raw + wave * 256 + 128;
    const int eslot = ((lane >> 5) & 1) * 8 + ((lane >> 4) & 1) * 4 + ((lane >> 3) & 1) * 2 + ((lane >> 2) & 1);
    for (int t = blockIdx.x * 8 + wave; t < ntok; t += gridDim.x * 8) {
        float hf[4][8];
#pragma unroll
        for (int c = 0; c < 4; ++c) { const u32x4v w = *(const u32x4v*)(H + (size_t)t * D + c * 512 + lane * 8);
#pragma unroll
            for (int e = 0; e < 4; ++e) { hf[c][2 * e] = bflo(w[e]); hf[c][2 * e + 1] = bfhi(w[e]); } }
        widx[lane] = IDX[(size_t)t * 128 + lane]; widx[64 + lane] = IDX[(size_t)t * 128 + 64 + lane];
        asm volatile("s_waitcnt lgkmcnt(0)" ::: "memory");
#pragma unroll 1
        for (int g = 0; g < 8; ++g) {
            float pr[16];
#pragma unroll
            for (int e = 0; e < 16; ++e) {
                const int id = __builtin_amdgcn_readfirstlane(widx[g * 16 + e]);
                const bf16* up = U + (size_t)id * D + lane * 8; float a = 0.f;
#pragma unroll
                for (int c = 0; c < 4; ++c) { const u32x4v w = *(const u32x4v*)(up + c * 512);
#pragma unroll
                    for (int q = 0; q < 4; ++q) { a = fmaf(bflo(w[q]), hf[c][2 * q], a); a = fmaf(bfhi(w[q]), hf[c][2 * q + 1], a); } }
                pr[e] = a; }
            const bool b5 = lane & 32, b4 = lane & 16, b3 = lane & 8, b2 = lane & 4;
            float q8[8], q4[4], q2[2], q1;
#pragma unroll
            for (int i = 0; i < 8; ++i) { const float keep = b5 ? pr[i + 8] : pr[i], send = b5 ? pr[i] : pr[i + 8]; q8[i] = keep + __shfl_xor(send, 32); }
#pragma unroll
            for (int i = 0; i < 4; ++i) { const float keep = b4 ? q8[i + 4] : q8[i], send = b4 ? q8[i] : q8[i + 4]; q4[i] = keep + __shfl_xor(send, 16); }
#pragma unroll
            for (int i = 0; i < 2; ++i) { const float keep = b3 ? q4[i + 2] : q4[i], send = b3 ? q4[i] : q4[i + 2]; q2[i] = keep + __shfl_xor(send, 8); }
            { const float keep = b2 ? q2[1] : q2[0], send = b2 ? q2[0] : q2[1]; q1 = keep + __shfl_xor(send, 4); }
            q1 += __shfl_xor(q1, 2); q1 += __shfl_xor(q1, 1);
            const float act = 0.5f * q1 * (1.f + erff(q1 * 0.70710678118654752f));
            const float wv = GATE[(size_t)t * 128 + g * 16 + eslot] * act;
            if ((lane & 3) == 0) wsm[g * 16 + eslot] = wv;
        }
        asm volatile("s_waitcnt lgkmcnt(0)" ::: "memory");
        float acc[4][8];
#pragma unroll
        for (int c = 0; c < 4; ++c)
#pragma unroll
            for (int e = 0; e < 8; ++e) acc[c][e] = 0.f;
#pragma unroll 4
        for (int s = 0; s < 128; ++s) {
            const float w = wsm[s];
            const int id = __builtin_amdgcn_readfirstlane(widx[s]);
            const bf16* vp = V + (size_t)id * D + lane * 8;
#pragma unroll
            for (int c = 0; c < 4; ++c) { const u32x4v x = *(const u32x4v*)(vp + c * 512);
#pragma unroll
                for (int q = 0; q < 4; ++q) { acc[c][2 * q] = fmaf(w, bflo(x[q]), acc[c][2 * q]); acc[c][2 * q + 1] = fmaf(w, bfhi(x[q]), acc[c][2 * q + 1]); } } }
#pragma unroll
        for (int c = 0; c < 4; ++c) { float* yp = Y + (size_t)t * D + c * 512 + lane * 8;
            *(f32x4v*)yp = (f32x4v){acc[c][0], acc[c][1], acc[c][2], acc[c][3]}; *(f32x4v*)(yp + 4) = (f32x4v){acc[c][4], acc[c][5], acc[c][6], acc[c][7]}; }
        asm volatile("s_waitcnt lgkmcnt(0)" ::: "memory");
    }
}

enum { K_PRO = 0, K_MOD0, K_GEMM_IN, K_PREP, K_ATT_AB, K_ATT_C, K_ATT_CCTX, K_GEMM_OUT, K_LN1, K_GEMM_PQ, K_SEL1, K_SEL2, K_EXP, K_LN2, K_COUNT };

template <int KIND>
__device__ __forceinline__ void run_phase(const Params& p, const int l, unsigned char* lds) {
    unsigned char* ws = p.ws;
    bf16* const Hb = (bf16*)(ws + WS_H); bf16* const QKV = (bf16*)(ws + WS_QKV); bf16* const ATT = (bf16*)(ws + WS_ATT); bf16* const PQ = (bf16*)(ws + WS_PQ);
    float* const X = (float*)(ws + WS_X); float* const Y = (float*)(ws + WS_Y); const float* const MOD = (const float*)(ws + WS_MOD);
    const bool odd = l & 1, last = (l == DEPTH - 1); const int i2 = l >> 1;
    const int NQ = odd ? NQ_C : NQ_AB; const int MR = last ? TL : T;
    const float* modl = MOD + (size_t)l * 3 * NMOD;
    if constexpr (KIND == K_PRO) phase_prologue(p, lds);
    if constexpr (KIND == K_MOD0) phase_mod0(p);
    if constexpr (KIND == K_GEMM_IN) {
        const bf16* Wt = odd ? (const bf16*)(ws + WS_WIN_C) + (size_t)i2 * NQ_C * D : (const bf16*)(ws + WS_WIN_AB) + (size_t)i2 * NQ_AB * D;
        pg8::Gemm g{Hb, Wt, T, NQ, D}; pg8::StaticOrder S; S.init(T, NQ, (int)gridDim.x, (int)blockIdx.x);
        pg8::EpiBf16<0> E{QKV, NQ, nullptr, 0, 0};
        pg8::gemm_phase<pg8::EpiBf16<0>, pg8::StaticOrder, false>((PG8_LAS unsigned char*)lds, g, S, E, nullptr);
    }
    if constexpr (KIND == K_PREP) {
        if (odd) phase_prep(QKV, NQ_C, 20, 16, true, p.c_q_gain + i2 * HD, p.c_k_gain + i2 * HD, (const float*)(ws + WS_ROPE), T);
        else     phase_prep(QKV, NQ_AB, 10, 8, false, nullptr, nullptr, (const float*)(ws + WS_ROPE), TL);
    }
    if constexpr (KIND == K_ATT_AB) phase_attn_ab_naive(QKV, ATT, p.a_sink + i2 * 8, p.b_rpb + (size_t)i2 * 8 * 15 * 31, !last);
    if constexpr (KIND == K_ATT_C) phase_attn_c_dense(QKV, ATT, (char*)lds);
    if constexpr (KIND == K_ATT_CCTX) phase_attn_c_ctx_naive(QKV, ATT);
    if constexpr (KIND == K_GEMM_OUT) {
        const bf16* Wt = odd ? (const bf16*)(ws + WS_WOUT_C) + (size_t)i2 * D * D : (const bf16*)(ws + WS_WOUT_AB) + (size_t)i2 * D * D;
        pg8::Gemm g{ATT, Wt, MR, D, D}; pg8::StaticOrder S; S.init(MR, D, (int)gridDim.x, (int)blockIdx.x);
        pg8::EpiF32 E{Y, D, nullptr};
        pg8::gemm_phase<pg8::EpiF32, pg8::StaticOrder, false>((PG8_LAS unsigned char*)lds, g, S, E, nullptr);
    }
    if constexpr (KIND == K_LN1) {
        const float* xl = (l == 0) ? p.x : X; const float* xc = (l == 0) ? p.ctx : X + (size_t)TL * D;
        phase_ln(xl, xc, Y, modl, 2, p.ln_g + (size_t)(l * 2 + 0) * D, p.ln_b + (size_t)(l * 2 + 0) * D, X, X + (size_t)TL * D, Hb, modl, 3, 4, MR);
    }
    if constexpr (KIND == K_GEMM_PQ) {
        pg8::Gemm g{Hb, (const bf16*)(ws + WS_WPQ) + (size_t)l * D * D, MR, D, D}; pg8::StaticOrder S; S.init(MR, D, (int)gridDim.x, (int)blockIdx.x);
        pg8::EpiBf16<0> E{PQ, D, nullptr, 0, 0};
        pg8::gemm_phase<pg8::EpiBf16<0>, pg8::StaticOrder, false>((PG8_LAS unsigned char*)lds, g, S, E, nullptr);
    }
    if constexpr (KIND == K_SEL1) phase_sel1_naive(PQ, (const bf16*)(ws + WS_SK) + (size_t)l * 16 * 128 * 128, (float*)(ws + WS_TOPV), (int*)(ws + WS_TOPI), MR);
    if constexpr (KIND == K_SEL2) phase_sel2_naive((const float*)(ws + WS_TOPV), (const int*)(ws + WS_TOPI), (int*)(ws + WS_IDX), (float*)(ws + WS_GATE), MR);
    if constexpr (KIND == K_EXP) phase_experts(Hb, (const bf16*)(ws + WS_U) + (size_t)l * NE * D, (const bf16*)(ws + WS_V) + (size_t)l * NE * D, (const int*)(ws + WS_IDX), (const float*)(ws + WS_GATE), Y, MR, lds);
    if constexpr (KIND == K_LN2) {
        const float* modn = MOD + (size_t)(last ? l : l + 1) * 3 * NMOD;
        phase_ln(X, X + (size_t)TL * D, Y, modl, 5, p.ln_g + (size_t)(l * 2 + 1) * D, p.ln_b + (size_t)(l * 2 + 1) * D, last ? p.out : X, X + (size_t)TL * D,
                 last ? nullptr : Hb, modn, 0, 1, MR);
    }
}

template <int KIND>
__global__ void __launch_bounds__(512, 2) mk_phase(Params p, int l) {
    extern __shared__ __attribute__((aligned(16))) unsigned char lds[];
    run_phase<KIND>(p, l, lds);
}
}

template <int KIND> static void launch_phase(const mk::Params& p, int l, int grid, hipStream_t stream) {
    static bool attr = false;
    if (!attr) { (void)hipFuncSetAttribute((const void*)mk::mk_phase<KIND>, hipFuncAttributeMaxDynamicSharedMemorySize, mk::LDS_BYTES); attr = true; }
    hipLaunchKernelGGL(mk::mk_phase<KIND>, dim3(grid), dim3(512), mk::LDS_BYTES, stream, p, l);
}
extern "C" void kernel_launch(void* const* d_in, const int* in_sizes, int n_in, void* d_out, int out_size, void* d_ws, size_t ws_size, hipStream_t stream) {
    using namespace mk;
    static int grid = 0;
    if (grid == 0) {
        if (n_in != 20 || in_sizes[0] != TL * D || out_size != TL * D || ws_size < WS_END) {
            fprintf(stderr, "kernel_launch: unexpected shapes: n_in %d in0 %d out %d ws %zu (need %zu)\n", n_in, n_in > 0 ? in_sizes[0] : -1, out_size, ws_size, (size_t)WS_END); grid = -1; return; }
        int dev = 0, cus = 0;
        if (hipGetDevice(&dev) != hipSuccess || hipDeviceGetAttribute(&cus, hipDeviceAttributeMultiprocessorCount, dev) != hipSuccess) { grid = -1; return; }
        grid = cus;
    }
    if (grid < 0) return;
    (void)hipMemsetAsync((char*)d_ws + WS_CTL, 0, 16384, stream);
    Params p{};
    const float** pp = (const float**)&p;
    for (int i = 0; i < 20; ++i) pp[i] = (const float*)d_in[i];
    p.out = (float*)d_out; p.ws = (unsigned char*)d_ws; p.ph_lo = 0; p.ph_hi = 0;
    launch_phase<K_PRO>(p, 0, grid, stream);
    launch_phase<K_MOD0>(p, 0, grid, stream);
    for (int l = 0; l < DEPTH; ++l) {
        const bool odd = l & 1, last = (l == DEPTH - 1);
        launch_phase<K_GEMM_IN>(p, l, grid, stream);
        launch_phase<K_PREP>(p, l, grid, stream);
        if (odd) { launch_phase<K_ATT_C>(p, l, grid, stream); if (!last) launch_phase<K_ATT_CCTX>(p, l, grid, stream); }
        else launch_phase<K_ATT_AB>(p, l, grid, stream);
        launch_phase<K_GEMM_OUT>(p, l, grid, stream);
        launch_phase<K_LN1>(p, l, grid, stream);
        launch_phase<K_GEMM_PQ>(p, l, grid, stream);
        launch_phase<K_SEL1>(p, l, grid, stream);
        launch_phase<K_SEL2>(p, l, grid, stream);
        launch_phase<K_EXP>(p, l, grid, stream);
        launch_phase<K_LN2>(p, l, grid, stream);
    }
    const hipError_t le = hipPeekAtLastError();
    if (le != hipSuccess) fprintf(stderr, "kernel_launch: launch failed: %s\n", hipGetErrorName(le));
}
```

```cpp
#include <hip/hip_runtime.h>
#include <cstdio>
#include <cstdint>

#ifndef MK_NAIVE_AB
#define MK_NAIVE_AB 0
#endif
#ifndef MK_SD_C
#define MK_SD_C 1
#endif
#ifndef MK_NAIVE_SEL
#define MK_NAIVE_SEL 0
#endif
#ifndef MK_SLICED
#define MK_SLICED 1
#endif
#ifndef MK_ATT_FP8
#define MK_ATT_FP8 1
#endif
#ifndef MK_ATT_I
#define MK_ATT_I 1
#endif
#ifndef MK_ONE_LAUNCH
#define MK_ONE_LAUNCH 1
#endif

__device__ __forceinline__ int mk_ltid() { int t; asm volatile("v_mov_b32 %0, %1" : "=v"(t) : "v"((int)threadIdx.x)); return t; }
#define XB_TMO      128
#define XB_XCNT(j)  (256  + 64 * (j))
#define XB_XSUB(j)  (1280 + 64 * (j))
#define XB_XGEN(j)  (2304 + 64 * (j))
#define XB_TOP      3328
#define XB_TOPGEN   3392
#define XCD_BAR_WORDS 3456
#define XB_SPIN_CAP (1u << 22)
#define LAS __attribute__((address_space(3)))

__device__ __forceinline__ unsigned xb_ld(unsigned* p)              { return __hip_atomic_load(p, __ATOMIC_RELAXED, __HIP_MEMORY_SCOPE_AGENT); }
__device__ __forceinline__ unsigned xb_add(unsigned* p, unsigned v) { return __hip_atomic_fetch_add(p, v, __ATOMIC_RELAXED, __HIP_MEMORY_SCOPE_AGENT); }
__device__ __forceinline__ unsigned xb_xcc_id() { return (unsigned)__builtin_amdgcn_s_getreg((3 << 11) | 20) & 0xFu; }
#define XB_SPIN(cond, bar) do { unsigned _sp = 0; while (cond) { __builtin_amdgcn_s_sleep(1); \
    if ((++_sp & 255u) == 0u) { if (xb_ld(&(bar)[XB_TMO])) break; if (_sp > XB_SPIN_CAP) { atomicAdd(&(bar)[XB_TMO], 1u); break; } } } } while (0)

struct XcdBarrier {
    unsigned* bar; unsigned x;
    volatile LAS unsigned* st;
};

__device__ __forceinline__ XcdBarrier xcd_barrier_post(unsigned* bar, volatile LAS unsigned* st) {
    XcdBarrier b; b.bar = bar; b.x = xb_xcc_id(); b.st = st;
    if (threadIdx.x == 0) (void)xb_add(&bar[XB_XCNT(b.x)], 1u);
    return b;
}
__device__ __forceinline__ void xcd_barrier_complete(unsigned* bar, unsigned x, unsigned& nloc, unsigned& nx) {
    const unsigned G = gridDim.x * gridDim.y * gridDim.z;
    unsigned sum, cnt, mine, sp = 0u;
    for (;;) {
        sum = 0u; cnt = 0u; mine = 0u;
#pragma unroll
        for (unsigned j = 0; j < 16; ++j) { const unsigned c = xb_ld(&bar[XB_XCNT(j)]); sum += c; cnt += (c > 0u) ? 1u : 0u; mine = (j == x) ? c : mine; }
        if (sum == G) break;
        __builtin_amdgcn_s_sleep(1);
        if ((++sp & 255u) == 0u) { if (xb_ld(&bar[XB_TMO])) break; if (sp > XB_SPIN_CAP) { atomicAdd(&bar[XB_TMO], 1u); break; } }
    }
    nloc = mine > 0u ? mine : 1u; nx = cnt > 0u ? cnt : 1u;
}

__device__ __forceinline__ void xcd_barrier(const XcdBarrier& b) {
    asm volatile("s_waitcnt vmcnt(0)" ::: "memory");
    __syncthreads();
    if (threadIdx.x == 0) {
        unsigned* bar = b.bar; unsigned bx = b.x; asm volatile("" : "+s"(bar), "+s"(bx));
        __builtin_amdgcn_s_waitcnt(0);
        unsigned nloc = b.st[0], nx = b.st[1];
        if (nloc == 0u) { xcd_barrier_complete(bar, bx, nloc, nx); b.st[0] = nloc; b.st[1] = nx; }
        const unsigned old = xb_add(&bar[XB_XSUB(bx)], 1u);
        const unsigned gen = old / nloc;
        if (old + 1u == (gen + 1u) * nloc) {
            __builtin_amdgcn_fence(__ATOMIC_RELEASE, "agent");
            asm volatile("s_waitcnt vmcnt(0)" ::: "memory");
            const unsigned og = xb_add(&bar[XB_TOP], 1u);
            const unsigned tg = og / nx;
            if (og + 1u == (tg + 1u) * nx) xb_add(&bar[XB_TOPGEN], 1u);
            else XB_SPIN(xb_ld(&bar[XB_TOPGEN]) == tg, bar);
            __builtin_amdgcn_fence(__ATOMIC_ACQUIRE, "agent");
            xb_add(&bar[XB_XGEN(bx)], 1u);
            asm volatile("s_waitcnt vmcnt(0)" ::: "memory");
        } else {
            XB_SPIN(xb_ld(&bar[XB_XGEN(bx)]) == gen, bar);
            __builtin_amdgcn_fence(__ATOMIC_ACQUIRE, "agent");
            asm volatile("s_waitcnt vmcnt(0)" ::: "memory");
        }
    }
    __syncthreads();
}


namespace pg8 {
#define PG8_LAS __attribute__((address_space(3)))
typedef unsigned short bf16_t;
typedef short bf16x8 __attribute__((ext_vector_type(8)));
typedef float f32x4 __attribute__((ext_vector_type(4)));
typedef unsigned u32x4 __attribute__((ext_vector_type(4)));
typedef int i32x4 __attribute__((ext_vector_type(4)));
typedef int i32x8 __attribute__((ext_vector_type(8)));
constexpr int BM = 256, BK = 64, HALF = 128, HTB = HALF * BK * 2  , STAGE_BYTES = 8 * HTB, NXCD = 8, WGM = 8;

__host__ __device__ __forceinline__ int lds_byte(int r, int c) { const int st = (r >> 4) * 2 + (c >> 5), rr = r & 15, cc = c & 31, ob = rr * 64 + cc * 2; return st * 1024 + (ob ^ (((ob >> 9) & 1) << 5)); }
__host__ __device__ __forceinline__ void stage_rc(int b, int& R, int& C) { const int st = b / 1024, sb = b % 1024, swz = sb ^ (((sb >> 9) & 1) << 5); R = (st >> 1) * 16 + swz / 64; C = (st & 1) * 32 + (swz % 64) / 2; }
__host__ __device__ __forceinline__ int perm32(int rho) { const int n = rho >> 4, i = rho & 15; return 8 * (i >> 2) + 4 * n + (i & 3); }

struct Unit { int pm, pn; };
struct Gemm { const bf16_t* A; const bf16_t* Bt; int M, N, K; int sa, sb; };

struct StaticOrder {
    int nM, nN, nwg, G, c;
    __host__ __device__ void init(int M, int N, int G_, int c_) { nM = M / BM; nN = N / BM; nwg = nM * nN; G = G_; c = c_; }
    __host__ __device__ bool next(int i, Unit& u) const {
        const long L = (long)i * G + c; if (L >= nwg) return false;
        int wgid = (int)L; { const int q = nwg / NXCD, r = nwg % NXCD, xcd = wgid % NXCD, off = wgid / NXCD; wgid = (xcd < r ? xcd * (q + 1) : r * (q + 1) + (xcd - r) * q) + off; }
        const int nig = WGM * nN, gid = wgid / nig, fm = gid * WGM, gsz = (nM - fm) < WGM ? (nM - fm) : WGM;
        u.pm = fm + ((wgid % nig) % gsz); u.pn = (wgid % nig) / gsz; return true;
    }
    __device__ __forceinline__ void a_ready(const Unit&) const {}
    __device__ __forceinline__ void done(const Unit&) const {}
};
__device__ __forceinline__ unsigned cvt_pk_bf16(float lo, float hi) { unsigned r; asm volatile("v_cvt_pk_bf16_f32 %0, %1, %2" : "=v"(r) : "v"(lo), "v"(hi)); return r; }
typedef float f32x2 __attribute__((ext_vector_type(2)));
__device__ __forceinline__ f32x2 gelu_pk(f32x2 v) {
    const f32x2 av = __builtin_elementwise_abs(v), d = av * 0.2316418882f + 1.0f;
    f32x2 t; t.x = __builtin_amdgcn_rcpf(d.x); t.y = __builtin_amdgcn_rcpf(d.y);
    f32x2 q = t * 0.5307027145f + (-0.7265760135f); q = q * t + 0.7107068705f; q = q * t + (-0.142248368f); q = q * t + 0.127414796f; q = q * t;
    const f32x2 s = (v * v) * (-0.72134752044f);
    f32x2 e; e.x = __builtin_amdgcn_exp2f(s.x); e.y = __builtin_amdgcn_exp2f(s.y);
    const f32x2 m = v * (q * e), r = v - m;
    f32x2 o; o.x = v.x < 0.f ? m.x : r.x; o.y = v.y < 0.f ? m.y : r.y; return o;
}

struct EpiF32 {
    static constexpr bool PERM = false, AFTER_DRAIN = false;
    float* C; int ldc; const float* bias;
    __device__ __forceinline__ void operator()(const f32x4 (&acc)[2][2][4][2], const Unit& u, int wr, int wc, int fr, int fq) const {
        const int row0 = u.pm * BM + wr * 64 + fr, col0 = u.pn * BM + wc * 32 + 4 * fq;
        f32x4 bv[2][2];
#pragma unroll
        for (int bj = 0; bj < 2; ++bj)
#pragma unroll
            for (int n = 0; n < 2; ++n) bv[bj][n] = bias ? *(const f32x4*)(bias + col0 + bj * HALF + n * 16) : (f32x4){0.f, 0.f, 0.f, 0.f};
#pragma unroll
        for (int ai = 0; ai < 2; ++ai)
#pragma unroll
            for (int m = 0; m < 4; ++m) { float* rowp = C + (size_t)(row0 + ai * HALF + m * 16) * ldc + col0;
#pragma unroll
                for (int bj = 0; bj < 2; ++bj)
#pragma unroll
                    for (int n = 0; n < 2; ++n) *(f32x4*)(rowp + bj * HALF + n * 16) = acc[ai][bj][m][n] + bv[bj][n]; }
    }
};
template <int ACT  > struct EpiBf16 {
    static constexpr bool PERM = true, AFTER_DRAIN = false;
    bf16_t* O; int ldc; const float* bias; int split_cols; size_t split_stride;
    __device__ __forceinline__ void operator()(const f32x4 (&acc)[2][2][4][2], const Unit& u, int wr, int wc, int fr, int fq) const {
        const int row0 = u.pm * BM + wr * 64 + fr; int colt = u.pn * BM; bf16_t* base = O;
        if (split_cols) { const int t = colt / split_cols; base += (size_t)t * split_stride; colt -= t * split_cols; }
        const int col0 = colt + wc * 32 + 8 * fq, bcol0 = u.pn * BM + wc * 32 + 8 * fq;
        f32x4 bv[2][2];
#pragma unroll
        for (int bj = 0; bj < 2; ++bj)
#pragma unroll
            for (int n = 0; n < 2; ++n) bv[bj][n] = bias ? *(const f32x4*)(bias + bcol0 + bj * HALF + 4 * n) : (f32x4){0.f, 0.f, 0.f, 0.f};
#pragma unroll
        for (int ai = 0; ai < 2; ++ai)
#pragma unroll
            for (int m = 0; m < 4; ++m) { bf16_t* rowp = base + (size_t)(row0 + ai * HALF + m * 16) * ldc + col0;
#pragma unroll
                for (int bj = 0; bj < 2; ++bj) { f32x4 v0 = acc[ai][bj][m][0] + bv[bj][0], v1 = acc[ai][bj][m][1] + bv[bj][1];
                    if (ACT == 1) { f32x2 a = gelu_pk((f32x2){v0[0], v0[1]}), b = gelu_pk((f32x2){v0[2], v0[3]}), c = gelu_pk((f32x2){v1[0], v1[1]}), d = gelu_pk((f32x2){v1[2], v1[3]});
                        v0 = (f32x4){a.x, a.y, b.x, b.y}; v1 = (f32x4){c.x, c.y, d.x, d.y}; }
                    if (ACT == 2) {
#pragma unroll
                        for (int j = 0; j < 4; ++j) { v0[j] = 0.5f * v0[j] * (1.0f + erff(v0[j] * 0.70710678f)); v1[j] = 0.5f * v1[j] * (1.0f + erff(v1[j] * 0.70710678f)); } }
                    u32x4 w; w.x = cvt_pk_bf16(v0[0], v0[1]); w.y = cvt_pk_bf16(v0[2], v0[3]); w.z = cvt_pk_bf16(v1[0], v1[1]); w.w = cvt_pk_bf16(v1[2], v1[3]);
                    *(u32x4*)(rowp + bj * HALF) = w; } }
    }
};

struct EpiI8Bf16 {
    static constexpr bool PERM = true, AFTER_DRAIN = false;
    bf16_t* O; int ldc; const float* rs; const float* cs;
    __device__ __forceinline__ void operator()(const f32x4 (&acc)[2][2][4][2], const Unit& u, int wr, int wc, int fr, int fq) const {
        const int row0 = u.pm * BM + wr * 64 + fr, col0 = u.pn * BM + wc * 32 + 8 * fq;
        f32x4 cv[2][2];
#pragma unroll
        for (int bj = 0; bj < 2; ++bj)
#pragma unroll
            for (int n = 0; n < 2; ++n) cv[bj][n] = *(const f32x4*)(cs + col0 + bj * HALF + 4 * n);
#pragma unroll
        for (int ai = 0; ai < 2; ++ai)
#pragma unroll
            for (int m = 0; m < 4; ++m) { const int row = row0 + ai * HALF + m * 16; const float rsv = rs[row]; bf16_t* rowp = O + (size_t)row * ldc + col0;
#pragma unroll
                for (int bj = 0; bj < 2; ++bj) { const i32x4 i0 = *(const i32x4*)&acc[ai][bj][m][0], i1 = *(const i32x4*)&acc[ai][bj][m][1];
                    f32x4 v0, v1;
#pragma unroll
                    for (int j = 0; j < 4; ++j) { v0[j] = (float)i0[j] * rsv * cv[bj][0][j]; v1[j] = (float)i1[j] * rsv * cv[bj][1][j]; }
                    u32x4 w; w.x = cvt_pk_bf16(v0[0], v0[1]); w.y = cvt_pk_bf16(v0[2], v0[3]); w.z = cvt_pk_bf16(v1[0], v1[1]); w.w = cvt_pk_bf16(v1[2], v1[3]);
                    *(u32x4*)(rowp + bj * HALF) = w; } }
    }
};

template <class Epi, class Sched, bool STAMP = false, int QMODE = 0>
__device__ __forceinline__ void gemm_phase(PG8_LAS unsigned char* lds, const Gemm g, const Sched& S, const Epi& E, unsigned long long* stamps) {
    constexpr bool FP8 = (QMODE == 1), I8 = (QMODE == 2);
    const int tid = mk_ltid(), wid = __builtin_amdgcn_readfirstlane(tid >> 6), lane = tid & 63, wr = wid >> 2, wc = wid & 3, fr = lane & 15, fq = lane >> 4;
    const int K = g.K, nt = K / BK;
    int ts_lo = 0, ts_hi = 0, nts = 0; const unsigned long long rt_entry = STAMP ? (unsigned long long)wall_clock64() : 0ull;
#define PG8_STAMP() do { if (STAMP && wid == 0 && nts < 64) { const unsigned long long _c = (unsigned long long)clock64(); \
        ts_lo = (lane == nts) ? (int)(unsigned)_c : ts_lo; ts_hi = (lane == nts) ? (int)(unsigned)(_c >> 32) : ts_hi; ++nts; } } while (0)
    PG8_STAMP();
    unsigned voffA[2], voffB[2];
#pragma unroll
    for (int i = 0; i < 2; ++i) { int R, C; stage_rc(tid * 16 + i * 8192, R, C); const int Rb = Epi::PERM ? ((R & ~31) + perm32(R & 31)) : R;
        voffA[i] = (unsigned)(R * K + C) * 2u; voffB[i] = (unsigned)(Rb * K + C) * 2u; }
    const size_t kstep = (size_t)(BK * 2);
    const size_t hstep = (size_t)HALF * K * 2;
    const size_t tstep = 2 * hstep;
    const unsigned ldsw = (unsigned)wid * 1024u;
    const int aoff = FP8 ? lds_byte(wr * 64 + fr, (fq >> 1) * 32 + (fq & 1) * 16) : lds_byte(wr * 64 + fr, fq * 8), boff = FP8 ? lds_byte(wc * 32 + fr, (fq >> 1) * 32 + (fq & 1) * 16) : lds_byte(wc * 32 + fr, fq * 8);
    constexpr int KST = FP8 ? 16 : 1024;
#define PG8_SA(b, h) (((b) * 2 + (h)) * HTB)
#define PG8_SB(b, h) ((4 + (b) * 2 + (h)) * HTB)
#define PG8_STAGE(bufoff, gbase, voff) do { _Pragma("unroll") for (int _i = 0; _i < 2; ++_i) \
        __builtin_amdgcn_global_load_lds((const unsigned*)((const char*)(gbase) + (voff)[_i]), (PG8_LAS unsigned*)(lds + (bufoff) + ldsw + _i * 8192), 16, 0, 0); } while (0)
#define PG8_LDA(dst, b, h) do { if constexpr (FP8) { _Pragma("unroll") for (int m = 0; m < 4; ++m) { const i32x4 lo_ = *(const PG8_LAS i32x4*)(lds + PG8_SA(b, h) + aoff + m * 2048), hi_ = *(const PG8_LAS i32x4*)(lds + PG8_SA(b, h) + aoff + m * 2048 + 16); \
        dst##8[m] = __builtin_shufflevector(lo_, hi_, 0, 1, 2, 3, 4, 5, 6, 7); } } \
    else { _Pragma("unroll") for (int m = 0; m < 4; ++m) _Pragma("unroll") for (int k = 0; k < 2; ++k) dst[m][k] = *(const PG8_LAS bf16x8*)(lds + PG8_SA(b, h) + aoff + m * 2048 + k * KST); } } while (0)
#define PG8_LDB(dst, b, h) do { if constexpr (FP8) { _Pragma("unroll") for (int n = 0; n < 2; ++n) { const i32x4 lo_ = *(const PG8_LAS i32x4*)(lds + PG8_SB(b, h) + boff + n * 2048), hi_ = *(const PG8_LAS i32x4*)(lds + PG8_SB(b, h) + boff + n * 2048 + 16); \
        dst##8[n] = __builtin_shufflevector(lo_, hi_, 0, 1, 2, 3, 4, 5, 6, 7); } } \
    else { _Pragma("unroll") for (int n = 0; n < 2; ++n) _Pragma("unroll") for (int k = 0; k < 2; ++k) dst[n][k] = *(const PG8_LAS bf16x8*)(lds + PG8_SB(b, h) + boff + n * 2048 + k * KST); } } while (0)
#define PG8_MMA(ai, bj, At, Bt) do { __builtin_amdgcn_s_setprio(1); \
    if constexpr (FP8) { _Pragma("unroll") for (int m = 0; m < 4; ++m) _Pragma("unroll") for (int n = 0; n < 2; ++n) \
        asm volatile("v_mfma_scale_f32_16x16x128_f8f6f4 %0, %1, %2, %0, %3, %4 op_sel_hi:[0,0,0]" : "+v"(acc[ai][bj][m][n]) : "v"(Bt##8[n]), "v"(At##8[m]), "v"(vsb), "v"(vsa)); } \
    else if constexpr (I8) { _Pragma("unroll") for (int m = 0; m < 4; ++m) _Pragma("unroll") for (int n = 0; n < 2; ++n) _Pragma("unroll") for (int k = 0; k < 2; ++k) { \
        const i32x4 r_ = __builtin_amdgcn_mfma_i32_16x16x64_i8(*(const i32x4*)&Bt[n][k], *(const i32x4*)&At[m][k], *(const i32x4*)&acc[ai][bj][m][n], 0, 0, 0); acc[ai][bj][m][n] = *(const f32x4*)&r_; } } \
    else { _Pragma("unroll") for (int m = 0; m < 4; ++m) _Pragma("unroll") for (int n = 0; n < 2; ++n) _Pragma("unroll") for (int k = 0; k < 2; ++k) \
        acc[ai][bj][m][n] = __builtin_amdgcn_mfma_f32_16x16x32_bf16(Bt[n][k], At[m][k], acc[ai][bj][m][n], 0, 0, 0); } \
    __builtin_amdgcn_s_setprio(0); } while (0)
#define PG8_WAIT_V(n) asm volatile("s_waitcnt vmcnt(" #n ")" ::: "memory")
#define PG8_WAIT_L(n) asm volatile("s_waitcnt lgkmcnt(" #n ")" ::: "memory")
#define PG8_BAR __builtin_amdgcn_s_barrier()
#define PG8_SCHED __builtin_amdgcn_sched_barrier(0)
    Unit cur, nxt; int ui = 0;
    if (!S.next(0, cur)) return;
    f32x4 acc[2][2][4][2];
#pragma unroll
    for (int a = 0; a < 2; ++a)
#pragma unroll
        for (int b = 0; b < 2; ++b)
#pragma unroll
            for (int m = 0; m < 4; ++m)
#pragma unroll
                for (int n = 0; n < 2; ++n) acc[a][b][m][n] = (f32x4){0.f, 0.f, 0.f, 0.f};
    const int vsa = g.sa, vsb = g.sb;
    bf16x8 At[4][2], B0[2][2], B1[2][2];
    i32x8 At8[4], B08[2], B18[2];
    const char* cA = (const char*)g.A + (size_t)cur.pm * tstep; const char* cB = (const char*)g.Bt + (size_t)cur.pn * tstep;
    S.a_ready(cur);
    PG8_STAGE(PG8_SB(0, 0), cB, voffB); PG8_STAGE(PG8_SA(0, 0), cA, voffA); PG8_STAGE(PG8_SB(0, 1), cB + hstep, voffB); PG8_STAGE(PG8_SA(0, 1), cA + hstep, voffA);
    if (wr == 1) PG8_BAR;
    PG8_WAIT_V(4); PG8_BAR;
    PG8_STAGE(PG8_SB(1, 0), cB + kstep, voffB); PG8_STAGE(PG8_SA(1, 0), cA + kstep, voffA); PG8_STAGE(PG8_SB(1, 1), cB + hstep + kstep, voffB);
    PG8_WAIT_V(6); PG8_BAR;
    PG8_STAMP();
    for (;;) {
        const bool has_next = S.next(ui + 1, nxt);
        const char* nA = has_next ? (const char*)g.A + (size_t)nxt.pm * tstep : cA; const char* nB = has_next ? (const char*)g.Bt + (size_t)nxt.pn * tstep : cB;
        for (int t = 0; t < nt; t += 2) {
            const bool last = (t == nt - 2);
            const char* a1 = cA + (size_t)(t + 1) * kstep;
            const char* a2 = last ? nA : cA + (size_t)(t + 2) * kstep; const char* b2 = last ? nB : cB + (size_t)(t + 2) * kstep;
            const char* a3 = a2 + kstep; const char* b3 = b2 + kstep;
            if (last && has_next) S.a_ready(nxt);
            PG8_LDB(B0, 0, 0); PG8_SCHED; PG8_LDA(At, 0, 0); PG8_STAGE(PG8_SA(1, 1), a1 + hstep, voffA);
            PG8_WAIT_L(8); PG8_BAR; PG8_WAIT_L(0); PG8_MMA(0, 0, At, B0); PG8_BAR; PG8_SCHED;
            PG8_LDB(B1, 0, 1); PG8_STAGE(PG8_SB(0, 0), b2, voffB);
            PG8_BAR; PG8_WAIT_L(0); PG8_MMA(0, 1, At, B1); PG8_BAR;
            PG8_LDA(At, 0, 1); PG8_STAGE(PG8_SA(0, 0), a2, voffA);
            PG8_BAR; PG8_WAIT_L(0); PG8_MMA(1, 0, At, B0); PG8_BAR; PG8_SCHED;
            PG8_STAGE(PG8_SB(0, 1), b2 + hstep, voffB);
            PG8_WAIT_V(6); PG8_BAR; PG8_MMA(1, 1, At, B1); PG8_BAR;
            PG8_LDB(B0, 1, 0); PG8_SCHED; PG8_LDA(At, 1, 0); PG8_STAGE(PG8_SA(0, 1), a2 + hstep, voffA);
            PG8_WAIT_L(8); PG8_BAR; PG8_WAIT_L(0); PG8_MMA(0, 0, At, B0); PG8_BAR; PG8_SCHED;
            PG8_LDB(B1, 1, 1); PG8_STAGE(PG8_SB(1, 0), b3, voffB);
            PG8_BAR; PG8_WAIT_L(0); PG8_MMA(0, 1, At, B1); PG8_BAR;
            PG8_LDA(At, 1, 1); PG8_STAGE(PG8_SA(1, 0), a3, voffA);
            PG8_BAR; PG8_WAIT_L(0); PG8_MMA(1, 0, At, B0); PG8_BAR; PG8_SCHED;
            PG8_STAGE(PG8_SB(1, 1), b3 + hstep, voffB);
            PG8_WAIT_V(6); PG8_BAR; PG8_MMA(1, 1, At, B1); PG8_BAR;
        }
        PG8_STAMP();
        if constexpr (FP8) asm volatile("s_nop 15\n\ts_nop 15" ::: "memory");
        if constexpr (!Epi::AFTER_DRAIN) { E(acc, cur, wr, wc, fr, fq); S.done(cur); }
        PG8_STAMP();
        if (!has_next) break;
#pragma unroll
        for (int a = 0; a < 2; ++a)
#pragma unroll
            for (int b = 0; b < 2; ++b)
#pragma unroll
                for (int m = 0; m < 4; ++m)
#pragma unroll
                    for (int n = 0; n < 2; ++n) acc[a][b][m][n] = (f32x4){0.f, 0.f, 0.f, 0.f};
        cur = nxt; cA = nA; cB = nB; ++ui;
    }
    PG8_WAIT_V(0);
    if (wr == 0) PG8_BAR;
    PG8_BAR;
    if constexpr (Epi::AFTER_DRAIN) { E.fused(acc, cur, wr, wc, fr, fq, lds, wid, lane); S.done(cur); }
    PG8_STAMP();
    if (STAMP && wid == 0) { stamps[lane] = lane < nts ? (((unsigned long long)(unsigned)ts_hi << 32) | (unsigned)ts_lo) : 0ull;
        if (lane == 62) stamps[62] = rt_entry; if (lane == 63) stamps[63] = (unsigned long long)wall_clock64(); }
#undef PG8_STAMP
#undef PG8_SA
#undef PG8_SB
#undef PG8_STAGE
#undef PG8_LDA
#undef PG8_LDB
#undef PG8_MMA
#undef PG8_WAIT_V
#undef PG8_WAIT_L
#undef PG8_BAR
#undef PG8_SCHED
}
}

namespace att {
typedef unsigned short bf16;
constexpr int   D = 128, NW = 8, QBLK = 32, KVBLK = 64;
constexpr float SCALE = 0.088388347648318440f;
constexpr float THR = 8.f;
constexpr int SDEPTH = 2;
constexpr size_t SHM_V = KVBLK * D * 2, SHM_K = KVBLK * D * 2, SHM_ATTN = 2 * SHM_V + 2 * SHM_K + NW * 64 * 4;
using bf16x8 = __attribute__((ext_vector_type(8))) short;
using s16x4  = __attribute__((ext_vector_type(4))) short;
using f32x16 = __attribute__((ext_vector_type(16))) float;
using u32x4  = __attribute__((ext_vector_type(4))) unsigned;
#define KSWZ(row, colB) ((row) * 256 + ((colB) ^ (((row) & 7) << 4)))
#define SBAR() __builtin_amdgcn_sched_barrier(0)
__device__ __forceinline__ int crow(int r, int hi) { return (r & 3) + 8 * (r >> 2) + 4 * hi; }
__device__ __forceinline__ unsigned cvtpk(float lo, float hi) {
  unsigned r; asm volatile("v_cvt_pk_bf16_f32 %0, %1, %2" : "=v"(r) : "v"(lo), "v"(hi)); return r;
}
__device__ __forceinline__ bf16x8 ld8(const bf16* p) { return *reinterpret_cast<const bf16x8*>(p); }

__device__ __forceinline__ void partialSM(f32x16& p0, f32x16& p1, float& m_reg, float& mn, float& alpha) {
  constexpr float C = SCALE * 1.4426950408889634f;
  float pmax = p0[0]; for (int r = 1; r < 16; ++r) pmax = fmaxf(pmax, p0[r]); for (int r = 0; r < 16; ++r) pmax = fmaxf(pmax, p1[r]);
  { auto rr = __builtin_amdgcn_permlane32_swap(__float_as_uint(pmax), __float_as_uint(pmax), false, false);
    pmax = fmaxf(__uint_as_float(rr[0]), __uint_as_float(rr[1])); }
  if (__builtin_expect(__all(pmax - m_reg <= THR / SCALE), 1)) { mn = m_reg; alpha = 1.f; }
  else { mn = fmaxf(m_reg, pmax); alpha = __builtin_amdgcn_exp2f((m_reg - mn) * C); m_reg = mn; }
  float mnC = -mn * C;
  for (int r = 0; r < 16; ++r) p0[r] = fmaf(p0[r], C, mnC); for (int r = 0; r < 16; ++r) p1[r] = fmaf(p1[r], C, mnC);
  for (int r = 0; r < 16; ++r) p0[r] = __builtin_amdgcn_exp2f(p0[r]);
}
__device__ __forceinline__ void finishSM(f32x16& p0, f32x16& p1, float alpha, float& l_reg, bf16x8& pa0, bf16x8& pa1, bf16x8& pa2, bf16x8& pa3) {
  for (int r = 0; r < 16; ++r) p1[r] = __builtin_amdgcn_exp2f(p1[r]);
  float ps = 0; for (int r = 0; r < 16; ++r) ps += p0[r]; for (int r = 0; r < 16; ++r) ps += p1[r];
  { auto rr = __builtin_amdgcn_permlane32_swap(__float_as_uint(ps), __float_as_uint(ps), false, false);
    ps = __uint_as_float(rr[0]) + __uint_as_float(rr[1]); }
  l_reg = l_reg * alpha + ps;
#define PK4(P, BASE, OUT) do { unsigned a0 = cvtpk(P[BASE + 0], P[BASE + 1]), a1 = cvtpk(P[BASE + 2], P[BASE + 3]);   \
    unsigned b0 = cvtpk(P[BASE + 4], P[BASE + 5]), b1 = cvtpk(P[BASE + 6], P[BASE + 7]);                              \
    auto r0 = __builtin_amdgcn_permlane32_swap(a0, b0, false, false); auto r1 = __builtin_amdgcn_permlane32_swap(a1, b1, false, false); \
    u32x4 w = {r0[0], r1[0], r0[1], r1[1]}; OUT = *reinterpret_cast<bf16x8*>(&w); } while (0)
  PK4(p0, 0, pa0); PK4(p0, 8, pa1); PK4(p1, 0, pa2); PK4(p1, 8, pa3);
#undef PK4
}
__device__ __forceinline__ void qkt(f32x16& p0, f32x16& p1, const bf16* Ks, const bf16x8* qr, int r32, int hi) {
  p0 = f32x16{}; p1 = f32x16{};
  for (int d0 = 0; d0 < 8; ++d0) { int cb = (d0 * 16 + hi * 8) * 2;
    bf16x8 b0 = *reinterpret_cast<const bf16x8*>((const char*)Ks + KSWZ(r32, cb));
    bf16x8 b1 = *reinterpret_cast<const bf16x8*>((const char*)Ks + KSWZ(32 + r32, cb));
    p0 = __builtin_amdgcn_mfma_f32_32x32x16_bf16(b0, qr[d0], p0, 0, 0, 0);
    p1 = __builtin_amdgcn_mfma_f32_32x32x16_bf16(b1, qr[d0], p1, 0, 0, 0); }
}
__device__ __forceinline__ int v_st(int k, int c) { const int kk = (k & ~0xC) | ((k & 4) << 1) | ((k & 8) >> 1); return ((kk >> 3) * 4 + (c >> 5)) * 512 + ((kk & 7) * 32 + (c & 31)) * 2; }
__device__ __forceinline__ int v_rd_base(int lane) { return ((lane & 3) << 3) | (((lane >> 2) & 3) << 6) | (((lane >> 4) & 1) << 5) | (((lane >> 5) & 1) << 8); }
constexpr int v_rd_off(int d0, int ks, int half) { return d0 * 512 + ks * 4096 + half * 2048; }
template <int OFF> __device__ __forceinline__ s16x4 tr_read(int vb) {
  s16x4 r; asm volatile("ds_read_b64_tr_b16 %0, %1 offset:%2" : "=&v"(r) : "v"(vb), "i"(OFF) : "memory"); return r;
}
template <int D0> __device__ __forceinline__ void pv_one(f32x16& od, int vb, bf16x8 pa0, bf16x8 pa1, bf16x8 pa2, bf16x8 pa3) {
  const s16x4 l0 = tr_read<v_rd_off(D0, 0, 0)>(vb), h0 = tr_read<v_rd_off(D0, 0, 1)>(vb), l1 = tr_read<v_rd_off(D0, 1, 0)>(vb), h1 = tr_read<v_rd_off(D0, 1, 1)>(vb);
  const s16x4 l2 = tr_read<v_rd_off(D0, 2, 0)>(vb), h2 = tr_read<v_rd_off(D0, 2, 1)>(vb), l3 = tr_read<v_rd_off(D0, 3, 0)>(vb), h3 = tr_read<v_rd_off(D0, 3, 1)>(vb);
  asm volatile("s_waitcnt lgkmcnt(0)" ::: "memory"); SBAR();
#define PK(L, H) (bf16x8){L[0], L[1], L[2], L[3], H[0], H[1], H[2], H[3]}
  od = __builtin_amdgcn_mfma_f32_32x32x16_bf16(pa0, PK(l0, h0), od, 0, 0, 0);
  od = __builtin_amdgcn_mfma_f32_32x32x16_bf16(pa1, PK(l1, h1), od, 0, 0, 0);
  od = __builtin_amdgcn_mfma_f32_32x32x16_bf16(pa2, PK(l2, h2), od, 0, 0, 0);
  od = __builtin_amdgcn_mfma_f32_32x32x16_bf16(pa3, PK(l3, h3), od, 0, 0, 0);
#undef PK
}
__device__ __forceinline__ void pv_d0(f32x16* o, int vb, bf16x8 pa0, bf16x8 pa1, bf16x8 pa2, bf16x8 pa3) {
  pv_one<0>(o[0], vb, pa0, pa1, pa2, pa3); pv_one<1>(o[1], vb, pa0, pa1, pa2, pa3); pv_one<2>(o[2], vb, pa0, pa1, pa2, pa3); pv_one<3>(o[3], vb, pa0, pa1, pa2, pa3);
}

struct MaskArgs { int kpos0, qpos0, krow0, qrow0; const float* bt; float sink; bool has_sink; };
struct QPrep { const float* qg; const float* rope; int qp0; bool norm, dorope; };
__device__ __forceinline__ void q_prepare(bf16x8 (&qr)[8], const QPrep qp, int rowpos, int hi) {
  if (!qp.norm && !qp.dorope) return;
  float x[8][8];
#pragma unroll
  for (int d0 = 0; d0 < 8; ++d0) { const u32x4 w = *reinterpret_cast<const u32x4*>(&qr[d0]);
#pragma unroll
    for (int e = 0; e < 4; ++e) { x[d0][2 * e] = __uint_as_float(w[e] << 16); x[d0][2 * e + 1] = __uint_as_float(w[e] & 0xffff0000u); } }
  if (qp.norm) {
    float ss = 0.f;
#pragma unroll
    for (int d0 = 0; d0 < 8; ++d0)
#pragma unroll
      for (int e = 0; e < 8; ++e) ss += x[d0][e] * x[d0][e];
    { auto rr = __builtin_amdgcn_permlane32_swap(__float_as_uint(ss), __float_as_uint(ss), false, false); ss = __uint_as_float(rr[0]) + __uint_as_float(rr[1]); }
    const float r = rsqrtf(ss * (1.f / 128.f) + 1e-6f);
#pragma unroll
    for (int d0 = 0; d0 < 8; ++d0) { const float* g = qp.qg + d0 * 16 + hi * 8;
#pragma unroll
      for (int e = 0; e < 8; ++e) x[d0][e] = x[d0][e] * r * g[e]; }
  }
  if (qp.dorope) {
    const int prow = rowpos >> 6, pcol = rowpos & 63;
#pragma unroll
    for (int dd = 0; dd < 2; ++dd) {
      const float* cr = qp.rope + prow * 32 + dd * 16 + hi * 8; const float* sr = cr + 128 * 32;
      const float* cc = qp.rope + pcol * 32 + dd * 16 + hi * 8; const float* sc = cc + 128 * 32;
#pragma unroll
      for (int e = 0; e < 8; ++e) {
        const float a = x[dd][e], b = x[2 + dd][e], c = x[4 + dd][e], d = x[6 + dd][e];
        x[dd][e] = a * cr[e] - b * sr[e]; x[2 + dd][e] = b * cr[e] + a * sr[e];
        x[4 + dd][e] = c * cc[e] - d * sc[e]; x[6 + dd][e] = d * cc[e] + c * sc[e]; } }
  }
#pragma unroll
  for (int d0 = 0; d0 < 8; ++d0) { u32x4 w;
#pragma unroll
    for (int e = 0; e < 4; ++e) w[e] = cvtpk(x[d0][2 * e], x[d0][2 * e + 1]);
    qr[d0] = *reinterpret_cast<bf16x8*>(&w); }
}

template <int MODE, int SDEPTH, int LDQ, int LDK, int LDO>
__device__ __forceinline__ void attn_body(const bf16* __restrict__ Qb, const bf16* __restrict__ Kc, const bf16* __restrict__ Kl, int voff, int nct,
                                          unsigned char* __restrict__ Ob, int NT, char* lds, const MaskArgs ma, const QPrep qp) {
  const int tid = mk_ltid(), wid = tid >> 6, lane = tid & 63, r32 = lane & 31, hi = lane >> 5;
  bf16* V_lds = (bf16*)lds; bf16* K_lds = (bf16*)(lds + 2 * SHM_V);
  float* ws = (float*)(lds + 2 * SHM_V + 2 * SHM_K) + wid * 64; float* li_l = ws; float* al_l = ws + 32;
  float m_reg = -1e30f, l_reg = 0; f32x16 o[4] = {}; bf16x8 qr[8];
  const bf16* Qw = Qb + (long)(wid * QBLK + r32) * LDQ + hi * 8;
#pragma unroll
  for (int d0 = 0; d0 < 8; ++d0) qr[d0] = ld8(Qw + d0 * 16);
  q_prepare(qr, qp, qp.qp0 + wid * QBLK + r32, hi);
  const int sr = tid >> 4, sc = (tid & 15) * 8, vst0 = v_st(sr, sc), vst1 = v_st(32 + sr, sc);
  const int vb0 = (int)(uintptr_t)V_lds + v_rd_base(lane);
  struct { bf16x8 vs0, vs1, ks0, ks1; } sr_[SDEPTH];
  const int mA = ma.kpos0 - ma.qpos0 - wid * 32 - r32 + 128 + 4 * hi;
  const int mrow = ma.qrow0 + (wid >> 1), mcol = (wid & 1) * 32 + r32;
  const int mrs = min(max(mrow - 4, 0), 120), mws = min(max(mcol - 8, 0), 48);
#define CC(r) (((r) & 3) + 8 * ((r) >> 2))
#define MASK(P0, P1, t) do { \
    if constexpr (MODE == 1) { if ((t) >= nct) { const int bd_ = mA + ((t) - nct) * 64; \
        _Pragma("unroll") for (int r_ = 0; r_ < 16; ++r_) { const unsigned u0_ = (unsigned)(bd_ + CC(r_)); P0[r_] = (u0_ <= 256u) ? P0[r_] : -1e30f; P1[r_] = (u0_ + 32u <= 256u) ? P1[r_] : -1e30f; } } } \
    if constexpr (MODE == 2) { if ((t) >= nct) { const int kr_ = ma.krow0 + ((t) - nct); \
        if (kr_ < mrs || kr_ >= mrs + 8) { _Pragma("unroll") for (int r_ = 0; r_ < 16; ++r_) { P0[r_] = -1e30f; P1[r_] = -1e30f; } } \
        else { const float* bt_ = ma.bt + (kr_ - mrow + 7) * 32; const int kb_ = 4 * hi - mws, db_ = 4 * hi - mcol + 15; \
          _Pragma("unroll") for (int r_ = 0; r_ < 16; ++r_) { \
            const float b0_ = bt_[min(max(db_ + CC(r_), 0), 30)], b1_ = bt_[min(max(db_ + CC(r_) + 32, 0), 30)]; \
            P0[r_] = ((unsigned)(kb_ + CC(r_)) < 16u) ? P0[r_] + b0_ : -1e30f; P1[r_] = ((unsigned)(kb_ + CC(r_) + 32) < 16u) ? P1[r_] + b1_ : -1e30f; \
            if ((r_ & 3) == 3) SBAR(); } } } } \
  } while (0)
#define TBASE(t) (((t) < nct) ? (Kc + (long)(t) * KVBLK * LDK) : (Kl + (long)((t) - nct) * KVBLK * LDK))
#define SLOAD(i, t) do { const bf16* kb_ = TBASE(t); sr_[i].vs0 = ld8(&kb_[(long)(sr) * LDK + sc + voff]); sr_[i].vs1 = ld8(&kb_[(long)(32 + sr) * LDK + sc + voff]); \
    sr_[i].ks0 = ld8(&kb_[(long)(sr) * LDK + sc]); sr_[i].ks1 = ld8(&kb_[(long)(32 + sr) * LDK + sc]); } while (0)
#define SWRITE(b, i) do { *(bf16x8*)((char*)V_lds + (b) * SHM_V + vst0) = sr_[i].vs0;          \
    *(bf16x8*)((char*)V_lds + (b) * SHM_V + vst1) = sr_[i].vs1; int kc = sc * 2;               \
    *(bf16x8*)((char*)K_lds + (b) * SHM_K + KSWZ(sr, kc)) = sr_[i].ks0;                       \
    *(bf16x8*)((char*)K_lds + (b) * SHM_K + KSWZ(32 + sr, kc)) = sr_[i].ks1; } while (0)
#define SWAIT() do { if constexpr (SDEPTH == 2) asm volatile("s_waitcnt vmcnt(4)" ::: "memory"); else asm volatile("s_waitcnt vmcnt(0)" ::: "memory"); } while (0)
#define RESC(a) do { if (__any((a) < 1.f)) { if (hi == 0) al_l[r32] = (a); asm volatile("s_waitcnt lgkmcnt(0)" ::: "memory"); \
    for (int d = 0; d < 4; ++d) for (int r = 0; r < 16; ++r) o[d][r] *= al_l[crow(r, hi)]; } } while (0)
  f32x16 pA0, pA1, pB0, pB1; float mnA, mnB, alA, alB; bf16x8 pa0, pa1, pa2, pa3;
  constexpr int SE = 0, SO = SDEPTH - 1;
  SLOAD(SE, 0); asm volatile("s_waitcnt vmcnt(0)" ::: "memory"); SWRITE(0, SE); __syncthreads();
  qkt(pA0, pA1, K_lds, qr, r32, hi); MASK(pA0, pA1, 0); partialSM(pA0, pA1, m_reg, mnA, alA);
  SLOAD(SO, 1); if constexpr (SDEPTH == 2) { if (2 < NT) SLOAD(SE, 2); }
  SWAIT(); SWRITE(1, SO); __syncthreads();
  for (int j = 1; j + 1 < NT; j += 2) {
    SBAR(); qkt(pB0, pB1, (bf16*)((char*)K_lds + SHM_K), qr, r32, hi);
    finishSM(pA0, pA1, alA, l_reg, pa0, pa1, pa2, pa3); SBAR();
    SLOAD(SO, (j + SDEPTH)); SBAR();
    pv_d0(o, vb0, pa0, pa1, pa2, pa3); MASK(pB0, pB1, j); partialSM(pB0, pB1, m_reg, mnB, alB);
    __syncthreads(); SWAIT(); SWRITE(0, SE);
    RESC(alB); __syncthreads();
    SBAR(); qkt(pA0, pA1, K_lds, qr, r32, hi);
    finishSM(pB0, pB1, alB, l_reg, pa0, pa1, pa2, pa3); SBAR();
    if (SDEPTH == 1 || j + 3 < NT) SLOAD(SE, (j + 1 + SDEPTH)); SBAR();
    pv_d0(o, vb0 + (int)SHM_V, pa0, pa1, pa2, pa3); MASK(pA0, pA1, j + 1); partialSM(pA0, pA1, m_reg, mnA, alA);
    __syncthreads(); SWAIT(); SWRITE(1, SO);
    RESC(alA); __syncthreads();
  }
  SBAR(); qkt(pB0, pB1, (bf16*)((char*)K_lds + SHM_K), qr, r32, hi);
  finishSM(pA0, pA1, alA, l_reg, pa0, pa1, pa2, pa3); SBAR();
  pv_d0(o, vb0, pa0, pa1, pa2, pa3); MASK(pB0, pB1, NT - 1); partialSM(pB0, pB1, m_reg, mnB, alB);
  __syncthreads(); RESC(alB);
  finishSM(pB0, pB1, alB, l_reg, pa0, pa1, pa2, pa3); SBAR();
  pv_d0(o, vb0 + (int)SHM_V, pa0, pa1, pa2, pa3);
  if (ma.has_sink) l_reg += __builtin_amdgcn_exp2f(ma.sink * 1.4426950408889634f - m_reg * (SCALE * 1.4426950408889634f));
  if (hi == 0) li_l[r32] = l_reg; asm volatile("s_waitcnt lgkmcnt(0)" ::: "memory");
  float rli[16];
#pragma unroll
  for (int r = 0; r < 16; ++r) rli[r] = __builtin_amdgcn_rcpf(li_l[crow(r, hi)]);
  unsigned char* Ow = Ob + (long)(wid * QBLK) * LDO;
#pragma unroll
  for (int r = 0; r < 16; ++r) { int orow = crow(r, hi);
#pragma unroll
    for (int d0 = 0; d0 < 4; d0 += 1) { const float f = o[d0][r] * rli[r] * 32.f;
      Ow[(long)orow * LDO + d0 * 32 + r32] = (unsigned char)((unsigned)__builtin_amdgcn_cvt_pk_fp8_f32(f, f, 0, false) & 0xffu); } }
#undef CC
#undef MASK
#undef TBASE
#undef SLOAD
#undef SWRITE
#undef SWAIT
#undef RESC
}

template <int MODE, int LDQ, int LDK, int LDO>
__device__ __forceinline__ void attn_body_simple(const bf16* __restrict__ Qb, const bf16* __restrict__ Kc, const bf16* __restrict__ Kl, int voff, int nct,
                                                 unsigned char* __restrict__ Ob, int NT, char* lds, const MaskArgs ma, const QPrep qp) {
  const int tid = mk_ltid(), wid = __builtin_amdgcn_readfirstlane(tid >> 6), lane = tid & 63, r32 = lane & 31, hi = lane >> 5;
  bf16* V_lds = (bf16*)lds; bf16* K_lds = (bf16*)(lds + 2 * SHM_V);
  float* ws = (float*)(lds + 2 * SHM_V + 2 * SHM_K) + wid * 64; float* li_l = ws; float* al_l = ws + 32;
  float m_reg = -1e30f, l_reg = 0; f32x16 o[4] = {}; bf16x8 qr[8];
  const bf16* Qw = Qb + (long)(wid * QBLK + r32) * LDQ + hi * 8;
#pragma unroll
  for (int d0 = 0; d0 < 8; ++d0) qr[d0] = ld8(Qw + d0 * 16);
  q_prepare(qr, qp, qp.qp0 + wid * QBLK + r32, hi);
  const int sr = tid >> 4, sc = (tid & 15) * 8, vst0 = v_st(sr, sc), vst1 = v_st(32 + sr, sc);
  const int vb0 = (int)(uintptr_t)V_lds + v_rd_base(lane);
  bf16x8 vs0, vs1, ks0, ks1;
  const int mA = ma.kpos0 - ma.qpos0 - wid * 32 - r32 + 128 + 4 * hi;
  const int mA0 = ma.kpos0 - ma.qpos0 - wid * 32;
  const int mrow = ma.qrow0 + (wid >> 1), mcol = (wid & 1) * 32 + r32;
  const int mrs = min(max(mrow - 4, 0), 120), mws = min(max(mcol - 8, 0), 48);
#define CC(r) (((r) & 3) + 8 * ((r) >> 2))
#define TBASE(t) (((t) < nct) ? (Kc + (long)(t) * KVBLK * LDK) : (Kl + (long)((t) - nct) * KVBLK * LDK))
#define SLOAD(t) do { const bf16* kb_ = TBASE(t); vs0 = ld8(&kb_[(long)(sr) * LDK + sc + voff]); vs1 = ld8(&kb_[(long)(32 + sr) * LDK + sc + voff]); \
    ks0 = ld8(&kb_[(long)(sr) * LDK + sc]); ks1 = ld8(&kb_[(long)(32 + sr) * LDK + sc]); } while (0)
#define SWRITE(b) do { *(bf16x8*)((char*)V_lds + (b) * SHM_V + vst0) = vs0; *(bf16x8*)((char*)V_lds + (b) * SHM_V + vst1) = vs1; const int kc = sc * 2; \
    *(bf16x8*)((char*)K_lds + (b) * SHM_K + KSWZ(sr, kc)) = ks0; *(bf16x8*)((char*)K_lds + (b) * SHM_K + KSWZ(32 + sr, kc)) = ks1; } while (0)
  SLOAD(0); SWRITE(0); __syncthreads();
  for (int j = 0; j < NT; ++j) {
    const int b = j & 1;
    if (j + 1 < NT) SLOAD(j + 1);
    bool active = true;
    if constexpr (MODE == 1) { if (j >= nct) { const int b0 = mA0 + (j - nct) * 64; active = (b0 + 63 >= -128) && (b0 - 31 <= 128); } }
    if constexpr (MODE == 2) { if (j >= nct) { const int kr = ma.krow0 + (j - nct); active = (kr >= mrs) && (kr < mrs + 8); } }
    if (active) {
      f32x16 p0, p1; float mn, al; bf16x8 pa0, pa1, pa2, pa3;
      qkt(p0, p1, (bf16*)((char*)K_lds + b * SHM_K), qr, r32, hi);
      if constexpr (MODE == 1) { if (j >= nct) { const int bd = mA + (j - nct) * 64;
#pragma unroll
          for (int r = 0; r < 16; ++r) { const unsigned u0 = (unsigned)(bd + CC(r)); p0[r] = (u0 <= 256u) ? p0[r] : -1e30f; p1[r] = (u0 + 32u <= 256u) ? p1[r] : -1e30f; } } }
      if constexpr (MODE == 2) { if (j >= nct) { const int kr = ma.krow0 + (j - nct);
          const float* bt = ma.bt + (kr - mrow + 7) * 32; const int kb = 4 * hi - mws, db = 4 * hi - mcol + 15;
#pragma unroll
          for (int r = 0; r < 16; ++r) {
            const float b0 = bt[min(max(db + CC(r), 0), 30)], b1 = bt[min(max(db + CC(r) + 32, 0), 30)];
            p0[r] = ((unsigned)(kb + CC(r)) < 16u) ? p0[r] + b0 : -1e30f; p1[r] = ((unsigned)(kb + CC(r) + 32) < 16u) ? p1[r] + b1 : -1e30f; } } }
      partialSM(p0, p1, m_reg, mn, al);
      if (__any(al < 1.f)) { if (hi == 0) al_l[r32] = al; asm volatile("s_waitcnt lgkmcnt(0)" ::: "memory");
        for (int d = 0; d < 4; ++d) for (int r = 0; r < 16; ++r) o[d][r] *= al_l[crow(r, hi)]; }
      finishSM(p0, p1, al, l_reg, pa0, pa1, pa2, pa3);
      pv_d0(o, vb0 + b * (int)SHM_V, pa0, pa1, pa2, pa3);
    }
    if (j + 1 < NT) SWRITE(b ^ 1);
    __syncthreads();
  }
  if (ma.has_sink) l_reg += __builtin_amdgcn_exp2f(ma.sink * 1.4426950408889634f - m_reg * (SCALE * 1.4426950408889634f));
  if (hi == 0) li_l[r32] = l_reg; asm volatile("s_waitcnt lgkmcnt(0)" ::: "memory");
  float rli[16];
#pragma unroll
  for (int r = 0; r < 16; ++r) rli[r] = __builtin_amdgcn_rcpf(li_l[crow(r, hi)]);
  unsigned char* Ow = Ob + (long)(wid * QBLK) * LDO;
#pragma unroll
  for (int r = 0; r < 16; ++r) { int orow = crow(r, hi);
#pragma unroll
    for (int d0 = 0; d0 < 4; d0 += 1) { const float f = o[d0][r] * rli[r] * 32.f;
      Ow[(long)orow * LDO + d0 * 32 + r32] = (unsigned char)((unsigned)__builtin_amdgcn_cvt_pk_fp8_f32(f, f, 0, false) & 0xffu); } }
#undef CC
#undef TBASE
#undef SLOAD
#undef SWRITE
}

using i32x8 = __attribute__((ext_vector_type(8))) int;
using i32x4 = __attribute__((ext_vector_type(4))) int;
#define MF8_ACC(ACC, A8, B8) asm volatile("v_mfma_scale_f32_32x32x64_f8f6f4 %0, %1, %2, %0, %3, %4 op_sel_hi:[0,0,0]" : "+v"(ACC) : "v"(A8), "v"(B8), "v"(sc1), "v"(sc1))
#define MF8_NEW(ACC, A8, B8) asm volatile("v_mfma_scale_f32_32x32x64_f8f6f4 %0, %1, %2, 0, %3, %4 op_sel_hi:[0,0,0]" : "=&v"(ACC) : "v"(A8), "v"(B8), "v"(sc1), "v"(sc1))
#define NOP16 "s_nop 15\n\t"
#define PIN2_LONG(X, Y) asm volatile(NOP16 NOP16 NOP16 NOP16 NOP16 NOP16 NOP16 NOP16 NOP16 NOP16 NOP16 NOP16 NOP16 NOP16 NOP16 NOP16 NOP16 NOP16 NOP16 NOP16 : "+v"(X), "+v"(Y))
#define PIN2_SHORT(X, Y) asm volatile(NOP16 NOP16 : "+v"(X), "+v"(Y))
#define PIN4(O) asm volatile(NOP16 NOP16 NOP16 NOP16 NOP16 NOP16 NOP16 NOP16 NOP16 NOP16 NOP16 NOP16 NOP16 NOP16 NOP16 NOP16 NOP16 NOP16 NOP16 NOP16 : "+v"(O[0]), "+v"(O[1]), "+v"(O[2]), "+v"(O[3]))
__device__ __forceinline__ void partialSM8(f32x16& p0, f32x16& p1, float& m_reg, float& mn, float& alpha) {
  constexpr float C = SCALE * 1.4426950408889634f; constexpr float THR8 = 3.f;
  float pmax = p0[0]; for (int r = 1; r < 16; ++r) pmax = fmaxf(pmax, p0[r]); for (int r = 0; r < 16; ++r) pmax = fmaxf(pmax, p1[r]);
  { auto rr = __builtin_amdgcn_permlane32_swap(__float_as_uint(pmax), __float_as_uint(pmax), false, false);
    pmax = fmaxf(__uint_as_float(rr[0]), __uint_as_float(rr[1])); }
  if (__builtin_expect(__all(pmax - m_reg <= THR8 / SCALE), 1)) { mn = m_reg; alpha = 1.f; }
  else { mn = fmaxf(m_reg, pmax); alpha = __builtin_amdgcn_exp2f((m_reg - mn) * C); m_reg = mn; }
  float mnC = -mn * C + 4.f;
  for (int r = 0; r < 16; ++r) p0[r] = fmaf(p0[r], C, mnC); for (int r = 0; r < 16; ++r) p1[r] = fmaf(p1[r], C, mnC);
  for (int r = 0; r < 16; ++r) p0[r] = __builtin_amdgcn_exp2f(p0[r]);
}
__device__ __forceinline__ void finishSM8(f32x16& p0, f32x16& p1, float alpha, float& l_reg, i32x8& pa) {
  for (int r = 0; r < 16; ++r) p1[r] = __builtin_amdgcn_exp2f(p1[r]);
  float ps = 0; for (int r = 0; r < 16; ++r) ps += p0[r]; for (int r = 0; r < 16; ++r) ps += p1[r];
  { auto rr = __builtin_amdgcn_permlane32_swap(__float_as_uint(ps), __float_as_uint(ps), false, false);
    ps = __uint_as_float(rr[0]) + __uint_as_float(rr[1]); }
  l_reg = l_reg * alpha + ps;
#pragma unroll
  for (int j = 0; j < 4; ++j) { int w = 0; w = __builtin_amdgcn_cvt_pk_fp8_f32(p0[4 * j], p0[4 * j + 1], w, false); w = __builtin_amdgcn_cvt_pk_fp8_f32(p0[4 * j + 2], p0[4 * j + 3], w, true); pa[j] = w;
    int v = 0; v = __builtin_amdgcn_cvt_pk_fp8_f32(p1[4 * j], p1[4 * j + 1], v, false); v = __builtin_amdgcn_cvt_pk_fp8_f32(p1[4 * j + 2], p1[4 * j + 3], v, true); pa[4 + j] = v; }
}
__device__ __forceinline__ void qkt8(f32x16& p0, f32x16& p1, const char* Kb, const i32x8 (&qf)[2], int r32, int hi, int sc1) {
  i32x8 kf[2][2];
#pragma unroll
  for (int kc = 0; kc < 2; ++kc)
#pragma unroll
    for (int kh = 0; kh < 2; ++kh) { const int row = kh * 32 + r32, c16 = kc * 4 + hi * 2;
      const i32x4 lo = *reinterpret_cast<const i32x4*>(Kb + row * 128 + ((c16 ^ ((row >> 1) & 7)) << 4)), hh = *reinterpret_cast<const i32x4*>(Kb + row * 128 + (((c16 + 1) ^ ((row >> 1) & 7)) << 4));
      kf[kc][kh] = __builtin_shufflevector(lo, hh, 0, 1, 2, 3, 4, 5, 6, 7); }
  asm volatile("s_waitcnt lgkmcnt(0)" ::: "memory");
  MF8_NEW(p0, kf[0][0], qf[0]); MF8_NEW(p1, kf[0][1], qf[0]); MF8_ACC(p0, kf[1][0], qf[1]); MF8_ACC(p1, kf[1][1], qf[1]);
}
__device__ __forceinline__ void pv8(f32x16* o, const char* Vb, const i32x8 pa, int r32, int hi, int sc1) {
  i32x8 vf[4];
#pragma unroll
  for (int d0 = 0; d0 < 4; ++d0) { const int col = d0 * 32 + r32, ch = hi * 2, sw = (col >> 2) & 3;
    const i32x4 lo = *reinterpret_cast<const i32x4*>(Vb + col * 64 + ((ch ^ sw) << 4)), hh = *reinterpret_cast<const i32x4*>(Vb + col * 64 + (((ch + 1) ^ sw) << 4));
    vf[d0] = __builtin_shufflevector(lo, hh, 0, 1, 2, 3, 4, 5, 6, 7); }
  asm volatile("s_waitcnt lgkmcnt(0)" ::: "memory");
  MF8_ACC(o[0], pa, vf[0]); MF8_ACC(o[1], pa, vf[1]); MF8_ACC(o[2], pa, vf[2]); MF8_ACC(o[3], pa, vf[3]);
}
template <int LDQ, int LDO>
__device__ __forceinline__ void attn_body_fp8(const bf16* __restrict__ Qb, const unsigned char* __restrict__ Kimg, const unsigned char* __restrict__ Vimg,
                                              unsigned char* __restrict__ Ob, int NT, char* lds, const QPrep qp) {
  const int tid = mk_ltid(), wid = tid >> 6, lane = tid & 63, r32 = lane & 31, hi = lane >> 5;
  constexpr int SHM8 = 8192;
  char* V_lds = lds; char* K_lds = lds + 2 * SHM8;
  float* ws = (float*)(lds + 4 * SHM8) + wid * 64; float* li_l = ws; float* al_l = ws + 32;
  const int sc1 = 0x7F7F7F7F;
  float m_reg = -1e30f, l_reg = 0; f32x16 o[4] = {}; bf16x8 qr[8];
  const bf16* Qw = Qb + (long)(wid * QBLK + r32) * LDQ + hi * 8;
#pragma unroll
  for (int d0 = 0; d0 < 8; ++d0) qr[d0] = ld8(Qw + d0 * 16);
  q_prepare(qr, qp, qp.qp0 + wid * QBLK + r32, hi);
  i32x8 qf[2];
#pragma unroll
  for (int kc = 0; kc < 2; ++kc)
#pragma unroll
    for (int i = 0; i < 4; ++i) { const u32x4 w = *reinterpret_cast<const u32x4*>(&qr[4 * kc + i]);
      const float f0 = __uint_as_float(w[0] << 16), f1 = __uint_as_float(w[0] & 0xffff0000u), f2 = __uint_as_float(w[1] << 16), f3 = __uint_as_float(w[1] & 0xffff0000u);
      const float f4 = __uint_as_float(w[2] << 16), f5 = __uint_as_float(w[2] & 0xffff0000u), f6 = __uint_as_float(w[3] << 16), f7 = __uint_as_float(w[3] & 0xffff0000u);
      int a = 0; a = __builtin_amdgcn_cvt_pk_fp8_f32(f0, f1, a, false); a = __builtin_amdgcn_cvt_pk_fp8_f32(f2, f3, a, true);
      int b = 0; b = __builtin_amdgcn_cvt_pk_fp8_f32(f4, f5, b, false); b = __builtin_amdgcn_cvt_pk_fp8_f32(f6, f7, b, true);
      qf[kc][2 * i] = a; qf[kc][2 * i + 1] = b; }
  struct { u32x4 vs, ks; } sr_[2];
#define SLOAD8(i, t) do { sr_[i].vs = *reinterpret_cast<const u32x4*>(Vimg + (size_t)(t) * 8192 + tid * 16); sr_[i].ks = *reinterpret_cast<const u32x4*>(Kimg + (size_t)(t) * 8192 + tid * 16); } while (0)
#define SWRITE8(b, i) do { *reinterpret_cast<u32x4*>(V_lds + (b) * SHM8 + tid * 16) = sr_[i].vs; *reinterpret_cast<u32x4*>(K_lds + (b) * SHM8 + tid * 16) = sr_[i].ks; } while (0)
#define SWAIT8() asm volatile("s_waitcnt vmcnt(2)" ::: "memory")
#define RESC8(a) do { if (__any((a) < 1.f)) { if (hi == 0) al_l[r32] = (a); asm volatile("s_waitcnt lgkmcnt(0)" ::: "memory"); PIN4(o); \
    for (int d = 0; d < 4; ++d) for (int r = 0; r < 16; ++r) o[d][r] *= al_l[crow(r, hi)]; } } while (0)
  f32x16 pA0, pA1, pB0, pB1; float mnA, mnB, alA, alB; i32x8 pa;
  SLOAD8(0, 0); asm volatile("s_waitcnt vmcnt(0)" ::: "memory"); SWRITE8(0, 0); __syncthreads();
  qkt8(pA0, pA1, K_lds, qf, r32, hi, sc1); PIN2_LONG(pA0, pA1); partialSM8(pA0, pA1, m_reg, mnA, alA);
  SLOAD8(1, 1); if (2 < NT) SLOAD8(0, 2);
  SWAIT8(); SWRITE8(1, 1); __syncthreads();
  for (int j = 1; j + 1 < NT; j += 2) {
    SBAR(); qkt8(pB0, pB1, K_lds + SHM8, qf, r32, hi, sc1);
    finishSM8(pA0, pA1, alA, l_reg, pa); SBAR();
    SLOAD8(1, (j + 2)); SBAR();
    pv8(o, V_lds, pa, r32, hi, sc1); PIN2_SHORT(pB0, pB1); partialSM8(pB0, pB1, m_reg, mnB, alB);
    __syncthreads(); SWAIT8(); SWRITE8(0, 0);
    RESC8(alB); __syncthreads();
    SBAR(); qkt8(pA0, pA1, K_lds, qf, r32, hi, sc1);
    finishSM8(pB0, pB1, alB, l_reg, pa); SBAR();
    if (j + 3 < NT) SLOAD8(0, (j + 3)); SBAR();
    pv8(o, V_lds + SHM8, pa, r32, hi, sc1); PIN2_SHORT(pA0, pA1); partialSM8(pA0, pA1, m_reg, mnA, alA);
    __syncthreads(); SWAIT8(); SWRITE8(1, 1);
    RESC8(alA); __syncthreads();
  }
  SBAR(); qkt8(pB0, pB1, K_lds + SHM8, qf, r32, hi, sc1);
  finishSM8(pA0, pA1, alA, l_reg, pa); SBAR();
  pv8(o, V_lds, pa, r32, hi, sc1); PIN2_LONG(pB0, pB1); partialSM8(pB0, pB1, m_reg, mnB, alB);
  __syncthreads(); RESC8(alB);
  finishSM8(pB0, pB1, alB, l_reg, pa); SBAR();
  pv8(o, V_lds + SHM8, pa, r32, hi, sc1);
  PIN4(o);
  if (hi == 0) li_l[r32] = l_reg; asm volatile("s_waitcnt lgkmcnt(0)" ::: "memory");
  float rli[16];
#pragma unroll
  for (int r = 0; r < 16; ++r) rli[r] = __builtin_amdgcn_rcpf(li_l[crow(r, hi)]);
  unsigned char* Ow = Ob + (long)(wid * QBLK) * LDO;
#pragma unroll
  for (int r = 0; r < 16; ++r) { int orow = crow(r, hi);
#pragma unroll
    for (int d0 = 0; d0 < 4; d0 += 1) { const float f = o[d0][r] * rli[r] * 32.f;
      Ow[(long)orow * LDO + d0 * 32 + r32] = (unsigned char)((unsigned)__builtin_amdgcn_cvt_pk_fp8_f32(f, f, 0, false) & 0xffu); } }
#undef SLOAD8
#undef SWRITE8
#undef SWAIT8
#undef RESC8
}
#define AS3 __attribute__((address_space(3)))
__device__ __forceinline__ void mq_new(f32x16& acc, const i32x8& a, const i32x8& b, const f32x16& c, f32x16& t1, float& t2, i32x8& t3, int sa, int sb) {
  asm volatile("v_mfma_scale_f32_32x32x64_f8f6f4 %[acc], %[a], %[b], %[c], %[sa], %[sb] op_sel_hi:[0,0,0]"
               : [acc] "=&v"(acc), "+v"(t1), "+v"(t2), "+v"(t3) : [a] "v"(a), [b] "v"(b), [c] "v"(c), [sa] "v"(sa), [sb] "v"(sb)); }
__device__ __forceinline__ void mq_acc(f32x16& acc, const i32x8& a, const i32x8& b, f32x16& t1, float& t2, i32x8& t3, int sa, int sb) {
  asm volatile("v_mfma_scale_f32_32x32x64_f8f6f4 %[acc], %[a], %[b], %[acc], %[sa], %[sb] op_sel_hi:[0,0,0]"
               : [acc] "+v"(acc), "+v"(t1), "+v"(t2), "+v"(t3) : [a] "v"(a), [b] "v"(b), [sa] "v"(sa), [sb] "v"(sb)); }
__device__ __forceinline__ void mp_acc(f32x16& acc, const i32x8& a, const i32x8& b, f32x16& t1, float& t2, int sc) {
  asm volatile("v_mfma_scale_f32_32x32x64_f8f6f4 %[acc], %[a], %[b], %[acc], %[sa], %[sa] op_sel_hi:[0,0,0]"
               : [acc] "+v"(acc), "+v"(t1), "+v"(t2) : [a] "v"(a), [b] "v"(b), [sa] "v"(sc)); }
__device__ __forceinline__ int pk8(float a, float b, float c, float d, int w = 0) { w = __builtin_amdgcn_cvt_pk_fp8_f32(a, b, w, false); w = __builtin_amdgcn_cvt_pk_fp8_f32(c, d, w, true); return w; }
template <int K>
__device__ __forceinline__ void fin_chunk(const f32x16& p0, f32x16& p1, float& ps, i32x8& pa) {
#pragma unroll
  for (int r = 4 * K; r < 4 * K + 4; ++r) p1[r] = __builtin_amdgcn_exp2f(p1[r]);
  if constexpr (K < 2) { pa[2 * K] = pk8(p0[8 * K], p0[8 * K + 1], p0[8 * K + 2], p0[8 * K + 3], pa[2 * K]); pa[2 * K + 1] = pk8(p0[8 * K + 4], p0[8 * K + 5], p0[8 * K + 6], p0[8 * K + 7], pa[2 * K + 1]); }
  else { constexpr int b = 8 * (K - 2);
#pragma unroll
    for (int r = b; r < b + 8; ++r) ps += p1[r];
    pa[2 * K] = pk8(p1[b], p1[b + 1], p1[b + 2], p1[b + 3], pa[2 * K]); pa[2 * K + 1] = pk8(p1[b + 4], p1[b + 5], p1[b + 6], p1[b + 7], pa[2 * K + 1]); }
}
template <int R0, int R1>
__device__ __forceinline__ void exp_chunk(f32x16& p0, float& ps) {
#pragma unroll
  for (int r = R0; r < R1; ++r) p0[r] = __builtin_amdgcn_exp2f(p0[r]);
#pragma unroll
  for (int r = R0; r < R1; ++r) ps += p0[r];
}
template <bool FIRST>
__device__ __forceinline__ void max_phase(f32x16& p0, f32x16& p1, f32x16& negm, float& alpha) {
  constexpr float T8 = 3.f * 1.4426950408889634f;
  float pmax = p0[0];
#pragma unroll
  for (int r = 1; r < 16; ++r) pmax = fmaxf(pmax, p0[r]);
#pragma unroll
  for (int r = 0; r < 16; ++r) pmax = fmaxf(pmax, p1[r]);
  { auto rr = __builtin_amdgcn_permlane32_swap(__float_as_uint(pmax), __float_as_uint(pmax), false, false);
    pmax = fmaxf(__uint_as_float(rr[0]), __uint_as_float(rr[1])); }
  alpha = 1.f;
  if (FIRST || __builtin_expect(!__all(pmax <= 4.f + T8), 0)) {
    const float delta = FIRST ? pmax - 4.f : fmaxf(pmax - 4.f, 0.f);
    if (!FIRST) alpha = __builtin_amdgcn_exp2f(-delta);
#pragma unroll
    for (int r = 0; r < 16; ++r) { p0[r] -= delta; p1[r] -= delta; negm[r] -= delta; }
  }
}
template <int LDQ, int LDO, int NT>
__device__ __forceinline__ void attn_body_fp8i(const bf16* __restrict__ Qb, const unsigned char* __restrict__ Kimg, const unsigned char* __restrict__ Vimg,
                                               unsigned char* __restrict__ Ob, char* lds_g, const QPrep qp) {
  const int tid = mk_ltid(), wid = __builtin_amdgcn_readfirstlane(tid >> 6), lane = tid & 63, r32 = lane & 31, hi = lane >> 5;
  constexpr int SLOT = 16384;
  AS3 unsigned char* lds = (AS3 unsigned char*)lds_g;
  float* ws = (float*)(lds_g + 4 * SLOT) + wid * 64; float* li_l = ws; float* al_l = ws + 32;
  const int sc1 = 0x7F7F7F7F, scq = 0x7C7C7C7C;
#define DMA8(t) do { const int so_ = ((t) & 3) * SLOT + wid * 1024; \
    __builtin_amdgcn_global_load_lds((const unsigned*)(Vimg + (size_t)(t) * 8192 + tid * 16), (AS3 unsigned*)(lds + so_), 16, 0, 0); \
    __builtin_amdgcn_global_load_lds((const unsigned*)(Kimg + (size_t)(t) * 8192 + tid * 16), (AS3 unsigned*)(lds + so_ + 8192), 16, 0, 0); } while (0)
#define DMA8V(t) do { const int so_ = ((t) & 3) * SLOT + wid * 1024; \
    __builtin_amdgcn_global_load_lds((const unsigned*)(Vimg + (size_t)(t) * 8192 + tid * 16), (AS3 unsigned*)(lds + so_), 16, 0, 0); } while (0)
#define DMA8K(t) do { const int so_ = ((t) & 3) * SLOT + wid * 1024; \
    __builtin_amdgcn_global_load_lds((const unsigned*)(Kimg + (size_t)(t) * 8192 + tid * 16), (AS3 unsigned*)(lds + so_ + 8192), 16, 0, 0); } while (0)
  DMA8(0); DMA8(1); DMA8(2);
  float l_reg = 0; f32x16 o[4] = {}; f32x16 negm = {};
  i32x8 qf[2];
  { bf16x8 qr[8];
    const bf16* Qw = Qb + (long)(wid * QBLK + r32) * LDQ + hi * 8;
#pragma unroll
    for (int d0 = 0; d0 < 8; ++d0) qr[d0] = ld8(Qw + d0 * 16);
    q_prepare(qr, qp, qp.qp0 + wid * QBLK + r32, hi);
    constexpr float QS = SCALE * 1.4426950408889634f * 8.f;
#pragma unroll
    for (int kc = 0; kc < 2; ++kc)
#pragma unroll
      for (int i = 0; i < 4; ++i) { const u32x4 w = *reinterpret_cast<const u32x4*>(&qr[4 * kc + i]);
        const float f0 = __uint_as_float(w[0] << 16) * QS, f1 = __uint_as_float(w[0] & 0xffff0000u) * QS, f2 = __uint_as_float(w[1] << 16) * QS, f3 = __uint_as_float(w[1] & 0xffff0000u) * QS;
        const float f4 = __uint_as_float(w[2] << 16) * QS, f5 = __uint_as_float(w[2] & 0xffff0000u) * QS, f6 = __uint_as_float(w[3] << 16) * QS, f7 = __uint_as_float(w[3] & 0xffff0000u) * QS;
        qf[kc][2 * i] = pk8(f0, f1, f2, f3); qf[kc][2 * i + 1] = pk8(f4, f5, f6, f7); } }
  int ka[4], va[2];
#pragma unroll
  for (int kc = 0; kc < 2; ++kc)
#pragma unroll
    for (int x = 0; x < 2; ++x) ka[kc * 2 + x] = 8192 + r32 * 128 + (((kc * 4 + hi * 2 + x) ^ ((r32 >> 1) & 7)) << 4);
#pragma unroll
  for (int x = 0; x < 2; ++x) va[x] = r32 * 64 + (((hi * 2 + x) ^ ((r32 >> 2) & 3)) << 4);
  i32x8 kf[2][2], vf[4], pa = {};
#define LDK8(t) do { const int so_ = ((t) & 3) * SLOT; _Pragma("unroll") for (int kc = 0; kc < 2; ++kc) _Pragma("unroll") for (int kh = 0; kh < 2; ++kh) { \
    const i32x4 lo_ = *(const AS3 i32x4*)(lds + so_ + ka[kc * 2] + kh * 4096), hh_ = *(const AS3 i32x4*)(lds + so_ + ka[kc * 2 + 1] + kh * 4096); \
    kf[kc][kh] = __builtin_shufflevector(lo_, hh_, 0, 1, 2, 3, 4, 5, 6, 7); } } while (0)
#define LDV8(t) do { const int so_ = ((t) & 3) * SLOT; _Pragma("unroll") for (int d0 = 0; d0 < 4; ++d0) { \
    const i32x4 lo_ = *(const AS3 i32x4*)(lds + so_ + va[0] + d0 * 2048), hh_ = *(const AS3 i32x4*)(lds + so_ + va[1] + d0 * 2048); \
    vf[d0] = __builtin_shufflevector(lo_, hh_, 0, 1, 2, 3, 4, 5, 6, 7); } } while (0)
#define LGK0() asm volatile("s_waitcnt lgkmcnt(0)" ::: "memory")
#define MEMB() asm volatile("" ::: "memory")
#define PINQ(X, Y, Z, W) asm volatile("s_nop 7" : "+v"(X), "+v"(Y), "+v"(Z), "+v"(W))
#define RESC8I(a) do { if (__any((a) < 1.f)) { if (hi == 0) al_l[r32] = (a); LGK0(); PIN4(o); \
    _Pragma("unroll") for (int d = 0; d < 4; ++d) _Pragma("unroll") for (int r = 0; r < 16; ++r) o[d][r] *= al_l[crow(r, hi)]; } } while (0)
#if defined(MK_PROBE_A)
  float dmy = 1.f;
#define PROBE_HOOK() asm volatile("v_exp_f32 %0, %0\n v_exp_f32 %0, %0\n v_exp_f32 %0, %0\n v_exp_f32 %0, %0\n v_exp_f32 %0, %0\n v_exp_f32 %0, %0\n v_exp_f32 %0, %0\n v_exp_f32 %0, %0\n v_exp_f32 %0, %0\n v_exp_f32 %0, %0\n v_exp_f32 %0, %0\n v_exp_f32 %0, %0\n v_exp_f32 %0, %0\n v_exp_f32 %0, %0\n v_exp_f32 %0, %0\n v_exp_f32 %0, %0" : "+v"(dmy))
#elif defined(MK_PROBE_A2)
  float dmy = 1.f;
#define PROBE_HOOK() asm volatile("v_add_f32 %0, %0, %0\n v_add_f32 %0, %0, %0\n v_add_f32 %0, %0, %0\n v_add_f32 %0, %0, %0\n v_add_f32 %0, %0, %0\n v_add_f32 %0, %0, %0\n v_add_f32 %0, %0, %0\n v_add_f32 %0, %0, %0\n v_add_f32 %0, %0, %0\n v_add_f32 %0, %0, %0\n v_add_f32 %0, %0, %0\n v_add_f32 %0, %0, %0\n v_add_f32 %0, %0, %0\n v_add_f32 %0, %0, %0\n v_add_f32 %0, %0, %0\n v_add_f32 %0, %0, %0\n v_add_f32 %0, %0, %0\n v_add_f32 %0, %0, %0\n v_add_f32 %0, %0, %0\n v_add_f32 %0, %0, %0\n v_add_f32 %0, %0, %0\n v_add_f32 %0, %0, %0\n v_add_f32 %0, %0, %0\n v_add_f32 %0, %0, %0\n v_add_f32 %0, %0, %0\n v_add_f32 %0, %0, %0\n v_add_f32 %0, %0, %0\n v_add_f32 %0, %0, %0\n v_add_f32 %0, %0, %0\n v_add_f32 %0, %0, %0\n v_add_f32 %0, %0, %0\n v_add_f32 %0, %0, %0" : "+v"(dmy))
#elif defined(MK_PROBE_B)
  i32x8 z8 = {};
#define PROBE_HOOK() do { asm volatile("" : "+v"(z8)); mp_acc(o[0], z8, kf[0][0], o[2], l_reg, sc1); mp_acc(o[1], z8, kf[0][0], o[2], l_reg, sc1); } while (0)
#elif defined(MK_PROBE_C)
  i32x4 dq;
#define PROBE_HOOK() do { _Pragma("unroll") for (int q_ = 0; q_ < 8; ++q_) asm volatile("ds_read_b128 %0, %1" : "=v"(dq) : "v"((int)(size_t)(lds + ka[q_ & 3] + (q_ >> 2) * 4096)) : "memory"); asm volatile("s_waitcnt lgkmcnt(0)" : "+v"(dq) :: "memory"); } while (0)
#elif defined(MK_PROBE_D)
#define PROBE_HOOK() __builtin_amdgcn_s_barrier()
#else
#define PROBE_HOOK() do {} while (0)
#endif
#define STEP8I(s, N0, N1, O0, O1, psN, psO, alN, alO) do { \
    __builtin_amdgcn_s_barrier(); \
    LDK8((s) + 1); asm volatile("" : "+v"(O0), "+v"(psO) :: "memory"); exp_chunk<8, 16>(O0, psO); asm volatile("s_waitcnt lgkmcnt(0)" : "+v"(O0), "+v"(psO) :: "memory"); \
    PROBE_HOOK(); mq_new(N0, kf[0][0], qf[0], negm, O1, psO, pa, sc1, scq); fin_chunk<0>(O0, O1, psO, pa); \
    mq_new(N1, kf[0][1], qf[0], negm, O1, psO, pa, sc1, scq); fin_chunk<1>(O0, O1, psO, pa); \
    mq_acc(N0, kf[1][0], qf[1], O1, psO, pa, sc1, scq);       fin_chunk<2>(O0, O1, psO, pa); \
    mq_acc(N1, kf[1][1], qf[1], O1, psO, pa, sc1, scq);       MEMB(); LDV8(s); fin_chunk<3>(O0, O1, psO, pa); \
    { auto rr_ = __builtin_amdgcn_permlane32_swap(__float_as_uint(psO), __float_as_uint(psO), false, false); l_reg = l_reg * alO + (__uint_as_float(rr_[0]) + __uint_as_float(rr_[1])); } \
    LGK0(); psN = 0.f; \
    mp_acc(o[0], pa, vf[0], N0, psN, sc1); PINQ(N0, N1, l_reg, psN); max_phase<false>(N0, N1, negm, alN); \
    mp_acc(o[1], pa, vf[1], N0, psN, sc1); exp_chunk<0, 3>(N0, psN); \
    mp_acc(o[2], pa, vf[2], N0, psN, sc1); if ((s) + 3 < NT) DMA8V((s) + 3);     \
    exp_chunk<3, 6>(N0, psN); \
    mp_acc(o[3], pa, vf[3], N0, psN, sc1); if ((s) + 3 < NT) DMA8K((s) + 3); \
    exp_chunk<6, 8>(N0, psN); \
    RESC8I(alN); \
    if ((s) + 3 < NT) asm volatile("s_waitcnt vmcnt(2)" ::: "memory"); else asm volatile("s_waitcnt vmcnt(0)" ::: "memory"); \
  } while (0)
  f32x16 pA0, pA1, pB0, pB1; float psA = 0.f, psB = 0.f, alA = 1.f, alB = 1.f;
  asm volatile("s_waitcnt vmcnt(4)" ::: "memory"); __builtin_amdgcn_s_barrier();
  LDK8(0); LGK0();
  mq_new(pA0, kf[0][0], qf[0], negm, o[0], psA, pa, sc1, scq); mq_new(pA1, kf[0][1], qf[0], negm, o[0], psA, pa, sc1, scq);
  mq_acc(pA0, kf[1][0], qf[1], o[0], psA, pa, sc1, scq); mq_acc(pA1, kf[1][1], qf[1], o[0], psA, pa, sc1, scq);
  PIN2_SHORT(pA0, pA1); max_phase<true>(pA0, pA1, negm, alA); exp_chunk<0, 8>(pA0, psA);
  asm volatile("s_waitcnt vmcnt(2)" ::: "memory");
  for (int s = 0; s + 2 < NT; s += 2) {
    STEP8I(s, pB0, pB1, pA0, pA1, psB, psA, alB, alA);
    STEP8I(s + 1, pA0, pA1, pB0, pB1, psA, psB, alA, alB);
  }
  STEP8I(NT - 2, pB0, pB1, pA0, pA1, psB, psA, alB, alA);
  exp_chunk<8, 16>(pB0, psB);
  fin_chunk<0>(pB0, pB1, psB, pa); fin_chunk<1>(pB0, pB1, psB, pa); fin_chunk<2>(pB0, pB1, psB, pa); fin_chunk<3>(pB0, pB1, psB, pa);
  { auto rr_ = __builtin_amdgcn_permlane32_swap(__float_as_uint(psB), __float_as_uint(psB), false, false); l_reg = l_reg * alB + (__uint_as_float(rr_[0]) + __uint_as_float(rr_[1])); }
  LDV8(NT - 1); LGK0();
  mp_acc(o[0], pa, vf[0], pB0, psB, sc1); mp_acc(o[1], pa, vf[1], pB0, psB, sc1); mp_acc(o[2], pa, vf[2], pB0, psB, sc1); mp_acc(o[3], pa, vf[3], pB0, psB, sc1);
  PIN4(o);
  if (hi == 0) li_l[r32] = l_reg; asm volatile("s_waitcnt lgkmcnt(0)" ::: "memory");
  float rli[16];
#pragma unroll
  for (int r = 0; r < 16; ++r) rli[r] = __builtin_amdgcn_rcpf(li_l[crow(r, hi)]);
  unsigned char* Ow = Ob + (long)(wid * QBLK) * LDO;
#pragma unroll
  for (int r = 0; r < 16; ++r) { int orow = crow(r, hi);
#pragma unroll
    for (int d0 = 0; d0 < 4; d0 += 1) { const float f = o[d0][r] * rli[r] * 32.f;
      Ow[(long)orow * LDO + d0 * 32 + r32] = (unsigned char)((unsigned)__builtin_amdgcn_cvt_pk_fp8_f32(f, f, 0, false) & 0xffu); } }
#undef DMA8
#undef DMA8V
#undef DMA8K
#undef LDK8
#undef LDV8
#undef STEP8I
#undef RESC8I
#undef PINQ
}
#undef KSWZ
#undef SBAR
}

namespace mk {
typedef unsigned short bf16;
typedef unsigned u32x4v __attribute__((ext_vector_type(4)));
typedef float f32x4v __attribute__((ext_vector_type(4)));
constexpr int D = 2048, NB = 2, L = 8192, CL = 256, TL = NB * L, TC = NB * CL, T = TL + TC, HD = 128, DEPTH = 4;
constexpr int NQ_AB = 4608, NQ_C = 3072, NE = 16384, NMOD = 6 * D;
constexpr float ALPHA = 1.6817928305074290f;
constexpr float SCALE = 0.088388347648318440f;
constexpr float NEG = -1e30f;
constexpr float U_SCALE = 64.f, V_SCALE = 8.f;
constexpr float W8_SCALE = 64.f, ATT8_SCALE = 32.f;
constexpr int SC_ONE = 0x7F7F7F7F, SC_W8 = 0x79797979  , SC_ATT8 = 0x7A7A7A7A  ;

constexpr size_t al256(size_t x) { return (x + 255) & ~(size_t)255; }
constexpr size_t WS_CTL    = 0;
constexpr size_t WS_MOD    = 16384;
constexpr size_t WS_ROPE   = al256(WS_MOD + (size_t)DEPTH * 3 * NMOD * 4);
constexpr size_t WS_WIN_AB = al256(WS_ROPE + 2 * 128 * 32 * 4);
constexpr size_t WS_WOUT_AB= al256(WS_WIN_AB + (size_t)2 * NQ_AB * D * 2);
constexpr size_t WS_WIN_C  = al256(WS_WOUT_AB + (size_t)2 * D * D * 2);
constexpr size_t WS_WOUT_C = al256(WS_WIN_C + (size_t)2 * NQ_C * D * 2);
constexpr size_t WS_WPQ    = al256(WS_WOUT_C + (size_t)2 * D * D * 2);
constexpr size_t WS_SK     = al256(WS_WPQ + (size_t)4 * D * D * 2);
constexpr size_t WS_U      = al256(WS_SK + (size_t)4 * 16 * 128 * 128 * 2);
constexpr size_t WS_V      = al256(WS_U + (size_t)4 * NE * D * 2);
constexpr size_t WS_X      = al256(WS_V + (size_t)4 * NE * D * 2);
constexpr size_t WS_H      = al256(WS_X + (size_t)T * D * 4);
constexpr size_t WS_QKV    = al256(WS_H + (size_t)T * D * 2);
constexpr size_t WS_ATT    = al256(WS_QKV + (size_t)T * NQ_AB * 2);
constexpr size_t WS_Y      = al256(WS_ATT + (size_t)T * D * 2);
constexpr size_t WS_PQ     = al256(WS_Y + (size_t)T * D * 4);
constexpr size_t WS_TOPV   = al256(WS_PQ + (size_t)T * D * 2);
constexpr size_t WS_TOPI   = al256(WS_TOPV + (size_t)T * 256 * 4);
constexpr size_t WS_IDX    = al256(WS_TOPI + (size_t)T * 256 * 4);
constexpr size_t WS_GATE   = al256(WS_IDX + (size_t)T * 128 * 4);
constexpr size_t WS_H8     = al256(WS_GATE + (size_t)T * 128 * 4);
constexpr int NTC = (CL + L) / 64;
constexpr size_t WS_K8     = al256(WS_H8 + (size_t)T * D);
constexpr size_t WS_VT8    = al256(WS_K8 + (size_t)NB * 4 * NTC * 8192);
constexpr size_t WS_USC    = al256(WS_VT8 + (size_t)NB * 4 * NTC * 8192);
constexpr size_t WS_HQ     = al256(WS_USC + (size_t)DEPTH * NE * 4);
constexpr size_t WS_HSC    = al256(WS_HQ + (size_t)T * D);
constexpr size_t WS_VSC    = al256(WS_HSC + (size_t)T * 4);
constexpr size_t WS_WQ     = al256(WS_VSC + (size_t)DEPTH * NE * 4);
constexpr size_t WS_WSC    = al256(WS_WQ + (size_t)T * 128);
constexpr size_t WS_PQSC   = al256(WS_WSC + (size_t)T * 4);
constexpr size_t WS_END    = al256(WS_PQSC + (size_t)DEPTH * D * 4);

constexpr int LDS_GEMM = 131072, LDS_MISC = LDS_GEMM, LDS_BYTES = LDS_GEMM + 256;

struct Params {
    const float *x, *c, *ctx, *c_ctx, *mod_w, *mod_b, *ln_g, *ln_b, *ab_w_in, *ab_w_out, *a_sink, *b_rpb, *c_w_in, *c_w_out, *c_q_gain, *c_k_gain, *peer_wq, *peer_sk, *peer_u, *peer_v;
    float* out; unsigned char* ws; int ph_lo, ph_hi;
};

__device__ __forceinline__ bf16 f2bf_rne(float f) { unsigned u = __float_as_uint(f); u += 0x7FFFu + ((u >> 16) & 1u); return (bf16)(u >> 16); }
__device__ __forceinline__ unsigned fp8_1(float f) { return (unsigned)__builtin_amdgcn_cvt_pk_fp8_f32(f, f, 0, false) & 0xffu; }
__device__ __forceinline__ unsigned fp8_4(float a, float b, float c, float d) { int w = 0; w = __builtin_amdgcn_cvt_pk_fp8_f32(a, b, w, false); w = __builtin_amdgcn_cvt_pk_fp8_f32(c, d, w, true); return (unsigned)w; }
__device__ __forceinline__ float bflo(unsigned u) { return __uint_as_float(u << 16); }
__device__ __forceinline__ float bfhi(unsigned u) { return __uint_as_float(u & 0xffff0000u); }
__device__ __forceinline__ unsigned pk2(float lo, float hi) { return pg8::cvt_pk_bf16(lo, hi); }
__device__ __forceinline__ float wave_sum(float v) {
#pragma unroll
    for (int o = 32; o >= 1; o >>= 1) v += __shfl_xor(v, o); return v; }
__device__ __forceinline__ float wave_max(float v) {
#pragma unroll
    for (int o = 32; o >= 1; o >>= 1) v = fmaxf(v, __shfl_xor(v, o)); return v; }

__device__ __forceinline__ void tr_tile_wave(const float* __restrict__ W, unsigned char* __restrict__ Wt, int K, int N, int tile, unsigned char* ldsw, int lane) {
    const int ntn = N >> 6, tk = tile / ntn, tn = tile - tk * ntn;
    const float* src = W + (size_t)(tk * 64 + (lane >> 4)) * N + tn * 64 + (lane & 15) * 4;
    f32x4v v[16];
#pragma unroll
    for (int i = 0; i < 16; ++i) v[i] = __builtin_nontemporal_load((const f32x4v*)(src + (size_t)(4 * i) * N));
#pragma unroll
    for (int i = 0; i < 16; ++i) { const int k = 4 * i + (lane >> 4), n = (lane & 15) * 4;
#pragma unroll
        for (int j = 0; j < 4; ++j) ldsw[(n + j) * 80 + k] = (unsigned char)fp8_1(v[i][j] * W8_SCALE); }
    asm volatile("s_waitcnt lgkmcnt(0)" ::: "memory");
#pragma unroll
    for (int i = 0; i < 4; ++i) { const int n = 16 * i + (lane >> 2), kc = (lane & 3) * 16;
        const u32x4v w = *(const u32x4v*)(ldsw + n * 80 + kc);
        *(u32x4v*)(Wt + (size_t)(tn * 64 + n) * K + tk * 64 + kc) = w; }
    asm volatile("s_waitcnt lgkmcnt(0)" ::: "memory");
}
__device__ __forceinline__ void tr_tile_wave_bf16(const float* __restrict__ W, bf16* __restrict__ Wt, int K, int N, int tile, bf16* ldsw, int lane) {
    const int ntn = N >> 6, tk = tile / ntn, tn = tile - tk * ntn;
    const float* src = W + (size_t)(tk * 64 + (lane >> 4)) * N + tn * 64 + (lane & 15) * 4;
    f32x4v v[16];
#pragma unroll
    for (int i = 0; i < 16; ++i) v[i] = *(const f32x4v*)(src + (size_t)(4 * i) * N);
#pragma unroll
    for (int i = 0; i < 16; ++i) { const int k = 4 * i + (lane >> 4), n = (lane & 15) * 4;
#pragma unroll
        for (int j = 0; j < 4; ++j) ldsw[(n + j) * 72 + k] = f2bf_rne(v[i][j]); }
    asm volatile("s_waitcnt lgkmcnt(0)" ::: "memory");
#pragma unroll
    for (int i = 0; i < 8; ++i) { const int n = 8 * i + (lane >> 3), kc = (lane & 7) * 8;
        const u32x4v w = *(const u32x4v*)(ldsw + n * 72 + kc);
        *(u32x4v*)(Wt + (size_t)(tn * 64 + n) * K + tk * 64 + kc) = w; }
    asm volatile("s_waitcnt lgkmcnt(0)" ::: "memory");
}
template <bool SHI>
__device__ __forceinline__ void cvt_rows_u4(const float* __restrict__ src, unsigned char* __restrict__ dst, float* __restrict__ steps, int nrows, int part, int nparts) {
    const int tid = mk_ltid(), wave = __builtin_amdgcn_readfirstlane(tid >> 6), lane = tid & 63;
    int row = part * 8 + wave; const int rstep = nparts * 8;
    f32x4v x[8], nx[8];
#define U4_FETCH(X, rr) do { _Pragma("unroll") for (int c_ = 0; c_ < 4; ++c_) { X[2 * c_] = __builtin_nontemporal_load((const f32x4v*)(src + (size_t)(rr) * D + c_ * 512 + lane * 8)); X[2 * c_ + 1] = __builtin_nontemporal_load((const f32x4v*)(src + (size_t)(rr) * D + c_ * 512 + lane * 8 + 4)); } } while (0)
    if (row < nrows) U4_FETCH(nx, row);
    while (row < nrows) {
#pragma unroll
        for (int j = 0; j < 8; ++j) x[j] = nx[j];
        const int nrow = row + rstep;
        if (nrow < nrows) U4_FETCH(nx, nrow);
        asm volatile("" ::: "memory");
        float ss = 0.f;
#pragma unroll
        for (int j = 0; j < 8; ++j) ss += (x[j][0] * x[j][0] + x[j][1] * x[j][1]) + (x[j][2] * x[j][2] + x[j][3] * x[j][3]);
        ss = wave_sum(ss);
        const float rms = sqrtf(ss * (1.f / D)), step = (rms > 0.f) ? 0.335f * rms : 1.f, inv = 1.f / step;
#pragma unroll
        for (int c = 0; c < 4; ++c) { unsigned w = 0u;
#pragma unroll
            for (int b = 0; b < 4; ++b) { const int lo = (int)fminf(fmaxf(rintf(x[2 * c][b] * inv) + 8.f, 0.f), 15.f); int hi = (int)fminf(fmaxf(rintf(x[2 * c + 1][b] * inv) + 8.f, 0.f), 15.f);
                if (SHI) hi = (hi - 8) & 15;
                w |= (unsigned)(lo | (hi << 4)) << (8 * b); }
            *(unsigned*)(dst + (size_t)(c * 2 + (lane >> 5)) * ((size_t)nrows * 128) + (size_t)row * 128 + (lane & 31) * 4) = w; }
        if (lane == 0) steps[row] = step;
        row = nrow;
    }
#undef U4_FETCH
}
__device__ __forceinline__ void tr_strip_i8(const float* __restrict__ W, unsigned char* __restrict__ Wt, float* __restrict__ steps, int N, int tn, unsigned char* lds_raw) {
    const int tid = mk_ltid(), wave = __builtin_amdgcn_readfirstlane(tid >> 6), lane = tid & 63;
    unsigned char* ldsw = lds_raw + wave * 5120; float* pmax = (float*)(lds_raw + 8 * 5120); float* stp = pmax + 8 * 64;
    float cm[4] = {0.f, 0.f, 0.f, 0.f};
    for (int tk = wave; tk < D / 64; tk += 8) { const float* src = W + (size_t)(tk * 64 + (lane >> 4)) * N + tn * 64 + (lane & 15) * 4;
#pragma unroll
        for (int i = 0; i < 16; ++i) { const f32x4v v = *(const f32x4v*)(src + (size_t)(4 * i) * N);
#pragma unroll
            for (int j = 0; j < 4; ++j) cm[j] = fmaxf(cm[j], fabsf(v[j])); } }
#pragma unroll
    for (int j = 0; j < 4; ++j) { cm[j] = fmaxf(cm[j], __shfl_xor(cm[j], 16)); cm[j] = fmaxf(cm[j], __shfl_xor(cm[j], 32)); }
    if (lane < 16) {
#pragma unroll
        for (int j = 0; j < 4; ++j) pmax[wave * 64 + lane * 4 + j] = cm[j]; }
    __syncthreads();
    if (tid < 64) { float mx = 0.f;
#pragma unroll
        for (int w = 0; w < 8; ++w) mx = fmaxf(mx, pmax[w * 64 + tid]);
        const float s = (mx > 0.f) ? mx * (1.f / 127.f) : 1.f; stp[tid] = s; steps[tn * 64 + tid] = s; }
    __syncthreads();
    float inv[4];
#pragma unroll
    for (int j = 0; j < 4; ++j) inv[j] = 1.f / stp[(lane & 15) * 4 + j];
    for (int tk = wave; tk < D / 64; tk += 8) { const float* src = W + (size_t)(tk * 64 + (lane >> 4)) * N + tn * 64 + (lane & 15) * 4;
        f32x4v v[16];
#pragma unroll
        for (int i = 0; i < 16; ++i) v[i] = *(const f32x4v*)(src + (size_t)(4 * i) * N);
#pragma unroll
        for (int i = 0; i < 16; ++i) { const int k = 4 * i + (lane >> 4), n = (lane & 15) * 4;
#pragma unroll
            for (int j = 0; j < 4; ++j) ldsw[(n + j) * 80 + k] = (unsigned char)((int)rintf(v[i][j] * inv[j]) & 255); }
        asm volatile("s_waitcnt lgkmcnt(0)" ::: "memory");
#pragma unroll
        for (int i = 0; i < 4; ++i) { const int n = 16 * i + (lane >> 2), kc = (lane & 3) * 16;
            const u32x4v w = *(const u32x4v*)(ldsw + n * 80 + kc);
            *(u32x4v*)(Wt + (size_t)(tn * 64 + n) * D + tk * 64 + kc) = w; }
        asm volatile("s_waitcnt lgkmcnt(0)" ::: "memory"); }
    __syncthreads();
}
__device__ __forceinline__ void cvt_stream_fp8(const float* __restrict__ src, unsigned char* __restrict__ dst, size_t n16, float scale, int part, int nparts) {
    const size_t stride = (size_t)nparts * 512;
    for (size_t i = (size_t)part * 512 + mk_ltid(); i < n16; i += 4 * stride) {
        f32x4v a[4][4]; bool ok[4];
#pragma unroll
        for (int u = 0; u < 4; ++u) { const size_t j = i + u * stride; ok[u] = j < n16;
            if (ok[u]) {
#pragma unroll
                for (int q = 0; q < 4; ++q) a[u][q] = *(const f32x4v*)(src + j * 16 + q * 4); } }
#pragma unroll
        for (int u = 0; u < 4; ++u) if (ok[u]) { const size_t j = i + u * stride; u32x4v w;
#pragma unroll
            for (int q = 0; q < 4; ++q) { const f32x4v x = a[u][q] * scale; int d = 0;
                d = __builtin_amdgcn_cvt_pk_fp8_f32(x[0], x[1], d, false); d = __builtin_amdgcn_cvt_pk_fp8_f32(x[2], x[3], d, true); w[q] = (unsigned)d; }
            *(u32x4v*)(dst + j * 16) = w; }
    }
}
__device__ __forceinline__ void cvt_stream(const float* __restrict__ src, bf16* __restrict__ dst, size_t n8) {
    for (size_t i = (size_t)blockIdx.x * 512 + mk_ltid(); i < n8; i += (size_t)gridDim.x * 512) {
        const f32x4v a = *(const f32x4v*)(src + i * 8), b = *(const f32x4v*)(src + i * 8 + 4);
        u32x4v w; w[0] = pk2(a[0], a[1]); w[1] = pk2(a[2], a[3]); w[2] = pk2(b[0], b[1]); w[3] = pk2(b[2], b[3]);
        *(u32x4v*)(dst + i * 8) = w; }
}
__device__ __forceinline__ void sincos_d(double a, double& s, double& c) {
    const double k = __builtin_rint(a * 0.63661977236758134308);
    double r = __builtin_fma(-k, 1.57079632679489655800, a); r = __builtin_fma(-k, 6.12323399573676603587e-17, r);
    const double r2 = r * r;
    double sp = -7.6471637318198164759e-13; sp = sp * r2 + 1.6059043836821614599e-10; sp = sp * r2 - 2.5052108385441718775e-08; sp = sp * r2 + 2.7557319223985890653e-06;
    sp = sp * r2 - 1.9841269841269841270e-04; sp = sp * r2 + 8.3333333333333333333e-03; sp = sp * r2 - 1.6666666666666666667e-01; const double sr = r + r * r2 * sp;
    double cp = 4.7794773323873852974e-14; cp = cp * r2 - 1.1470745597729724714e-11; cp = cp * r2 + 2.0876756987868098979e-09; cp = cp * r2 - 2.7557319223985890653e-07;
    cp = cp * r2 + 2.4801587301587301587e-05; cp = cp * r2 - 1.3888888888888888889e-03; cp = cp * r2 + 4.1666666666666666667e-02; cp = cp * r2 - 0.5; const double cr = 1.0 + r2 * cp;
    const int q = ((int)k) & 3;
    s = (q == 0) ? sr : (q == 1) ? cr : (q == 2) ? -sr : -cr;
    c = (q == 0) ? cr : (q == 1) ? -sr : (q == 2) ? -cr : sr;
}

__device__ __forceinline__ void phase_prologue(const Params& p, unsigned char* lds_raw) {
    float* lds = (float*)lds_raw; unsigned char* ws = p.ws; const int tid = mk_ltid();
    { const int nt_inab = 32 * (NQ_AB / 64), nt_sq = 32 * 32, nt_inc = 32 * (NQ_C / 64);
      const int o1 = 2 * nt_inab, o2 = o1 + 2 * nt_sq, o3 = o2 + 2 * nt_inc, o4 = o3 + 2 * nt_sq, o5 = o4;
      const int wv_ = __builtin_amdgcn_readfirstlane(tid >> 6); unsigned char* ldsw = lds_raw + wv_ * (64 * 72 * 2);
      for (int t = blockIdx.x * 8 + wv_; t < o5; t += gridDim.x * 8) {
          const float* W; unsigned char* Wt; int N, tile;
          if (t < o1)      { const int i = t / nt_inab; tile = t - i * nt_inab; N = NQ_AB; W = p.ab_w_in + (size_t)i * D * NQ_AB; Wt = (ws + WS_WIN_AB) + (size_t)i * NQ_AB * D; }
          else if (t < o2) { const int u = t - o1, i = u / nt_sq; tile = u - i * nt_sq; N = D; W = p.ab_w_out + (size_t)i * D * D; Wt = (ws + WS_WOUT_AB) + (size_t)i * D * D; }
          else if (t < o3) { const int u = t - o2, i = u / nt_inc; tile = u - i * nt_inc; N = NQ_C; W = p.c_w_in + (size_t)i * D * NQ_C; Wt = (ws + WS_WIN_C) + (size_t)i * NQ_C * D; }
          else if (t < o4) { const int u = t - o3, i = u / nt_sq; tile = u - i * nt_sq; N = D; W = p.c_w_out + (size_t)i * D * D; Wt = (ws + WS_WOUT_C) + (size_t)i * D * D; }
          else             { const int u = t - o4, i = u / nt_sq; tile = u - i * nt_sq; N = D; W = p.peer_wq + (size_t)i * D * D; Wt = nullptr;
                             tr_tile_wave_bf16(W, (bf16*)(ws + WS_WPQ) + (size_t)i * D * D, D, N, tile, (bf16*)ldsw, tid & 63); }
          if (Wt != nullptr) tr_tile_wave(W, Wt, D, N, tile, ldsw, tid & 63);
      }
      __syncthreads();
      for (int t = blockIdx.x; t < DEPTH * (D / 64); t += gridDim.x) { const int i = t / (D / 64), tn = t - i * (D / 64);
          tr_strip_i8(p.peer_wq + (size_t)i * D * D, ws + WS_WPQ + (size_t)i * D * D, (float*)(ws + WS_PQSC) + (size_t)i * D, D, tn, lds_raw); } }
    cvt_rows_u4<false>(p.peer_u, ws + WS_U, (float*)(ws + WS_USC), NE, blockIdx.x, gridDim.x);
    cvt_rows_u4<true>(p.peer_v, ws + WS_V, (float*)(ws + WS_VSC), NE, blockIdx.x, gridDim.x);
    cvt_stream(p.peer_sk, (bf16*)(ws + WS_SK), (size_t)4 * 16 * 128 * 128 / 8);
    for (int i = blockIdx.x * 512 + tid; i < 128 * 32; i += gridDim.x * 512) {
        const int pp = i >> 5, j = i & 31;
        double fd = 1.0; for (int q = 0; q < j; ++q) fd *= 0.74989420933245582730;
        const float invf = (float)fd;
        const float ang = (float)pp * invf; double s, c; sincos_d((double)ang, s, c);
        ((float*)(ws + WS_ROPE))[i] = (float)c; ((float*)(ws + WS_ROPE))[128 * 32 + i] = (float)s; }
    { float* sv = lds;
      float* part = lds + 3 * D;
      for (int i = tid; i < 3 * D; i += 512) { const int r = i / D, k = i - r * D; const float v = (r < 2) ? p.c[r * D + k] : p.c_ctx[k]; sv[i] = v / (1.f + __expf(-v)); }
      __syncthreads();
      const int kq = tid >> 4, nq = tid & 15;
      for (int t = blockIdx.x; t < DEPTH * (NMOD / 64); t += gridDim.x) {
          const int l = t / (NMOD / 64), n0 = (t - l * (NMOD / 64)) * 64;
          const float* Wp = p.mod_w + (size_t)l * D * NMOD + (size_t)(kq * 64) * NMOD + n0 + nq * 4;
          f32x4v a0 = {0.f, 0.f, 0.f, 0.f}, a1 = a0, a2 = a0;
#pragma unroll 8
          for (int k = 0; k < 64; ++k) { const f32x4v w = __builtin_nontemporal_load((const f32x4v*)(Wp + (size_t)k * NMOD)); const int kk = kq * 64 + k;
              a0 += w * sv[kk]; a1 += w * sv[D + kk]; a2 += w * sv[2 * D + kk]; }
          float* pp = part + (kq * 3) * 64 + nq * 4;
#pragma unroll
          for (int e = 0; e < 4; ++e) { pp[e] = a0[e]; pp[64 + e] = a1[e]; pp[128 + e] = a2[e]; }
          __syncthreads();
          if (tid < 192) { const int r = tid >> 6, n = tid & 63; float s = 0.f;
#pragma unroll 8
              for (int q = 0; q < 32; ++q) s += part[(q * 3 + r) * 64 + n];
              ((float*)(ws + WS_MOD))[((size_t)l * 3 + r) * NMOD + n0 + n] = s + p.mod_b[(size_t)l * NMOD + n0 + n]; }
          __syncthreads();
      } }
}

__device__ __forceinline__ void phase_mod0(const Params& p) {
    const int tid_ = mk_ltid(); const int wave = __builtin_amdgcn_readfirstlane(tid_ >> 6), lane = tid_ & 63; const float* MOD = (const float*)(p.ws + WS_MOD); unsigned char* H8 = p.ws + WS_H8;
    const int rstride = gridDim.x * 8;
    for (int row = blockIdx.x * 8 + wave; row < T; row += 2 * rstride) {
        const int row2 = row + rstride; const bool has2 = row2 < T; const int rb = has2 ? row2 : row;
        const float* xa = (row < TL) ? p.x + (size_t)row * D : p.ctx + (size_t)(row - TL) * D;
        const float* xb = (rb < TL) ? p.x + (size_t)rb * D : p.ctx + (size_t)(rb - TL) * D;
        f32x4v va[8], vb[8];
#pragma unroll
        for (int i = 0; i < 8; ++i) { const int col = (i >> 1) * 512 + lane * 8 + (i & 1) * 4; va[i] = __builtin_nontemporal_load((const f32x4v*)(xa + col)); vb[i] = __builtin_nontemporal_load((const f32x4v*)(xb + col)); }
#pragma unroll
        for (int u = 0; u < 2; ++u) { const int rw = u ? rb : row; if (u && !has2) break;
            const int b = (rw < TL) ? (rw / L) : 2; const float* m = MOD + (size_t)b * NMOD;
#pragma unroll
            for (int j = 0; j < 4; ++j) { const int col = j * 512 + lane * 8; uint2 w;
#pragma unroll
                for (int hf = 0; hf < 2; ++hf) { const f32x4v xv = u ? vb[2 * j + hf] : va[2 * j + hf], sh = *(const f32x4v*)(m + col + hf * 4), sc = *(const f32x4v*)(m + D + col + hf * 4);
                    const f32x4v h = xv * (1.f + sc) + sh; const unsigned q = fp8_4(h[0], h[1], h[2], h[3]); if (hf == 0) w.x = q; else w.y = q; }
                *(uint2*)(H8 + (size_t)rw * D + col) = w; } }
    }
}
template <bool XIN_F32, bool XOUT_F32>
__device__ __forceinline__ void phase_ln(const void* xl, const void* xc, const bf16* __restrict__ y, const float* __restrict__ modg, int gidx,
                         const float* __restrict__ lng, const float* __restrict__ lnb, void* xol, void* xoc,
                         bf16* __restrict__ H, unsigned char* __restrict__ H8, const float* __restrict__ modn, int shi, int sci, int nrows, unsigned char* lds_raw,
                         unsigned char* __restrict__ HQ = nullptr, float* __restrict__ HSC = nullptr) {
    const int tid_ = mk_ltid(); const int wave = __builtin_amdgcn_readfirstlane(tid_ >> 6), lane = tid_ & 63;
    float* vec = (float*)lds_raw;
    constexpr int NXW = XIN_F32 ? 8 : 4;
    constexpr int RB = XIN_F32 ? 1 : 2;
    u32x4v xw[RB][NXW], yw[RB][4];
    int row = blockIdx.x * 8 + wave; const int rstride = gridDim.x * 8;
#define LN_ROFF(rr) (((rr) < TL) ? (size_t)(rr) * D : (size_t)((rr) - TL) * D)
#define LN_COL(i) (((i) >> 1) * 512 + lane * 8 + ((i) & 1) * 4)
#define LN_FETCH(u_, rr) do { const bool lat_ = (rr) < TL; const size_t ro_ = LN_ROFF(rr); \
        if constexpr (XIN_F32) { _Pragma("unroll") for (int i_ = 0; i_ < 8; ++i_) xw[u_][i_] = __builtin_nontemporal_load((const u32x4v*)((const float*)(lat_ ? xl : xc) + ro_ + LN_COL(i_))); } \
        else { _Pragma("unroll") for (int i_ = 0; i_ < 4; ++i_) xw[u_][i_] = *(const u32x4v*)((const bf16*)(lat_ ? xl : xc) + ro_ + i_ * 512 + lane * 8); } \
        _Pragma("unroll") for (int i_ = 0; i_ < 4; ++i_) yw[u_][i_] = *(const u32x4v*)(y + (size_t)(rr) * D + i_ * 512 + lane * 8); } while (0)
#pragma unroll
    for (int u = 0; u < RB; ++u) if (row + u * rstride < nrows) LN_FETCH(u, row + u * rstride);
    for (int i = tid_; i < 2048 / 4; i += 512) { const int di = ((i >> 7) * 2 + (i & 1)) * 64 + ((i >> 1) & 63);
        ((f32x4v*)vec)[di] = ((const f32x4v*)lng)[i]; ((f32x4v*)(vec + 2048))[di] = ((const f32x4v*)lnb)[i];
#pragma unroll
        for (int b = 0; b < 3; ++b) { ((f32x4v*)(vec + 4096 + b * 6144))[di] = ((const f32x4v*)(modg + (size_t)b * NMOD + (size_t)gidx * D))[i];
            ((f32x4v*)(vec + 4096 + b * 6144 + 2048))[di] = ((const f32x4v*)(modn + (size_t)b * NMOD + (size_t)shi * D))[i];
            ((f32x4v*)(vec + 4096 + b * 6144 + 4096))[di] = ((const f32x4v*)(modn + (size_t)b * NMOD + (size_t)sci * D))[i]; } }
    __syncthreads();
    while (row < nrows) {
        f32x4v z[RB][8]; float s[RB];
#pragma unroll
        for (int u = 0; u < RB; ++u) { const int rw = row + u * rstride; const int b = (rw < TL) ? (rw / L) : 2; s[u] = 0.f;
            const float* gv = vec + 4096 + b * 6144;
            if (rw < nrows) {
#pragma unroll
                for (int i = 0; i < 8; ++i) { const int col = i * 256 + lane * 4; f32x4v xv;
                    if constexpr (XIN_F32) xv = (f32x4v){__uint_as_float(xw[u][i][0]), __uint_as_float(xw[u][i][1]), __uint_as_float(xw[u][i][2]), __uint_as_float(xw[u][i][3])};
                    else { const unsigned x0 = xw[u][i >> 1][(i & 1) * 2], x1 = xw[u][i >> 1][(i & 1) * 2 + 1]; xv = (f32x4v){bflo(x0), bfhi(x0), bflo(x1), bfhi(x1)}; }
                    const f32x4v g = *(const f32x4v*)(gv + col); const unsigned y0 = yw[u][i >> 1][(i & 1) * 2], y1 = yw[u][i >> 1][(i & 1) * 2 + 1];
                    const f32x4v yv = {bflo(y0), bfhi(y0), bflo(y1), bfhi(y1)};
                    z[u][i] = xv * ALPHA + g * yv; s[u] += (z[u][i][0] + z[u][i][1]) + (z[u][i][2] + z[u][i][3]);
                    if ((i & 3) == 3) asm volatile("" ::: "memory"); } }
            asm volatile("" ::: "memory"); }
        const int nrow = row + RB * rstride;
#pragma unroll
        for (int u = 0; u < RB; ++u) if (nrow + u * rstride < nrows) LN_FETCH(u, nrow + u * rstride);
        asm volatile("" ::: "memory");
#pragma unroll
        for (int u = 0; u < RB; ++u) { const int rw = row + u * rstride;
            if (rw < nrows) {
                const bool lat = rw < TL; const int b = lat ? (rw / L) : 2; const size_t roff = LN_ROFF(rw);
                const float mean = wave_sum(s[u]) * (1.f / D); float q = 0.f;
#pragma unroll
                for (int i = 0; i < 8; ++i) { const f32x4v d = z[u][i] - mean; q += (d[0] * d[0] + d[1] * d[1]) + (d[2] * d[2] + d[3] * d[3]); }
                const float rstd = rsqrtf(wave_sum(q) * (1.f / D) + 1e-5f);
                f32x4v hk[8]; float amax = 0.f;
#pragma unroll
                for (int j = 0; j < 4; ++j) { const int gcol = j * 512 + lane * 8; f32x4v o2[2], h2[2];
#pragma unroll
                    for (int hf = 0; hf < 2; ++hf) { const int i = 2 * j + hf, col = i * 256 + lane * 4;
                        const f32x4v g = *(const f32x4v*)(vec + col), bb = *(const f32x4v*)(vec + 2048 + col);
                        o2[hf] = (z[u][i] - mean) * rstd * g + bb;
                        if (H8 || H || HQ) { const float* mm = vec + 4096 + b * 6144; const f32x4v sh = *(const f32x4v*)(mm + 2048 + col), sc = *(const f32x4v*)(mm + 4096 + col);
                            h2[hf] = o2[hf] * (1.f + sc) + sh;
                            if (HQ) { hk[i] = h2[hf]; amax = fmaxf(amax, fmaxf(fmaxf(fabsf(h2[hf][0]), fabsf(h2[hf][1])), fmaxf(fabsf(h2[hf][2]), fabsf(h2[hf][3])))); } } }
                    if constexpr (XOUT_F32) { __builtin_nontemporal_store(o2[0], (f32x4v*)((float*)(lat ? xol : xoc) + roff + gcol)); __builtin_nontemporal_store(o2[1], (f32x4v*)((float*)(lat ? xol : xoc) + roff + gcol + 4)); }
                    else { u32x4v w; w[0] = pk2(o2[0][0], o2[0][1]); w[1] = pk2(o2[0][2], o2[0][3]); w[2] = pk2(o2[1][0], o2[1][1]); w[3] = pk2(o2[1][2], o2[1][3]); *(u32x4v*)((bf16*)(lat ? xol : xoc) + roff + gcol) = w; }
                    if (H) { u32x4v w; w[0] = pk2(h2[0][0], h2[0][1]); w[1] = pk2(h2[0][2], h2[0][3]); w[2] = pk2(h2[1][0], h2[1][1]); w[3] = pk2(h2[1][2], h2[1][3]); *(u32x4v*)(H + (size_t)rw * D + gcol) = w; }
                    if (H8) { uint2 w; w.x = fp8_4(h2[0][0], h2[0][1], h2[0][2], h2[0][3]); w.y = fp8_4(h2[1][0], h2[1][1], h2[1][2], h2[1][3]); *(uint2*)(H8 + (size_t)rw * D + gcol) = w; }
                    asm volatile("" ::: "memory"); }
                if (HQ) {
                    amax = wave_max(amax); const float stp = (amax > 0.f) ? amax * (1.f / 127.f) : 1.f, inv = 1.f / stp;
#pragma unroll
                    for (int j = 0; j < 4; ++j) { uint2 w;
#pragma unroll
                        for (int hf = 0; hf < 2; ++hf) { const int i = 2 * j + hf;
                            const int q0 = (int)rintf(hk[i][0] * inv), q1 = (int)rintf(hk[i][1] * inv), q2 = (int)rintf(hk[i][2] * inv), q3 = (int)rintf(hk[i][3] * inv);
                            const unsigned v = (unsigned)(q0 & 255) | ((unsigned)(q1 & 255) << 8) | ((unsigned)(q2 & 255) << 16) | ((unsigned)(q3 & 255) << 24);
                            if (hf == 0) w.x = v; else w.y = v; }
                        *(uint2*)(HQ + (size_t)rw * D + j * 512 + lane * 8) = w; }
                    if (lane == 0) HSC[rw] = stp; } }
            asm volatile("" ::: "memory"); }
        row = nrow;
    }
#undef LN_ROFF
#undef LN_FETCH
#undef LN_COL
}

__device__ __forceinline__ void phase_prep(bf16* __restrict__ QKV, int ld, int cbase, int nheads, int nqh, bool isC, const float* __restrict__ qg, const float* __restrict__ kg, const float* __restrict__ rope, int ntok, unsigned char* __restrict__ K8img) {
    const long total = (long)ntok * nheads * 4;
    for (long task = (long)blockIdx.x * 512 + mk_ltid(); task < total; task += (long)gridDim.x * 512) {
        const int j = (int)(task & 3); const long th = task >> 2; const int hh = (int)(th % nheads); const int t = (int)(th / nheads);
        bf16* base = QKV + (size_t)t * ld + cbase + hh * 128 + j * 8;
        float x[4][8];
#pragma unroll
        for (int s = 0; s < 4; ++s) { const u32x4v w = *(const u32x4v*)(base + s * 32);
#pragma unroll
            for (int e = 0; e < 4; ++e) { x[s][2 * e] = bflo(w[e]); x[s][2 * e + 1] = bfhi(w[e]); } }
        if (isC) {
            float ss = 0.f;
#pragma unroll
            for (int s = 0; s < 4; ++s)
#pragma unroll
                for (int e = 0; e < 8; ++e) ss += x[s][e] * x[s][e];
            ss += __shfl_xor(ss, 1); ss += __shfl_xor(ss, 2);
            const float r = rsqrtf(ss * (1.f / 128.f) + 1e-6f); const float* gn = (hh < nqh) ? qg : kg;
#pragma unroll
            for (int s = 0; s < 4; ++s)
#pragma unroll
                for (int e = 0; e < 8; ++e) x[s][e] = x[s][e] * r * gn[s * 32 + j * 8 + e];
        }
        if (t < TL) {
            const int pos = t & (L - 1), prow = pos >> 6, pcol = pos & 63;
            const float* cr = rope + prow * 32 + j * 8; const float* sr = rope + 128 * 32 + prow * 32 + j * 8;
            const float* cc = rope + pcol * 32 + j * 8; const float* sc = rope + 128 * 32 + pcol * 32 + j * 8;
#pragma unroll
            for (int e = 0; e < 8; ++e) {
                const float a = x[0][e], b = x[1][e], c = x[2][e], d = x[3][e];
                x[0][e] = a * cr[e] - b * sr[e]; x[1][e] = b * cr[e] + a * sr[e];
                x[2][e] = c * cc[e] - d * sc[e]; x[3][e] = d * cc[e] + c * sc[e]; }
        }
#pragma unroll
        for (int s = 0; s < 4; ++s) { u32x4v w;
#pragma unroll
            for (int e = 0; e < 4; ++e) w[e] = pk2(x[s][2 * e], x[s][2 * e + 1]);
            *(u32x4v*)(base + s * 32) = w; }
        if (K8img) {
            const int b = (t < TL) ? (t >> 13) : ((t - TL) >> 8), kk = (t < TL) ? CL + (t & (L - 1)) : ((t - TL) & (CL - 1)), r = kk & 63;
            unsigned char* tb = K8img + ((size_t)((b * 4 + hh) * NTC + (kk >> 6))) * 8192 + r * 128;
#pragma unroll
            for (int s = 0; s < 4; ++s) { const int blk = s * 4 + j, pos = (blk >> 3) * 64 + (blk & 1) * 32 + ((blk & 7) >> 1) * 8;
                uint2 w; w.x = fp8_4(x[s][0], x[s][1], x[s][2], x[s][3]); w.y = fp8_4(x[s][4], x[s][5], x[s][6], x[s][7]);
                *(uint2*)(tb + (((pos >> 4) ^ ((r >> 1) & 7)) << 4) + (pos & 15)) = w; } }
    }
}
__device__ __forceinline__ void phase_vt8(const bf16* __restrict__ QKV, unsigned char* __restrict__ Vimg) {
    const int total = NB * 4 * ((CL + L) / 4) * 16;
    for (int task = blockIdx.x * 512 + mk_ltid(); task < total; task += gridDim.x * 512) {
        const int cb = task & 15, rest = task >> 4, q4 = rest % ((CL + L) / 4), bh = rest / ((CL + L) / 4), b = bh >> 2, kvh = bh & 3, kk = q4 * 4;
        const int trow = (kk < CL) ? TL + b * CL + kk : b * L + (kk - CL);
        const bf16* vp = QKV + (size_t)trow * NQ_C + 2560 + kvh * 128 + cb * 8;
        float v[4][8];
#pragma unroll
        for (int q = 0; q < 4; ++q) { const u32x4v w = *(const u32x4v*)(vp + (size_t)q * NQ_C);
#pragma unroll
            for (int e = 0; e < 4; ++e) { v[q][2 * e] = bflo(w[e]); v[q][2 * e + 1] = bfhi(w[e]); } }
        const int r0 = kk & 63, posk = ((r0 >> 2) & 1) * 32 + (((r0 & 31) >> 3) + 4 * (r0 >> 5)) * 4;
        unsigned char* tb = Vimg + ((size_t)(bh * NTC + (kk >> 6))) * 8192;
#pragma unroll
        for (int i = 0; i < 8; ++i) { const int c = cb * 8 + i;
            *(unsigned*)(tb + c * 64 + (((posk >> 4) ^ ((c >> 2) & 3)) << 4) + (posk & 15)) = fp8_4(v[0][i], v[1][i], v[2][i], v[3][i]); }
    }
}

struct NaiveQ { const bf16* q; bf16* o; float sink; bool has_sink; };
__device__ __forceinline__ float dot128(const u32x4v (&qv)[16], const bf16* __restrict__ kp) {
    float acc = 0.f;
#pragma unroll
    for (int i = 0; i < 16; ++i) { const u32x4v kv = *(const u32x4v*)(kp + i * 8);
#pragma unroll
        for (int e = 0; e < 4; ++e) { acc = fmaf(bflo(qv[i][e]), bflo(kv[e]), acc); acc = fmaf(bfhi(qv[i][e]), bfhi(kv[e]), acc); } }
    return acc;
}
struct SoftState { float m, l, o0, o1; };
__device__ __forceinline__ void naive_step(SoftState& st, const u32x4v (&qv)[16], const bf16* __restrict__ base, int off, bool valid, float bias, int voff, int lane) {
    float s = valid ? dot128(qv, base + off) * SCALE + bias : NEG;
    const float bm = wave_max(s), mn = fmaxf(st.m, bm);
    const float pr = valid ? __expf(s - mn) : 0.f, alpha = __expf(st.m - mn);
    st.l = st.l * alpha + wave_sum(pr); st.o0 *= alpha; st.o1 *= alpha; st.m = mn;
#pragma unroll 4
    for (int kk = 0; kk < 64; ++kk) {
        const float pk = __shfl(pr, kk); const int ok = __shfl(off, kk);
        const unsigned w = *(const unsigned*)(base + ok + voff + 2 * lane);
        st.o0 = fmaf(pk, bflo(w), st.o0); st.o1 = fmaf(pk, bfhi(w), st.o1); }
}
__device__ __forceinline__ void naive_finish(const SoftState& st, bool has_sink, float sink, bf16* op, int lane) {
    float l = st.l; if (has_sink) l += __expf(sink - st.m);
    const float inv = 1.f / l; *(unsigned*)(op + 2 * lane) = pk2(st.o0 * inv, st.o1 * inv);
}
__device__ __forceinline__ void load_q(u32x4v (&qv)[16], const bf16* qp) {
#pragma unroll
    for (int i = 0; i < 16; ++i) qv[i] = *(const u32x4v*)(qp + i * 8);
}

__device__ __forceinline__ void phase_attn_ab_naive(const bf16* __restrict__ QKV, bf16* __restrict__ ATT, const float* __restrict__ sinkv, const float* __restrict__ rpb, bool with_ctx) {
    constexpr int LD = NQ_AB; const int tid_ = mk_ltid(); const int wave = __builtin_amdgcn_readfirstlane(tid_ >> 6), lane = tid_ & 63;
    const long ntask = (long)(with_ctx ? T : TL) * 16;
    for (long task = (long)blockIdx.x * 8 + wave; task < ntask; task += (long)gridDim.x * 8) {
        const int t = (int)(task >> 4), hd = (int)(task & 15); const bool isA = hd < 8; const int h = hd & 7;
        const bool lat = t < TL; const int b = lat ? (t >> 13) : ((t - TL) >> 8);
        const int qcol = isA ? h * 128 : 1536 + h * 128, kcol = isA ? 1024 + (h >> 2) * 128 : 2560 + h * 128, voff = isA ? 256 : 1024;
        u32x4v qv[16]; load_q(qv, QKV + (size_t)t * LD + qcol);
        SoftState st{NEG, 0.f, 0.f, 0.f};
        const bf16* kc0 = QKV + (size_t)(TL + b * CL) * LD + kcol;
        if (lat) {
            const int pos = t & (L - 1); const bf16* kl0 = QKV + (size_t)(b * L) * LD + kcol;
            if (isA) {
                for (int s = 0; s < 5; ++s) { const int kp = pos - 128 + s * 64 + lane; const bool valid = kp >= 0 && kp < L && kp <= pos + 128;
                    naive_step(st, qv, kl0, (valid ? kp : 0) * LD, valid, 0.f, voff, lane); }
            } else {
                const int r = pos >> 6, c = pos & 63;
                const int rs = min(max(r - 4, 0), 120), wsx = min(max(c - 8, 0), 48);
                for (int s = 0; s < 2; ++s) { const int e = s * 64 + lane, kr = rs + (e >> 4), kcx = wsx + (e & 15);
                    const int dr = kr - r + 7, dc = min(max(kcx - c + 15, 0), 30);
                    const float bias = rpb[(h * 15 + dr) * 31 + dc];
                    naive_step(st, qv, kl0, (kr * 64 + kcx) * LD, true, bias, voff, lane); }
            }
        }
        for (int s = 0; s < 4; ++s) naive_step(st, qv, kc0, (s * 64 + lane) * LD, true, 0.f, voff, lane);
        naive_finish(st, isA, isA ? sinkv[h] : 0.f, ATT + (size_t)t * D + (isA ? h * 128 : 1024 + h * 128), lane);
    }
}
__device__ __forceinline__ void phase_attn_c_ctx_naive(const bf16* __restrict__ QKV, bf16* __restrict__ ATT) {
    constexpr int LD = NQ_C; const int tid_ = mk_ltid(); const int wave = __builtin_amdgcn_readfirstlane(tid_ >> 6), lane = tid_ & 63;
    for (int task = blockIdx.x * 8 + wave; task < TC * 16; task += gridDim.x * 8) {
        const int t = TL + (task >> 4), h = task & 15, b = (t - TL) >> 8;
        u32x4v qv[16]; load_q(qv, QKV + (size_t)t * LD + h * 128);
        SoftState st{NEG, 0.f, 0.f, 0.f};
        const bf16* kc0 = QKV + (size_t)(TL + b * CL) * LD + 2048 + (h >> 2) * 128;
        for (int s = 0; s < 4; ++s) naive_step(st, qv, kc0, (s * 64 + lane) * LD, true, 0.f, 512, lane);
        naive_finish(st, false, 0.f, ATT + (size_t)t * D + h * 128, lane);
    }
}
__device__ __forceinline__ void phase_attn_c_dense(const bf16* __restrict__ QKV, bf16* __restrict__ ATT, char* lds, bool with_ctx, const float* qg, const float* rope, const unsigned char* K8img, const unsigned char* Vt8img) {
    const att::MaskArgs ma{0, 0, 0, 0, nullptr, 0.f, false};
    for (int u = blockIdx.x; u < NB * 16 * (L / 256); u += gridDim.x) {
        const int g = u & 7, rest = u >> 3, b = g >> 2, kvh = g & 3, hq = kvh * 4 + (rest >> 5), qb = rest & 31;
        const bf16* Qb = QKV + (size_t)(b * L + qb * 256) * NQ_C + hq * 128;
        const bf16* Kc = QKV + (size_t)(TL + b * CL) * NQ_C + 2048 + kvh * 128;
        const bf16* Kl = QKV + (size_t)(b * L) * NQ_C + 2048 + kvh * 128;
#if MK_ATT_FP8
#if MK_ATT_I
        att::attn_body_fp8i<NQ_C, D, NTC>(Qb, K8img + (size_t)((b * 4 + kvh) * NTC) * 8192, Vt8img + (size_t)((b * 4 + kvh) * NTC) * 8192, (unsigned char*)ATT + (size_t)(b * L + qb * 256) * D + hq * 128, lds, att::QPrep{qg, rope, qb * 256, true, true});
#else
        att::attn_body_fp8<NQ_C, D>(Qb, K8img + (size_t)((b * 4 + kvh) * NTC) * 8192, Vt8img + (size_t)((b * 4 + kvh) * NTC) * 8192, (unsigned char*)ATT + (size_t)(b * L + qb * 256) * D + hq * 128, NTC, lds, att::QPrep{qg, rope, qb * 256, true, true});
#endif
#else
        att::attn_body<0, MK_SD_C, NQ_C, NQ_C, D>(Qb, Kc, Kl, 512, CL / 64, (unsigned char*)ATT + (size_t)(b * L + qb * 256) * D + hq * 128, (CL + L) / 64, lds, ma, att::QPrep{qg, rope, qb * 256, true, true});
#endif
        __syncthreads();
    }
    if (with_ctx) for (int u = blockIdx.x; u < NB * 16; u += gridDim.x) {
        const int b = u >> 4, hq = u & 15, kvh = hq >> 2;
        const bf16* Qb = QKV + (size_t)(TL + b * CL) * NQ_C + hq * 128;
        const bf16* Kc = QKV + (size_t)(TL + b * CL) * NQ_C + 2048 + kvh * 128;
        att::attn_body<0, MK_SD_C, NQ_C, NQ_C, D>(Qb, Kc, Kc, 512, CL / 64, (unsigned char*)ATT + (size_t)(TL + b * CL) * D + hq * 128, CL / 64, lds, ma, att::QPrep{qg, rope, 0, true, false});
        __syncthreads();
    }
}
__device__ __forceinline__ void phase_attn_ab(const bf16* __restrict__ QKV, bf16* __restrict__ ATT, const float* __restrict__ sinkv, const float* __restrict__ rpb, char* lds, bool with_ctx, const float* rope) {
    constexpr int LD = NQ_AB; float* bt = (float*)(lds + 69632);
    const int tid = mk_ltid();
    const int nunits = 1024 + (with_ctx ? 32 : 0);
    for (int u = blockIdx.x; u < nunits; u += gridDim.x) {
#ifndef MK_ABM
#define MK_ABM 7
#endif
        if (u < 512) {  if constexpr (MK_ABM & 1) {
            const int b = u >> 8, h = (u >> 5) & 7, qb = u & 31, r0 = qb * 4;
            int first = min(max(r0 - 4, 0), 120), lastr = min(max(r0 - 1, 0), 120) + 7;
            if (tid < 480) bt[tid] = rpb[(h * 15 + (tid >> 5)) * 31 + min(tid & 31, 30)] * (1.f / SCALE);
            const bf16* Qb = QKV + (size_t)(b * L + qb * 256) * LD + 1536 + h * 128;
            const bf16* Kc = QKV + (size_t)(TL + b * CL) * LD + 2560 + h * 128;
            const bf16* Kl = QKV + (size_t)(b * L + first * 64) * LD + 2560 + h * 128;
            const att::MaskArgs ma{0, 0, first, r0, bt, 0.f, false};
            att::attn_body_simple<2, LD, LD, D>(Qb, Kc, Kl, 1024, CL / 64, (unsigned char*)ATT + (size_t)(b * L + qb * 256) * D + 1024 + h * 128, CL / 64 + (lastr - first + 1), lds, ma, att::QPrep{nullptr, rope, 0, false, false});
        } } else if (u < 1024) {  if constexpr (MK_ABM & 2) {
            const int v = u - 512, b = v >> 8, hq = (v >> 5) & 7, qb = v & 31, kvh = hq >> 2, q0 = qb * 256;
            const int k0 = max(q0 - 128, 0), k1 = min(q0 + 384, L);
            const bf16* Qb = QKV + (size_t)(b * L + q0) * LD + hq * 128;
            const bf16* Kc = QKV + (size_t)(TL + b * CL) * LD + 1024 + kvh * 128;
            const bf16* Kl = QKV + (size_t)(b * L + k0) * LD + 1024 + kvh * 128;
            const att::MaskArgs ma{k0, q0, 0, 0, nullptr, sinkv[hq], true};
            att::attn_body_simple<1, LD, LD, D>(Qb, Kc, Kl, 256, CL / 64, (unsigned char*)ATT + (size_t)(b * L + q0) * D + hq * 128, CL / 64 + (k1 - k0) / 64, lds, ma, att::QPrep{nullptr, rope, q0, false, true});
        } } else {  if constexpr (MK_ABM & 4) {
            const int v = u - 1024, b = v >> 4, hd = v & 15, h = hd & 7; const bool isA = hd < 8;
            const int qcol = isA ? h * 128 : 1536 + h * 128, kcol = isA ? 1024 + (h >> 2) * 128 : 2560 + h * 128;
            const bf16* Qb = QKV + (size_t)(TL + b * CL) * LD + qcol;
            const bf16* Kc = QKV + (size_t)(TL + b * CL) * LD + kcol;
            const att::MaskArgs ma{0, 0, 0, 0, nullptr, isA ? sinkv[h] : 0.f, isA};
            att::attn_body_simple<0, LD, LD, D>(Qb, Kc, Kc, isA ? 256 : 1024, CL / 64, (unsigned char*)ATT + (size_t)(TL + b * CL) * D + (isA ? h * 128 : 1024 + h * 128), CL / 64, lds, ma, att::QPrep{nullptr, rope, 0, false, false});
        } }
        __syncthreads();
    }
}

#define MK_INSERT16(tv, ti, v_, id_) do { float v__ = (v_); int id__ = (id_); _Pragma("unroll") for (int k_ = 0; k_ < 16; ++k_) { const bool gt_ = v__ > tv[k_]; \
    const float ov_ = tv[k_]; const int oi_ = ti[k_]; tv[k_] = gt_ ? v__ : ov_; ti[k_] = gt_ ? id__ : oi_; v__ = gt_ ? ov_ : v__; id__ = gt_ ? oi_ : id__; } } while (0)
__device__ __forceinline__ void phase_sel1_naive(const bf16* __restrict__ PQ, const bf16* __restrict__ SK, float* __restrict__ TOPV, int* __restrict__ TOPI, int ntok) {
    const int tid_ = mk_ltid(); const int wave = __builtin_amdgcn_readfirstlane(tid_ >> 6), lane = tid_ & 63; const int ntile = ntok >> 6;
    for (int wt = blockIdx.x * 8 + wave; wt < ntile * 16; wt += gridDim.x * 8) {
        const int hp = __builtin_amdgcn_readfirstlane(wt & 15), t = (wt >> 4) * 64 + lane;
        u32x4v qv[16]; load_q(qv, PQ + (size_t)t * D + hp * 128);
        float tv[16]; int ti[16];
#pragma unroll
        for (int k = 0; k < 16; ++k) { tv[k] = -3.0e38f; ti[k] = 0; }
        const bf16* skb = SK + (size_t)hp * 128 * 128;
        for (int n = 0; n < 128; ++n) { const float s = dot128(qv, skb + n * 128); MK_INSERT16(tv, ti, s, n); }
        float* ov = TOPV + ((size_t)t * 16 + hp) * 16; int* oi = TOPI + ((size_t)t * 16 + hp) * 16;
#pragma unroll
        for (int k = 0; k < 16; ++k) { ov[k] = tv[k]; oi[k] = ti[k]; }
    }
}
__device__ __forceinline__ void phase_sel2_naive(const float* __restrict__ TOPV, const int* __restrict__ TOPI, int* __restrict__ IDX, float* __restrict__ GATE, int ntok) {
    for (int task = blockIdx.x * 512 + mk_ltid(); task < ntok * 8; task += gridDim.x * 512) {
        const float* av = TOPV + (size_t)task * 32; const int* ai = TOPI + (size_t)task * 32;
        float bv[16]; int bi[16];
#pragma unroll
        for (int k = 0; k < 16; ++k) { bv[k] = av[16 + k]; bi[k] = ai[16 + k]; }
        float tv[16]; int ti[16];
#pragma unroll
        for (int k = 0; k < 16; ++k) { tv[k] = -3.0e38f; ti[k] = 0; }
#pragma unroll 1
        for (int i = 0; i < 16; ++i) { const float a = av[i]; const int ia = ai[i] * 128;
#pragma unroll
            for (int j = 0; j < 16; ++j) MK_INSERT16(tv, ti, a + bv[j], ia + bi[j]); }
        float e[16], sum = 0.f;
#pragma unroll
        for (int k = 0; k < 16; ++k) { e[k] = __expf(tv[k] - tv[0]); sum += e[k]; }
        const float inv = 1.f / sum;
#pragma unroll
        for (int k = 0; k < 16; ++k) { IDX[(size_t)task * 16 + k] = ti[k]; GATE[(size_t)task * 16 + k] = e[k] * inv; }
    }
}

__device__ __forceinline__ unsigned key_of(float s, unsigned tag, unsigned mask) { unsigned u = __float_as_uint(s); u = (u & 0x80000000u) ? ~u : (u | 0x80000000u); return (u & ~mask) | tag; }
__device__ __forceinline__ float score_of(unsigned key, unsigned mask) { const unsigned m = key & ~mask; return __uint_as_float((m & 0x80000000u) ? (m ^ 0x80000000u) : ~m); }
#define CE(a, b) do { const unsigned hi__ = max((a), (b)), lo__ = min((a), (b)); (a) = hi__; (b) = lo__; } while (0)
#define SORT16(A, B0) do { CE(A[(B0) + 0], A[(B0) + 1]); CE(A[(B0) + 3], A[(B0) + 2]); CE(A[(B0) + 4], A[(B0) + 5]); CE(A[(B0) + 7], A[(B0) + 6]); CE(A[(B0) + 8], A[(B0) + 9]); CE(A[(B0) + 11], A[(B0) + 10]); CE(A[(B0) + 12], A[(B0) + 13]); CE(A[(B0) + 15], A[(B0) + 14]); CE(A[(B0) + 0], A[(B0) + 2]); CE(A[(B0) + 1], A[(B0) + 3]); CE(A[(B0) + 6], A[(B0) + 4]); CE(A[(B0) + 7], A[(B0) + 5]); CE(A[(B0) + 8], A[(B0) + 10]); CE(A[(B0) + 9], A[(B0) + 11]); CE(A[(B0) + 14], A[(B0) + 12]); CE(A[(B0) + 15], A[(B0) + 13]); CE(A[(B0) + 0], A[(B0) + 1]); CE(A[(B0) + 2], A[(B0) + 3]); CE(A[(B0) + 5], A[(B0) + 4]); CE(A[(B0) + 7], A[(B0) + 6]); CE(A[(B0) + 8], A[(B0) + 9]); CE(A[(B0) + 10], A[(B0) + 11]); CE(A[(B0) + 13], A[(B0) + 12]); CE(A[(B0) + 15], A[(B0) + 14]); CE(A[(B0) + 0], A[(B0) + 4]); CE(A[(B0) + 1], A[(B0) + 5]); CE(A[(B0) + 2], A[(B0) + 6]); CE(A[(B0) + 3], A[(B0) + 7]); CE(A[(B0) + 12], A[(B0) + 8]); CE(A[(B0) + 13], A[(B0) + 9]); CE(A[(B0) + 14], A[(B0) + 10]); CE(A[(B0) + 15], A[(B0) + 11]); CE(A[(B0) + 0], A[(B0) + 2]); CE(A[(B0) + 1], A[(B0) + 3]); CE(A[(B0) + 4], A[(B0) + 6]); CE(A[(B0) + 5], A[(B0) + 7]); CE(A[(B0) + 10], A[(B0) + 8]); CE(A[(B0) + 11], A[(B0) + 9]); CE(A[(B0) + 14], A[(B0) + 12]); CE(A[(B0) + 15], A[(B0) + 13]); CE(A[(B0) + 0], A[(B0) + 1]); CE(A[(B0) + 2], A[(B0) + 3]); CE(A[(B0) + 4], A[(B0) + 5]); CE(A[(B0) + 6], A[(B0) + 7]); CE(A[(B0) + 9], A[(B0) + 8]); CE(A[(B0) + 11], A[(B0) + 10]); CE(A[(B0) + 13], A[(B0) + 12]); CE(A[(B0) + 15], A[(B0) + 14]); CE(A[(B0) + 0], A[(B0) + 8]); CE(A[(B0) + 1], A[(B0) + 9]); CE(A[(B0) + 2], A[(B0) + 10]); CE(A[(B0) + 3], A[(B0) + 11]); CE(A[(B0) + 4], A[(B0) + 12]); CE(A[(B0) + 5], A[(B0) + 13]); CE(A[(B0) + 6], A[(B0) + 14]); CE(A[(B0) + 7], A[(B0) + 15]); CE(A[(B0) + 0], A[(B0) + 4]); CE(A[(B0) + 1], A[(B0) + 5]); CE(A[(B0) + 2], A[(B0) + 6]); CE(A[(B0) + 3], A[(B0) + 7]); CE(A[(B0) + 8], A[(B0) + 12]); CE(A[(B0) + 9], A[(B0) + 13]); CE(A[(B0) + 10], A[(B0) + 14]); CE(A[(B0) + 11], A[(B0) + 15]); CE(A[(B0) + 0], A[(B0) + 2]); CE(A[(B0) + 1], A[(B0) + 3]); CE(A[(B0) + 4], A[(B0) + 6]); CE(A[(B0) + 5], A[(B0) + 7]); CE(A[(B0) + 8], A[(B0) + 10]); CE(A[(B0) + 9], A[(B0) + 11]); CE(A[(B0) + 12], A[(B0) + 14]); CE(A[(B0) + 13], A[(B0) + 15]); CE(A[(B0) + 0], A[(B0) + 1]); CE(A[(B0) + 2], A[(B0) + 3]); CE(A[(B0) + 4], A[(B0) + 5]); CE(A[(B0) + 6], A[(B0) + 7]); CE(A[(B0) + 8], A[(B0) + 9]); CE(A[(B0) + 10], A[(B0) + 11]); CE(A[(B0) + 12], A[(B0) + 13]); CE(A[(B0) + 14], A[(B0) + 15]); } while (0)
#define MERGE16(A, B0) do { CE(A[(B0) + 0], A[(B0) + 8]); CE(A[(B0) + 1], A[(B0) + 9]); CE(A[(B0) + 2], A[(B0) + 10]); CE(A[(B0) + 3], A[(B0) + 11]); CE(A[(B0) + 4], A[(B0) + 12]); CE(A[(B0) + 5], A[(B0) + 13]); CE(A[(B0) + 6], A[(B0) + 14]); CE(A[(B0) + 7], A[(B0) + 15]); CE(A[(B0) + 0], A[(B0) + 4]); CE(A[(B0) + 1], A[(B0) + 5]); CE(A[(B0) + 2], A[(B0) + 6]); CE(A[(B0) + 3], A[(B0) + 7]); CE(A[(B0) + 8], A[(B0) + 12]); CE(A[(B0) + 9], A[(B0) + 13]); CE(A[(B0) + 10], A[(B0) + 14]); CE(A[(B0) + 11], A[(B0) + 15]); CE(A[(B0) + 0], A[(B0) + 2]); CE(A[(B0) + 1], A[(B0) + 3]); CE(A[(B0) + 4], A[(B0) + 6]); CE(A[(B0) + 5], A[(B0) + 7]); CE(A[(B0) + 8], A[(B0) + 10]); CE(A[(B0) + 9], A[(B0) + 11]); CE(A[(B0) + 12], A[(B0) + 14]); CE(A[(B0) + 13], A[(B0) + 15]); CE(A[(B0) + 0], A[(B0) + 1]); CE(A[(B0) + 2], A[(B0) + 3]); CE(A[(B0) + 4], A[(B0) + 5]); CE(A[(B0) + 6], A[(B0) + 7]); CE(A[(B0) + 8], A[(B0) + 9]); CE(A[(B0) + 10], A[(B0) + 11]); CE(A[(B0) + 12], A[(B0) + 13]); CE(A[(B0) + 14], A[(B0) + 15]); } while (0)
#define SEL_XLANE(SRC, OUT) do { unsigned lo_[16], hi_[16]; \
    _Pragma("unroll") for (int i_ = 0; i_ < 16; ++i_) { auto rr_ = __builtin_amdgcn_permlane32_swap(SRC[i_], SRC[i_], false, false); lo_[i_] = (unsigned)rr_[0]; hi_[i_] = (unsigned)rr_[1]; } \
    _Pragma("unroll") for (int i_ = 0; i_ < 16; ++i_) OUT[i_] = max(lo_[i_], hi_[15 - i_]); \
    MERGE16(OUT, 0); } while (0)
#define SEL_TOP16_OF64(KA, OUT) do { SORT16(KA, 0); SORT16(KA, 16); SORT16(KA, 32); SORT16(KA, 48); \
    _Pragma("unroll") for (int i_ = 0; i_ < 16; ++i_) KA[i_] = max(KA[i_], KA[31 - i_]); MERGE16(KA, 0); \
    _Pragma("unroll") for (int i_ = 0; i_ < 16; ++i_) KA[32 + i_] = max(KA[32 + i_], KA[63 - i_]); MERGE16(KA, 32); \
    _Pragma("unroll") for (int i_ = 0; i_ < 16; ++i_) KA[i_] = max(KA[i_], KA[47 - i_]); MERGE16(KA, 0); \
    SEL_XLANE(KA, OUT); } while (0)
__device__ __forceinline__ void phase_select(const bf16* __restrict__ PQ, const bf16* __restrict__ SK, int* __restrict__ IDX, float* __restrict__ GATE, int ntok, unsigned char* lds_raw) {
    typedef short bf16x8v __attribute__((ext_vector_type(8)));
    typedef float f32x16v __attribute__((ext_vector_type(16)));
    const int tid = mk_ltid(), wave = __builtin_amdgcn_readfirstlane(tid >> 6), lane = tid & 63, r32 = lane & 31, hi = lane >> 5;
    const int h = blockIdx.x & 7, rank = blockIdx.x >> 3, nrank = (gridDim.x + 7 - h) >> 3;
    unsigned char* sk_lds = lds_raw;
    int* tab = (int*)(lds_raw + 65536) + wave * (32 * 33) + r32 * 33;
    const int ntile = ntok >> 5;
    bf16x8v qn[8];
#define SEL_QLOAD(tl, pp) do { const bf16* qp_ = PQ + (size_t)((tl) * 32 + r32) * D + (h * 2 + (pp)) * 128 + hi * 8; \
        _Pragma("unroll") for (int ks_ = 0; ks_ < 8; ++ks_) qn[ks_] = *(const bf16x8v*)(qp_ + ks_ * 16); } while (0)
    if (rank * 8 + wave < ntile) SEL_QLOAD(rank * 8 + wave, 0);
    for (int i = tid; i < 2 * 128 * 16; i += 512) { const int row = i >> 4, ch = i & 15;
        const u32x4v w = *(const u32x4v*)(SK + (size_t)(h * 256 + row) * 128 + ch * 8);
        *(u32x4v*)(sk_lds + row * 256 + ((ch ^ (row & 7)) << 4)) = w; }
    __syncthreads();
    for (int tile = rank * 8 + wave; tile < ntile; tile += nrank * 8) {
        const int t0 = tile * 32;
        unsigned la[16], lb[16];
#pragma unroll
        for (int p = 0; p < 2; ++p) {
            bf16x8v qf[8];
#pragma unroll
            for (int ks = 0; ks < 8; ++ks) qf[ks] = qn[ks];
            if (p == 0) SEL_QLOAD(tile, 1); else if (tile + nrank * 8 < ntile) SEL_QLOAD(tile + nrank * 8, 0);
            asm volatile("" ::: "memory");
            f32x16v acc[4];
#pragma unroll
            for (int nb = 0; nb < 4; ++nb) acc[nb] = f32x16v{};
#pragma unroll
            for (int ks = 0; ks < 8; ++ks) {
#pragma unroll
                for (int nb = 0; nb < 4; ++nb) { const int row = p * 128 + nb * 32 + r32;
                    const bf16x8v kf = *(const bf16x8v*)(sk_lds + row * 256 + (((ks * 2 + hi) ^ (row & 7)) << 4));
                    acc[nb] = __builtin_amdgcn_mfma_f32_32x32x16_bf16(kf, qf[ks], acc[nb], 0, 0, 0); } }
            unsigned K[64];
#pragma unroll
            for (int nb = 0; nb < 4; ++nb)
#pragma unroll
                for (int r = 0; r < 16; ++r) { const int n = 32 * nb + (r & 3) + 8 * (r >> 2); K[nb * 16 + r] = key_of(acc[nb][r], 127u - (unsigned)(n + 4 * hi), 127u); }
            asm volatile("" ::: "memory"); __builtin_amdgcn_sched_barrier(0);
            if (p == 0) SEL_TOP16_OF64(K, la); else SEL_TOP16_OF64(K, lb);
            asm volatile("" ::: "memory"); __builtin_amdgcn_sched_barrier(0);
        }
        if (hi == 0) {
#pragma unroll
            for (int k = 0; k < 16; ++k) { tab[k] = 127 - (int)(la[k] & 127u); tab[16 + k] = 127 - (int)(lb[k] & 127u); } }
        float sa[16], sb[16];
#pragma unroll
        for (int k = 0; k < 16; ++k) { sa[k] = score_of(la[k], 127u); sb[k] = score_of(lb[k], 127u); }
        unsigned CK[32], best[16];
#pragma unroll
        for (int c = 25; c < 32; ++c) CK[c] = 0u;
        CK[0] = hi ? key_of(sa[2] + sb[1], 255u - 33u, 255u) : key_of(sa[0] + sb[0], 255u - 0u, 255u);
        CK[1] = hi ? key_of(sa[2] + sb[2], 255u - 34u, 255u) : key_of(sa[0] + sb[1], 255u - 1u, 255u);
        CK[2] = hi ? key_of(sa[2] + sb[3], 255u - 35u, 255u) : key_of(sa[0] + sb[2], 255u - 2u, 255u);
        CK[3] = hi ? key_of(sa[2] + sb[4], 255u - 36u, 255u) : key_of(sa[0] + sb[3], 255u - 3u, 255u);
        CK[4] = hi ? key_of(sa[3] + sb[0], 255u - 48u, 255u) : key_of(sa[0] + sb[4], 255u - 4u, 255u);
        CK[5] = hi ? key_of(sa[3] + sb[1], 255u - 49u, 255u) : key_of(sa[0] + sb[5], 255u - 5u, 255u);
        CK[6] = hi ? key_of(sa[3] + sb[2], 255u - 50u, 255u) : key_of(sa[0] + sb[6], 255u - 6u, 255u);
        CK[7] = hi ? key_of(sa[3] + sb[3], 255u - 51u, 255u) : key_of(sa[0] + sb[7], 255u - 7u, 255u);
        CK[8] = hi ? key_of(sa[4] + sb[0], 255u - 64u, 255u) : key_of(sa[0] + sb[8], 255u - 8u, 255u);
        CK[9] = hi ? key_of(sa[4] + sb[1], 255u - 65u, 255u) : key_of(sa[0] + sb[9], 255u - 9u, 255u);
        CK[10] = hi ? key_of(sa[4] + sb[2], 255u - 66u, 255u) : key_of(sa[0] + sb[10], 255u - 10u, 255u);
        CK[11] = hi ? key_of(sa[5] + sb[0], 255u - 80u, 255u) : key_of(sa[0] + sb[11], 255u - 11u, 255u);
        CK[12] = hi ? key_of(sa[5] + sb[1], 255u - 81u, 255u) : key_of(sa[0] + sb[12], 255u - 12u, 255u);
        CK[13] = hi ? key_of(sa[6] + sb[0], 255u - 96u, 255u) : key_of(sa[0] + sb[13], 255u - 13u, 255u);
        CK[14] = hi ? key_of(sa[6] + sb[1], 255u - 97u, 255u) : key_of(sa[0] + sb[14], 255u - 14u, 255u);
        CK[15] = hi ? key_of(sa[7] + sb[0], 255u - 112u, 255u) : key_of(sa[0] + sb[15], 255u - 15u, 255u);
        CK[16] = hi ? key_of(sa[7] + sb[1], 255u - 113u, 255u) : key_of(sa[1] + sb[0], 255u - 16u, 255u);
        CK[17] = hi ? key_of(sa[8] + sb[0], 255u - 128u, 255u) : key_of(sa[1] + sb[1], 255u - 17u, 255u);
        CK[18] = hi ? key_of(sa[9] + sb[0], 255u - 144u, 255u) : key_of(sa[1] + sb[2], 255u - 18u, 255u);
        CK[19] = hi ? key_of(sa[10] + sb[0], 255u - 160u, 255u) : key_of(sa[1] + sb[3], 255u - 19u, 255u);
        CK[20] = hi ? key_of(sa[11] + sb[0], 255u - 176u, 255u) : key_of(sa[1] + sb[4], 255u - 20u, 255u);
        CK[21] = hi ? key_of(sa[12] + sb[0], 255u - 192u, 255u) : key_of(sa[1] + sb[5], 255u - 21u, 255u);
        CK[22] = hi ? key_of(sa[13] + sb[0], 255u - 208u, 255u) : key_of(sa[1] + sb[6], 255u - 22u, 255u);
        CK[23] = hi ? key_of(sa[14] + sb[0], 255u - 224u, 255u) : key_of(sa[1] + sb[7], 255u - 23u, 255u);
        CK[24] = hi ? key_of(sa[15] + sb[0], 255u - 240u, 255u) : key_of(sa[2] + sb[0], 255u - 32u, 255u);
        SORT16(CK, 0); SORT16(CK, 16);
#pragma unroll
        for (int i = 0; i < 16; ++i) CK[i] = max(CK[i], CK[31 - i]);
        MERGE16(CK, 0);
        SEL_XLANE(CK, best);
        asm volatile("s_waitcnt lgkmcnt(0)" ::: "memory");
        float e[16], sum = 0.f; int eid[16]; const float mx = score_of(best[0], 255u);
#pragma unroll
        for (int k = 0; k < 16; ++k) { const int id = 255 - (int)(best[k] & 255u); eid[k] = tab[id >> 4] * 128 + tab[16 + (id & 15)];
            e[k] = __expf(score_of(best[k], 255u) - mx); sum += e[k]; }
        const float inv = 1.f / sum;
        typedef int i32x4v __attribute__((ext_vector_type(4)));
        int* ip = IDX + (size_t)(t0 + r32) * 128 + h * 16 + hi * 8; float* gp = GATE + (size_t)(t0 + r32) * 128 + h * 16 + hi * 8;
#pragma unroll
        for (int q = 0; q < 2; ++q) {
            i32x4v iv; f32x4v gv;
#pragma unroll
            for (int j = 0; j < 4; ++j) { iv[j] = hi ? eid[8 + q * 4 + j] : eid[q * 4 + j]; gv[j] = (hi ? e[8 + q * 4 + j] : e[q * 4 + j]) * inv; }
            *(i32x4v*)(ip + q * 4) = iv; *(f32x4v*)(gp + q * 4) = gv; }
        asm volatile("s_waitcnt lgkmcnt(0)" ::: "memory");
    }
}

typedef float f32x2v __attribute__((ext_vector_type(2)));
#define EXP_LOAD(R, tab, wi, s0) do { _Pragma("unroll") for (int e_ = 0; e_ < 8; ++e_) { const int id_ = __builtin_amdgcn_readfirstlane((wi)[(s0) + e_]); const unsigned char* rb_ = (tab) + (size_t)id_ * D; \
    R[e_ * 2] = *(const u32x4v*)(rb_ + loff); R[e_ * 2 + 1] = *(const u32x4v*)(rb_ + loff + 1024); } } while (0)
#define EXP_DOT(R, s0) do { float p_[8]; _Pragma("unroll") for (int e_ = 0; e_ < 8; ++e_) { float a_ = 0.f; \
    _Pragma("unroll") for (int c_ = 0; c_ < 2; ++c_) { _Pragma("unroll") for (int q_ = 0; q_ < 4; ++q_) { const int x_ = (int)R[e_ * 2 + c_][q_]; \
        const f32x2v lo_ = __builtin_amdgcn_cvt_pk_f32_fp8(x_, false), hi_ = __builtin_amdgcn_cvt_pk_f32_fp8(x_, true); \
        a_ = fmaf(lo_[0], hf[c_][4 * q_], a_); a_ = fmaf(lo_[1], hf[c_][4 * q_ + 1], a_); a_ = fmaf(hi_[0], hf[c_][4 * q_ + 2], a_); a_ = fmaf(hi_[1], hf[c_][4 * q_ + 3], a_); } } p_[e_] = a_; } \
    float r_[4], s2_[2]; \
    _Pragma("unroll") for (int i_ = 0; i_ < 4; ++i_) r_[i_] = (b5 ? p_[i_ + 4] : p_[i_]) + __shfl_xor(b5 ? p_[i_] : p_[i_ + 4], 32); \
    _Pragma("unroll") for (int i_ = 0; i_ < 2; ++i_) s2_[i_] = (b4 ? r_[i_ + 2] : r_[i_]) + __shfl_xor(b4 ? r_[i_] : r_[i_ + 2], 16); \
    float t_ = (b3 ? s2_[1] : s2_[0]) + __shfl_xor(b3 ? s2_[0] : s2_[1], 8); t_ += __shfl_xor(t_, 4); t_ += __shfl_xor(t_, 2); t_ += __shfl_xor(t_, 1); \
    if ((lane & 7) == 0) wsm[(s0) + (lane >> 3)] = t_ * (1.f / U_SCALE); } while (0)
#define EXP_FMA(R, s0) do { _Pragma("unroll") for (int e_ = 0; e_ < 8; ++e_) { const float w_ = wsm[(s0) + e_]; \
    _Pragma("unroll") for (int c_ = 0; c_ < 2; ++c_) { _Pragma("unroll") for (int q_ = 0; q_ < 4; ++q_) { const int x_ = (int)R[e_ * 2 + c_][q_]; \
        const f32x2v lo_ = __builtin_amdgcn_cvt_pk_f32_fp8(x_, false), hi_ = __builtin_amdgcn_cvt_pk_f32_fp8(x_, true); \
        acc[c_][4 * q_] = fmaf(w_, lo_[0], acc[c_][4 * q_]); acc[c_][4 * q_ + 1] = fmaf(w_, lo_[1], acc[c_][4 * q_ + 1]); \
        acc[c_][4 * q_ + 2] = fmaf(w_, hi_[0], acc[c_][4 * q_ + 2]); acc[c_][4 * q_ + 3] = fmaf(w_, hi_[1], acc[c_][4 * q_ + 3]); } } } } while (0)
#define EXP_SB() do { asm volatile("" ::: "memory"); __builtin_amdgcn_sched_barrier(0); } while (0)
#define EXP_PIN() do { _Pragma("unroll") for (int c_ = 0; c_ < 2; ++c_) { \
    asm volatile("" : "+v"(acc[c_][0]), "+v"(acc[c_][1]), "+v"(acc[c_][2]), "+v"(acc[c_][3]), "+v"(acc[c_][4]), "+v"(acc[c_][5]), "+v"(acc[c_][6]), "+v"(acc[c_][7]) :: "memory"); \
    asm volatile("" : "+v"(acc[c_][8]), "+v"(acc[c_][9]), "+v"(acc[c_][10]), "+v"(acc[c_][11]), "+v"(acc[c_][12]), "+v"(acc[c_][13]), "+v"(acc[c_][14]), "+v"(acc[c_][15]) :: "memory"); } } while (0)
__device__ __forceinline__ void phase_experts(const bf16* H, const unsigned char* __restrict__ U, const unsigned char* __restrict__ V, const int* __restrict__ IDX, const float* __restrict__ GATE,
                              int ntok, unsigned char* lds_raw,
                              const float* X, const float* __restrict__ modg, const float* __restrict__ lng, const float* __restrict__ lnb, float* XO, bf16* HO, const float* __restrict__ modn) {
    const int tid0 = mk_ltid(); const int wave = __builtin_amdgcn_readfirstlane(tid0 >> 6);
    float* vec = (float*)lds_raw + 3072;
    for (int i = tid0; i < 2048 / 4; i += 512) {
        ((f32x4v*)vec)[i] = ((const f32x4v*)lng)[i]; ((f32x4v*)(vec + 2048))[i] = ((const f32x4v*)lnb)[i];
#pragma unroll
        for (int b = 0; b < 3; ++b) { ((f32x4v*)(vec + 4096 + b * 6144))[i] = ((const f32x4v*)(modg + (size_t)b * NMOD + 5 * D))[i];
            ((f32x4v*)(vec + 4096 + b * 6144 + 2048))[i] = ((const f32x4v*)(modn + (size_t)b * NMOD))[i];
            ((f32x4v*)(vec + 4096 + b * 6144 + 4096))[i] = ((const f32x4v*)(modn + (size_t)b * NMOD + D))[i]; } }
    __syncthreads();
    int t = blockIdx.x * 8 + wave; const int tstride = gridDim.x * 8;
    if (t >= ntok) return;
    int* widx0 = (int*)lds_raw + wave * 384; float* wsm = (float*)lds_raw + wave * 384 + 256;
    u32x4v nH[4]; u32x4v RA[16], RB[16]; int pb = 0;
    { const int lane = tid0 & 63; const unsigned loff = (unsigned)lane * 16u;
      widx0[lane] = IDX[(size_t)t * 128 + lane]; widx0[64 + lane] = IDX[(size_t)t * 128 + 64 + lane];
#pragma unroll
      for (int c = 0; c < 4; ++c) nH[c] = *(const u32x4v*)(H + (size_t)t * D + (c >> 1) * 1024 + lane * 16 + (c & 1) * 8);
      asm volatile("s_waitcnt lgkmcnt(0)" ::: "memory");
      EXP_LOAD(RA, U, widx0, 0); EXP_SB(); }
    for (;;) {
        const int lane = mk_ltid() & 63;
        int* widx = widx0 + pb * 128; int* widxn = widx0 + (pb ^ 1) * 128;
        const bool b5 = lane & 32, b4 = lane & 16, b3 = lane & 8; const unsigned loff = (unsigned)lane * 16u;
        const int tn = t + tstride; const bool hasn = tn < ntok; const int tnc = hasn ? tn : t;
        float hf[2][16];
#pragma unroll
        for (int c = 0; c < 4; ++c)
#pragma unroll
            for (int e = 0; e < 4; ++e) { hf[c >> 1][(c & 1) * 8 + 2 * e] = bflo(nH[c][e]); hf[c >> 1][(c & 1) * 8 + 2 * e + 1] = bfhi(nH[c][e]); }
        const int nia = IDX[(size_t)tnc * 128 + lane], nib = IDX[(size_t)tnc * 128 + 64 + lane];
        const float g0 = GATE[(size_t)t * 128 + lane], g1 = GATE[(size_t)t * 128 + 64 + lane];
#pragma unroll
        for (int c = 0; c < 4; ++c) nH[c] = *(const u32x4v*)(H + (size_t)tnc * D + (c >> 1) * 1024 + lane * 16 + (c & 1) * 8);
        EXP_SB();
#pragma unroll 1
        for (int i = 0; i < 16; i += 2) {
            EXP_LOAD(RB, U, widx, i * 8 + 8); EXP_SB(); EXP_DOT(RA, i * 8); EXP_SB();
            { const unsigned char* tb_ = (i < 14) ? U : V; const int sn_ = (i < 14) ? i * 8 + 16 : 0; EXP_LOAD(RA, tb_, widx, sn_); }
            EXP_SB(); EXP_DOT(RB, i * 8 + 8); EXP_SB();
        }
        asm volatile("s_waitcnt lgkmcnt(0)" ::: "memory");
        { const float a0 = wsm[lane], a1 = wsm[64 + lane];
          asm volatile("s_waitcnt lgkmcnt(0)" ::: "memory");
          wsm[lane] = g0 * 0.5f * a0 * (1.f + erff(a0 * 0.70710678118654752f)); wsm[64 + lane] = g1 * 0.5f * a1 * (1.f + erff(a1 * 0.70710678118654752f));
          widxn[lane] = nia; widxn[64 + lane] = nib; }
        asm volatile("s_waitcnt lgkmcnt(0)" ::: "memory");
        f32x4v xr[8];
#pragma unroll
        for (int c = 0; c < 2; ++c)
#pragma unroll
            for (int q = 0; q < 4; ++q) xr[c * 4 + q] = *(const f32x4v*)(X + (size_t)t * D + c * 1024 + lane * 16 + q * 4);
        float acc[2][16];
#pragma unroll
        for (int c = 0; c < 2; ++c)
#pragma unroll
            for (int e = 0; e < 16; ++e) acc[c][e] = 0.f;
        EXP_SB();
#pragma unroll 1
        for (int i = 0; i < 16; i += 2) {
            EXP_LOAD(RB, V, widx, i * 8 + 8); EXP_SB(); EXP_FMA(RA, i * 8); EXP_PIN(); EXP_SB();
            { const unsigned char* tb_ = (i < 14) ? V : U; const int* wi_ = (i < 14) ? widx : widxn; const int sn_ = (i < 14) ? i * 8 + 16 : 0; EXP_LOAD(RA, tb_, wi_, sn_); }
            EXP_SB(); EXP_FMA(RB, i * 8 + 8); EXP_PIN(); EXP_SB();
        }
        { const int b = (t < TL) ? (t / L) : 2; const float* vb = vec + 4096 + b * 6144;
          float s = 0.f;
#pragma unroll
          for (int c = 0; c < 2; ++c)
#pragma unroll
              for (int q = 0; q < 4; ++q) { const int col = c * 1024 + lane * 16 + q * 4; const f32x4v g = *(const f32x4v*)(vb + col);
#pragma unroll
                  for (int j = 0; j < 4; ++j) { const float z = xr[c * 4 + q][j] * ALPHA + g[j] * (acc[c][4 * q + j] * (1.f / V_SCALE)); acc[c][4 * q + j] = z; s += z; } }
          const float mean = wave_sum(s) * (1.f / D); float qq = 0.f;
#pragma unroll
          for (int c = 0; c < 2; ++c)
#pragma unroll
              for (int j = 0; j < 16; ++j) { const float d = acc[c][j] - mean; qq += d * d; }
          const float rstd = rsqrtf(wave_sum(qq) * (1.f / D) + 1e-5f);
          float* xo = XO + (size_t)t * D;
#pragma unroll
          for (int c = 0; c < 2; ++c)
#pragma unroll
              for (int q = 0; q < 4; ++q) { const int col = c * 1024 + lane * 16 + q * 4; const f32x4v g = *(const f32x4v*)(vec + col), bb = *(const f32x4v*)(vec + 2048 + col); f32x4v o;
#pragma unroll
                  for (int j = 0; j < 4; ++j) o[j] = (acc[c][4 * q + j] - mean) * rstd * g[j] + bb[j];
                  *(f32x4v*)(xo + col) = o;
                  if (HO) { const f32x4v sh = *(const f32x4v*)(vb + 2048 + col), sc = *(const f32x4v*)(vb + 4096 + col); const f32x4v hh = o * (1.f + sc) + sh;
                      uint2 w; w.x = pk2(hh[0], hh[1]); w.y = pk2(hh[2], hh[3]); *(uint2*)(HO + (size_t)t * D + col) = w; } } }
        asm volatile("s_waitcnt lgkmcnt(0)" ::: "memory");
        if (!hasn) break;
        t = tn; pb ^= 1;
    }
    asm volatile("s_waitcnt vmcnt(0)" ::: "memory");
}

template <bool VPASS>
__device__ __forceinline__ void phase_exp_sliced(const unsigned char* __restrict__ TAB, const int* __restrict__ IDX, const bf16* __restrict__ H, const float* __restrict__ W,
                                                 bf16* __restrict__ PART, bf16* __restrict__ YB, int ntok, unsigned char* lds_raw) {
    const int tid = mk_ltid(), wave = __builtin_amdgcn_readfirstlane(tid >> 6), lane = tid & 63, r = lane >> 3, cq = lane & 7;
    const int xg = blockIdx.x & 7, rank = blockIdx.x >> 3, nrank = (gridDim.x + 7 - xg) >> 3, tstep = nrank * 8;
    const bool b5 = lane & 32, b4 = lane & 16, b3 = lane & 8, b2 = lane & 4, b1 = lane & 2, b0 = lane & 1;
    int* idl = (int*)lds_raw + wave * 256; float* wl = (float*)lds_raw + wave * 256 + 128;
#define XS_IDS(IR, tt) do { IR[0] = IDX[(size_t)(tt) * 128 + lane]; IR[1] = IDX[(size_t)(tt) * 128 + 64 + lane]; } while (0)
#define XS_ROWS(R, IR, kk) do { const unsigned char* tb_ = TAB + XS_SL(kk) * 128 + cq * 16; idl[lane] = IR[0]; idl[64 + lane] = IR[1]; \
        _Pragma("unroll") for (int i_ = 0; i_ < 16; ++i_) { const int id_ = idl[16 * r + i_]; R[i_] = *(const u32x4v*)(tb_ + (size_t)id_ * D); } } while (0)
#define XS_AUX(A, tt, kk) do { const int s = XS_SL(kk); if constexpr (VPASS) { A[0] = __float_as_uint(W[(size_t)(tt) * 128 + lane]); A[1] = __float_as_uint(W[(size_t)(tt) * 128 + 64 + lane]); } \
        else { const u32x4v a0_ = *(const u32x4v*)(H + (size_t)(tt) * D + s * 128 + cq * 16), a1_ = *(const u32x4v*)(H + (size_t)(tt) * D + s * 128 + cq * 16 + 8); \
               _Pragma("unroll") for (int i_ = 0; i_ < 4; ++i_) { A[i_] = a0_[i_]; A[4 + i_] = a1_[i_]; } } } while (0)
#define XS_COMPUTE(R, A, tt, kk) do { const int s = XS_SL(kk); if constexpr (VPASS) { \
        wl[lane] = __uint_as_float(A[0]); wl[64 + lane] = __uint_as_float(A[1]); \
        f32x2v ac_[8]; _Pragma("unroll") for (int j_ = 0; j_ < 8; ++j_) ac_[j_] = (f32x2v){0.f, 0.f}; \
        _Pragma("unroll") for (int i_ = 0; i_ < 16; ++i_) { const float w_ = wl[16 * r + i_]; const f32x2v w2_ = {w_, w_}; \
            _Pragma("unroll") for (int q_ = 0; q_ < 4; ++q_) { const int x_ = (int)R[i_][q_]; \
                ac_[2 * q_] += w2_ * __builtin_amdgcn_cvt_pk_f32_fp8(x_, false); ac_[2 * q_ + 1] += w2_ * __builtin_amdgcn_cvt_pk_f32_fp8(x_, true); } } \
        float a_[16]; _Pragma("unroll") for (int j_ = 0; j_ < 8; ++j_) { a_[2 * j_] = ac_[j_][0]; a_[2 * j_ + 1] = ac_[j_][1]; } \
        float q8_[8], q4_[4], q2_[2]; \
        _Pragma("unroll") for (int k_ = 0; k_ < 8; ++k_) q8_[k_] = (b5 ? a_[k_ + 8] : a_[k_]) + __shfl_xor(b5 ? a_[k_] : a_[k_ + 8], 32); \
        _Pragma("unroll") for (int k_ = 0; k_ < 4; ++k_) q4_[k_] = (b4 ? q8_[k_ + 4] : q8_[k_]) + __shfl_xor(b4 ? q8_[k_] : q8_[k_ + 4], 16); \
        _Pragma("unroll") for (int k_ = 0; k_ < 2; ++k_) q2_[k_] = (b3 ? q4_[k_ + 2] : q4_[k_]) + __shfl_xor(b3 ? q4_[k_] : q4_[k_ + 2], 8); \
        *(unsigned*)(YB + (size_t)(tt) * D + s * 128 + cq * 16 + r * 2) = pk2(q2_[0] * (1.f / V_SCALE), q2_[1] * (1.f / V_SCALE)); \
    } else { \
        f32x2v h2_[8]; _Pragma("unroll") for (int j_ = 0; j_ < 8; ++j_) h2_[j_] = (f32x2v){bflo(A[j_]), bfhi(A[j_])}; \
        float p_[16]; \
        _Pragma("unroll") for (int i_ = 0; i_ < 16; ++i_) { f32x2v d_ = {0.f, 0.f}; \
            _Pragma("unroll") for (int q_ = 0; q_ < 4; ++q_) { const int x_ = (int)R[i_][q_]; \
                d_ += h2_[2 * q_] * __builtin_amdgcn_cvt_pk_f32_fp8(x_, false); d_ += h2_[2 * q_ + 1] * __builtin_amdgcn_cvt_pk_f32_fp8(x_, true); } \
            p_[i_] = d_[0] + d_[1]; } \
        float q8_[8], q4_[4], q2_[2]; \
        _Pragma("unroll") for (int k_ = 0; k_ < 8; ++k_) q8_[k_] = (b2 ? p_[k_ + 8] : p_[k_]) + __shfl_xor(b2 ? p_[k_] : p_[k_ + 8], 4); \
        _Pragma("unroll") for (int k_ = 0; k_ < 4; ++k_) q4_[k_] = (b1 ? q8_[k_ + 4] : q8_[k_]) + __shfl_xor(b1 ? q8_[k_] : q8_[k_ + 4], 2); \
        _Pragma("unroll") for (int k_ = 0; k_ < 2; ++k_) q2_[k_] = (b0 ? q4_[k_ + 2] : q4_[k_]) + __shfl_xor(b0 ? q4_[k_] : q4_[k_ + 2], 1); \
        *(unsigned*)(PART + ((size_t)s * T + (tt)) * 128 + 16 * r + 2 * cq) = pk2(q2_[0] * (1.f / U_SCALE), q2_[1] * (1.f / U_SCALE)); \
    } } while (0)
    constexpr int NAUX = VPASS ? 2 : 8;
    const int t0 = rank * 8 + wave;
    if (t0 < ntok) {
        const int nj = (ntok - t0 + tstep - 1) / tstep, ntask = 2 * nj;
#define XS_SL(kk) (xg + (((kk) >= nj) ? 8 : 0))
#define XS_TOK(kk) (t0 + (((kk) >= nj) ? (kk) - nj : (kk)) * tstep)
        int idn[2]; u32x4v RA[16], RB[16]; unsigned auxP[NAUX], auxQ[NAUX];
        int k = 0;
        XS_IDS(idn, XS_TOK(0)); XS_AUX(auxP, XS_TOK(0), 0);
        XS_ROWS(RA, idn, 0);
        { const int k1 = (1 < ntask) ? 1 : 0; XS_IDS(idn, XS_TOK(k1)); }
        EXP_SB();
        for (;;) {
            { const int k1 = (k + 1 < ntask) ? k + 1 : k, k2 = (k + 2 < ntask) ? k + 2 : k1;
              XS_ROWS(RB, idn, k1); XS_IDS(idn, XS_TOK(k2)); XS_AUX(auxQ, XS_TOK(k1), k1); EXP_SB();
              XS_COMPUTE(RA, auxP, XS_TOK(k), k); EXP_SB();
              if (++k >= ntask) break; }
            { const int k1 = (k + 1 < ntask) ? k + 1 : k, k2 = (k + 2 < ntask) ? k + 2 : k1;
              XS_ROWS(RA, idn, k1); XS_IDS(idn, XS_TOK(k2)); XS_AUX(auxP, XS_TOK(k1), k1); EXP_SB();
              XS_COMPUTE(RB, auxQ, XS_TOK(k), k); EXP_SB();
              if (++k >= ntask) break; }
        }
        asm volatile("s_waitcnt vmcnt(0)" ::: "memory");
#undef XS_SL
#undef XS_TOK
    }
#undef XS_IDS
#undef XS_ROWS
#undef XS_AUX
#undef XS_COMPUTE
}
__device__ __forceinline__ void phase_exp_u4(const unsigned char* __restrict__ TAB, const int* __restrict__ IDX, const unsigned char* __restrict__ HQ,
                                             bf16* __restrict__ PART, int ntok, unsigned char* lds_raw) {
    const int tid = mk_ltid(), wave = __builtin_amdgcn_readfirstlane(tid >> 6), lane = tid & 63, r = lane >> 3, cq = lane & 7;
    const int s = blockIdx.x & 7, rank = blockIdx.x >> 3, nrank = (gridDim.x + 7 - s) >> 3, tstep = nrank * 8;
    const bool b2 = lane & 4, b1 = lane & 2, b0 = lane & 1;
    int* idl = (int*)lds_raw + wave * 256;
    const unsigned char* tbs = TAB + (size_t)s * NE * 128; const unsigned cq16 = cq * 16; const unsigned char* hb = HQ + s * 256 + cq * 32;
#define U4_IDS(IR, tt) do { IR[0] = IDX[(size_t)(tt) * 128 + lane]; IR[1] = IDX[(size_t)(tt) * 128 + 64 + lane]; } while (0)
#define U4_ROWS(R, IR) do { idl[lane] = IR[0]; idl[64 + lane] = IR[1]; \
        _Pragma("unroll") for (int i_ = 0; i_ < 16; ++i_) { const unsigned off_ = (unsigned)idl[16 * r + i_] * 128u + cq16; R[i_] = *(const u32x4v*)(tbs + off_); } } while (0)
#define U4_AUX(A, tt) do { const u32x4v a0_ = *(const u32x4v*)(hb + (size_t)(tt) * D), a1_ = *(const u32x4v*)(hb + (size_t)(tt) * D + 16); \
        _Pragma("unroll") for (int i_ = 0; i_ < 4; ++i_) { A[i_] = a0_[i_]; A[4 + i_] = a1_[i_]; } } while (0)
#define U4_COMPUTE(R, A, tt) do { int hs_ = 0; _Pragma("unroll") for (int j_ = 0; j_ < 8; ++j_) hs_ = __builtin_amdgcn_sdot4(0x01010101, (int)A[j_], hs_, false); \
        float p_[16]; \
        _Pragma("unroll") for (int i_ = 0; i_ < 16; ++i_) { int acc_ = 0; \
            _Pragma("unroll") for (int k_ = 0; k_ < 4; ++k_) { const unsigned x_ = R[i_][k_]; \
                acc_ = __builtin_amdgcn_sdot4((int)(x_ & 0x0F0F0F0Fu), (int)A[2 * k_], acc_, false); acc_ = __builtin_amdgcn_sdot4((int)((x_ >> 4) & 0x0F0F0F0Fu), (int)A[2 * k_ + 1], acc_, false); } \
            p_[i_] = (float)(acc_ - 8 * hs_); } \
        float q8_[8], q4_[4], q2_[2]; \
        _Pragma("unroll") for (int k_ = 0; k_ < 8; ++k_) q8_[k_] = (b2 ? p_[k_ + 8] : p_[k_]) + __shfl_xor(b2 ? p_[k_] : p_[k_ + 8], 4); \
        _Pragma("unroll") for (int k_ = 0; k_ < 4; ++k_) q4_[k_] = (b1 ? q8_[k_ + 4] : q8_[k_]) + __shfl_xor(b1 ? q8_[k_] : q8_[k_ + 4], 2); \
        _Pragma("unroll") for (int k_ = 0; k_ < 2; ++k_) q2_[k_] = (b0 ? q4_[k_ + 2] : q4_[k_]) + __shfl_xor(b0 ? q4_[k_] : q4_[k_ + 2], 1); \
        *(unsigned*)(PART + ((size_t)s * T + (tt)) * 128 + 16 * r + 2 * cq) = pk2(q2_[0], q2_[1]); } while (0)
    const int t0 = rank * 8 + wave;
    if (t0 < ntok) {
        const int ntask = (ntok - t0 + tstep - 1) / tstep;
#define U4_TOK(kk) (t0 + (kk) * tstep)
        int idn[2]; u32x4v RA[16], RB[16]; unsigned auxP[8], auxQ[8];
        int k = 0;
        U4_IDS(idn, U4_TOK(0)); U4_AUX(auxP, U4_TOK(0));
        U4_ROWS(RA, idn);
        { const int k1 = (1 < ntask) ? 1 : 0; U4_IDS(idn, U4_TOK(k1)); }
        EXP_SB();
        for (;;) {
            { const int k1 = (k + 1 < ntask) ? k + 1 : k, k2 = (k + 2 < ntask) ? k + 2 : k1;
              U4_ROWS(RB, idn); U4_IDS(idn, U4_TOK(k2)); U4_AUX(auxQ, U4_TOK(k1)); EXP_SB();
              U4_COMPUTE(RA, auxP, U4_TOK(k)); EXP_SB();
              if (++k >= ntask) break; }
            { const int k1 = (k + 1 < ntask) ? k + 1 : k, k2 = (k + 2 < ntask) ? k + 2 : k1;
              U4_ROWS(RA, idn); U4_IDS(idn, U4_TOK(k2)); U4_AUX(auxP, U4_TOK(k1)); EXP_SB();
              U4_COMPUTE(RB, auxQ, U4_TOK(k)); EXP_SB();
              if (++k >= ntask) break; }
        }
        asm volatile("s_waitcnt vmcnt(0)" ::: "memory");
#undef U4_TOK
    }
#undef U4_IDS
#undef U4_ROWS
#undef U4_AUX
#undef U4_COMPUTE
}
__device__ __forceinline__ void phase_exp_v4(const unsigned char* __restrict__ TAB, const int* __restrict__ IDX, const unsigned char* __restrict__ WQ, const float* __restrict__ WSC,
                                             bf16* __restrict__ YB, int ntok) {
    typedef int i32x4w __attribute__((ext_vector_type(4)));
    const int tid = mk_ltid(), wave = __builtin_amdgcn_readfirstlane(tid >> 6), lane = tid & 63, tk = lane >> 3, cq = lane & 7;
    const int s = blockIdx.x & 7, rank = blockIdx.x >> 3, nrank = (gridDim.x + 7 - s) >> 3, gstride = nrank * 8, ngroups = ntok >> 3;
    const unsigned char* tbs = TAB + (size_t)s * NE * 128; const unsigned cq16 = cq * 16;
    const int g0 = wave * nrank + rank;
#define V4_TT(kk) ((g0 + ((kk) >> 3) * gstride) * 8 + tk)
#define V4_IDS(ID, kk) do { const int* ip_ = IDX + (size_t)V4_TT(kk) * 128 + 16 * ((kk) & 7); _Pragma("unroll") for (int g_ = 0; g_ < 4; ++g_) ID[g_] = *(const i32x4w*)(ip_ + 4 * g_); } while (0)
#define V4_ROWS(R, ID) do { _Pragma("unroll") for (int i_ = 0; i_ < 16; ++i_) R[i_] = *(const u32x4v*)(tbs + ((unsigned)ID[i_ >> 2][i_ & 3] * 128u + cq16)); } while (0)
#define V4_AUX(A, kk) do { A = *(const u32x4v*)(WQ + (size_t)V4_TT(kk) * 128 + 16 * ((kk) & 7)); } while (0)
#define V4_COMPUTE(R, A, kk) do { \
        _Pragma("unroll") for (int g_ = 0; g_ < 4; ++g_) wsum = __builtin_amdgcn_sdot4(0x01010101, (int)A[g_], wsum, false); \
        _Pragma("unroll") for (int g_ = 0; g_ < 4; ++g_) { const int w4_ = (int)A[g_]; \
            _Pragma("unroll") for (int k_ = 0; k_ < 4; ++k_) { \
                const unsigned x0_ = R[4 * g_][k_], x1_ = R[4 * g_ + 1][k_], x2_ = R[4 * g_ + 2][k_], x3_ = R[4 * g_ + 3][k_]; \
                  \
                const unsigned u0_ = __builtin_amdgcn_perm(x1_, x0_, 0x05010400u), u1_ = __builtin_amdgcn_perm(x1_, x0_, 0x07030602u), u2_ = __builtin_amdgcn_perm(x3_, x2_, 0x05010400u), u3_ = __builtin_amdgcn_perm(x3_, x2_, 0x07030602u); \
                const unsigned t0_ = __builtin_amdgcn_perm(u2_, u0_, 0x05040100u), t1_ = __builtin_amdgcn_perm(u2_, u0_, 0x07060302u), t2_ = __builtin_amdgcn_perm(u3_, u1_, 0x05040100u), t3_ = __builtin_amdgcn_perm(u3_, u1_, 0x07060302u); \
                acc[8 * k_ + 0] = __builtin_amdgcn_sdot4((int)(t0_ & 0x0F0F0F0Fu), w4_, acc[8 * k_ + 0], false); acc[8 * k_ + 4] = __builtin_amdgcn_sdot4((int)t0_, w4_, acc[8 * k_ + 4], false); \
                acc[8 * k_ + 1] = __builtin_amdgcn_sdot4((int)(t1_ & 0x0F0F0F0Fu), w4_, acc[8 * k_ + 1], false); acc[8 * k_ + 5] = __builtin_amdgcn_sdot4((int)t1_, w4_, acc[8 * k_ + 5], false); \
                acc[8 * k_ + 2] = __builtin_amdgcn_sdot4((int)(t2_ & 0x0F0F0F0Fu), w4_, acc[8 * k_ + 2], false); acc[8 * k_ + 6] = __builtin_amdgcn_sdot4((int)t2_, w4_, acc[8 * k_ + 6], false); \
                acc[8 * k_ + 3] = __builtin_amdgcn_sdot4((int)(t3_ & 0x0F0F0F0Fu), w4_, acc[8 * k_ + 3], false); acc[8 * k_ + 7] = __builtin_amdgcn_sdot4((int)t3_, w4_, acc[8 * k_ + 7], false); } } \
        if (((kk) & 7) == 7) {            \
            const int tt_ = V4_TT(kk); const float sc_ = WSC[tt_]; bf16* yo_ = YB + (size_t)tt_ * D + s * 256 + cq * 32; \
            _Pragma("unroll") for (int k_ = 0; k_ < 4; ++k_) { float lo_[4], hi_[4]; \
                _Pragma("unroll") for (int c_ = 0; c_ < 4; ++c_) { lo_[c_] = (float)(acc[8 * k_ + c_] - 8 * wsum) * sc_; hi_[c_] = (float)((acc[8 * k_ + 4 + c_] - acc[8 * k_ + c_]) >> 4) * sc_; } \
                u32x4v o_; o_[0] = pk2(lo_[0], lo_[1]); o_[1] = pk2(lo_[2], lo_[3]); o_[2] = pk2(hi_[0], hi_[1]); o_[3] = pk2(hi_[2], hi_[3]); \
                *(u32x4v*)(yo_ + 8 * k_) = o_; } \
            _Pragma("unroll") for (int c_ = 0; c_ < 32; ++c_) acc[c_] = 0; \
            wsum = 0; } } while (0)
    if (g0 < ngroups) {
        const int ntask = ((ngroups - g0 + gstride - 1) / gstride) * 8;
        i32x4w idn[4]; u32x4v RA[16], RB[16]; u32x4v auxP, auxQ;
        int acc[32], wsum = 0;
#pragma unroll
        for (int c = 0; c < 32; ++c) acc[c] = 0;
        int k = 0;
        V4_IDS(idn, 0); V4_AUX(auxP, 0);
        V4_ROWS(RA, idn);
        V4_IDS(idn, 1);
        EXP_SB();
        for (;;) {
            { const int k1 = (k + 1 < ntask) ? k + 1 : k, k2 = (k + 2 < ntask) ? k + 2 : k1;
              V4_ROWS(RB, idn); V4_IDS(idn, k2); V4_AUX(auxQ, k1); EXP_SB();
              V4_COMPUTE(RA, auxP, k); EXP_SB();
              if (++k >= ntask) break; }
            { const int k1 = (k + 1 < ntask) ? k + 1 : k, k2 = (k + 2 < ntask) ? k + 2 : k1;
              V4_ROWS(RA, idn); V4_IDS(idn, k2); V4_AUX(auxP, k1); EXP_SB();
              V4_COMPUTE(RB, auxQ, k); EXP_SB();
              if (++k >= ntask) break; }
        }
        asm volatile("s_waitcnt vmcnt(0)" ::: "memory");
    }
#undef V4_TT
#undef V4_IDS
#undef V4_ROWS
#undef V4_AUX
#undef V4_COMPUTE
}
__device__ __forceinline__ void phase_exp_w(const bf16* __restrict__ PART, const float* __restrict__ GATE, const int* __restrict__ IDX, const float* __restrict__ usteps, const float* __restrict__ hsteps,
                                            const float* __restrict__ vsteps, unsigned char* __restrict__ WQ, float* __restrict__ WSC, int ntok) {
    const size_t n8 = (size_t)ntok * 16, stride = (size_t)gridDim.x * 512;
    for (size_t i = (size_t)blockIdx.x * 512 + mk_ltid(); i < n8; i += stride) {
        float a[8];
#pragma unroll
        for (int q = 0; q < 8; ++q) a[q] = 0.f;
#pragma unroll
        for (int s = 0; s < 8; ++s) { const u32x4v w = *(const u32x4v*)(PART + (size_t)s * T * 128 + i * 8);
#pragma unroll
            for (int q = 0; q < 4; ++q) { a[2 * q] += bflo(w[q]); a[2 * q + 1] += bfhi(w[q]); } }
        typedef int i32x4w __attribute__((ext_vector_type(4)));
        const i32x4w e0 = *(const i32x4w*)(IDX + i * 8), e1 = *(const i32x4w*)(IDX + i * 8 + 4); const float hs = hsteps[i >> 4];
#pragma unroll
        for (int q = 0; q < 4; ++q) { a[q] *= usteps[e0[q]] * hs; a[4 + q] *= usteps[e1[q]] * hs; }
        const f32x4v g0 = *(const f32x4v*)(GATE + i * 8), g1 = *(const f32x4v*)(GATE + i * 8 + 4); float o[8]; float amax = 0.f;
#pragma unroll
        for (int q = 0; q < 4; ++q) { o[q] = g0[q] * 0.5f * a[q] * (1.f + erff(a[q] * 0.70710678118654752f)) * vsteps[e0[q]]; o[4 + q] = g1[q] * 0.5f * a[4 + q] * (1.f + erff(a[4 + q] * 0.70710678118654752f)) * vsteps[e1[q]]; }
#pragma unroll
        for (int q = 0; q < 8; ++q) amax = fmaxf(amax, fabsf(o[q]));
        amax = fmaxf(amax, __shfl_xor(amax, 1)); amax = fmaxf(amax, __shfl_xor(amax, 2)); amax = fmaxf(amax, __shfl_xor(amax, 4)); amax = fmaxf(amax, __shfl_xor(amax, 8));
        const float stp = (amax > 0.f) ? amax * (1.f / 127.f) : 1.f, inv = 1.f / stp; unsigned w0 = 0u, w1 = 0u;
#pragma unroll
        for (int q = 0; q < 4; ++q) { w0 |= ((unsigned)((int)rintf(o[q] * inv)) & 255u) << (8 * q); w1 |= ((unsigned)((int)rintf(o[4 + q] * inv)) & 255u) << (8 * q); }
        uint2 ww; ww.x = w0; ww.y = w1; *(uint2*)(WQ + i * 8) = ww;
        if ((i & 15) == 0) WSC[i >> 4] = stp; }
}

template <bool SHI>
__device__ __forceinline__ void tail_convert(const float* __restrict__ src, unsigned char* __restrict__ dst, float scale, int l, int mrows, float* usteps) {
    if (l >= DEPTH - 1) return;
    const int nunits = (mrows / 256) * (D / 256), G = (int)gridDim.x, busy = nunits % G;
    if ((int)blockIdx.x < busy || busy == 0) { if (busy != 0) return; }
    const int part = (busy == 0) ? (int)blockIdx.x : (int)blockIdx.x - busy, nparts = (busy == 0) ? G : G - busy;
    if (usteps) cvt_rows_u4<SHI>(src + (size_t)(l + 1) * NE * D, dst + (size_t)(l + 1) * NE * (D / 2), usteps + (size_t)(l + 1) * NE, NE, part, nparts);
    else cvt_stream_fp8(src + (size_t)(l + 1) * NE * D, dst + (size_t)(l + 1) * NE * D, (size_t)NE * D / 16, scale, part, nparts);
}

enum { K_PRO = 0, K_MOD0, K_GEMM_IN, K_PREP, K_ATT_AB, K_ATT_C, K_ATT_CCTX, K_GEMM_OUT, K_LN1, K_GEMM_PQ, K_SEL1, K_SEL2, K_EXP, K_LN2, K_EXPU, K_EXPW, K_EXPV, K_COUNT };

#ifndef MK_PHASE_INLINE
#define MK_PHASE_INLINE __forceinline__
#endif
template <int KIND>
__device__ MK_PHASE_INLINE void run_phase(const Params& p, const int l, unsigned char* lds) {
#ifdef MK_SKIP
    if constexpr (((MK_SKIP) >> KIND) & 1) return;
#endif
    unsigned char* ws = p.ws;
    bf16* const Hb = (bf16*)(ws + WS_H); bf16* const QKV = (bf16*)(ws + WS_QKV); bf16* const ATT = (bf16*)(ws + WS_ATT); bf16* const PQ = (bf16*)(ws + WS_PQ);
    bf16* const X = (bf16*)(ws + WS_X); float* const Y = (float*)(ws + WS_Y); const float* const MOD = (const float*)(ws + WS_MOD);
    const bool odd = l & 1, last = (l == DEPTH - 1); const int i2 = l >> 1;
    const int NQ = odd ? NQ_C : NQ_AB; const int MR = last ? TL : T;
    const float* modl = MOD + (size_t)l * 3 * NMOD;
    if constexpr (KIND == K_PRO) phase_prologue(p, lds);
    if constexpr (KIND == K_MOD0) phase_mod0(p);
    if constexpr (KIND == K_GEMM_IN) {
        const unsigned char* Wt = odd ? ws + WS_WIN_C + (size_t)i2 * NQ_C * D : ws + WS_WIN_AB + (size_t)i2 * NQ_AB * D;
        pg8::Gemm g{(const bf16*)(ws + WS_H8), (const bf16*)Wt, T, NQ, D / 2, SC_ONE, SC_W8}; pg8::StaticOrder S; S.init(T, NQ, (int)gridDim.x, (int)blockIdx.x);
        pg8::EpiBf16<0> E{QKV, NQ, nullptr, 0, 0};
        pg8::gemm_phase<pg8::EpiBf16<0>, pg8::StaticOrder, false, 1>((PG8_LAS unsigned char*)lds, g, S, E, nullptr);
    }
    if constexpr (KIND == K_PREP) {
        if (odd) { phase_prep(QKV, NQ_C, 2048, 4, 0, true, p.c_q_gain + i2 * HD, p.c_k_gain + i2 * HD, (const float*)(ws + WS_ROPE), T, ws + WS_K8);
                   phase_vt8(QKV, ws + WS_VT8); }
        else     phase_prep(QKV, NQ_AB, 1024, 2, 0, false, nullptr, nullptr, (const float*)(ws + WS_ROPE), TL, nullptr);
    }
    #if MK_NAIVE_AB
    if constexpr (KIND == K_ATT_AB) phase_attn_ab_naive(QKV, ATT, p.a_sink + i2 * 8, p.b_rpb + (size_t)i2 * 8 * 15 * 31, !last);
#else
    if constexpr (KIND == K_ATT_AB) phase_attn_ab(QKV, ATT, p.a_sink + i2 * 8, p.b_rpb + (size_t)i2 * 8 * 15 * 31, (char*)lds, !last, (const float*)(ws + WS_ROPE));
#endif
    if constexpr (KIND == K_ATT_C) phase_attn_c_dense(QKV, ATT, (char*)lds, !last, p.c_q_gain + i2 * HD, (const float*)(ws + WS_ROPE), ws + WS_K8, ws + WS_VT8);
    if constexpr (KIND == K_GEMM_OUT) {
        const unsigned char* Wt = odd ? ws + WS_WOUT_C + (size_t)i2 * D * D : ws + WS_WOUT_AB + (size_t)i2 * D * D;
        pg8::Gemm g{(const bf16*)ATT, (const bf16*)Wt, MR, D, D / 2, SC_ATT8, SC_W8}; pg8::StaticOrder S; S.init(MR, D, (int)gridDim.x, (int)blockIdx.x);
        pg8::EpiBf16<0> E{(bf16*)Y, D, nullptr, 0, 0};
        pg8::gemm_phase<pg8::EpiBf16<0>, pg8::StaticOrder, false, 1>((PG8_LAS unsigned char*)lds, g, S, E, nullptr);
        tail_convert<false>(p.peer_u, ws + WS_U, U_SCALE, l, MR, (float*)(ws + WS_USC));
    }
    if constexpr (KIND == K_LN1) {
        const float* lg = p.ln_g + (size_t)(l * 2 + 0) * D; const float* lb = p.ln_b + (size_t)(l * 2 + 0) * D;
        if (l == 0) phase_ln<true, false>(p.x, p.ctx, (const bf16*)Y, modl, 2, lg, lb, X, X + (size_t)TL * D, nullptr, nullptr, modl, 3, 4, MR, lds, ws + WS_HQ, (float*)(ws + WS_HSC));
        else        phase_ln<false, false>(X, X + (size_t)TL * D, (const bf16*)Y, modl, 2, lg, lb, X, X + (size_t)TL * D, nullptr, nullptr, modl, 3, 4, MR, lds, ws + WS_HQ, (float*)(ws + WS_HSC));
    }
    if constexpr (KIND == K_GEMM_PQ) {
        pg8::Gemm g{(const bf16*)(ws + WS_HQ), (const bf16*)(ws + WS_WPQ + (size_t)l * D * D), MR, D, D / 2, 0, 0}; pg8::StaticOrder S; S.init(MR, D, (int)gridDim.x, (int)blockIdx.x);
        pg8::EpiI8Bf16 E{PQ, D, (const float*)(ws + WS_HSC), (const float*)(ws + WS_PQSC) + (size_t)l * D};
        pg8::gemm_phase<pg8::EpiI8Bf16, pg8::StaticOrder, false, 2>((PG8_LAS unsigned char*)lds, g, S, E, nullptr);
        tail_convert<true>(p.peer_v, ws + WS_V, V_SCALE, l, MR, (float*)(ws + WS_VSC));
    }
#if MK_NAIVE_SEL
    if constexpr (KIND == K_SEL1) phase_sel1_naive(PQ, (const bf16*)(ws + WS_SK) + (size_t)l * 16 * 128 * 128, (float*)(ws + WS_TOPV), (int*)(ws + WS_TOPI), MR);
    if constexpr (KIND == K_SEL2) phase_sel2_naive((const float*)(ws + WS_TOPV), (const int*)(ws + WS_TOPI), (int*)(ws + WS_IDX), (float*)(ws + WS_GATE), MR);
#else
    if constexpr (KIND == K_SEL1) phase_select(PQ, (const bf16*)(ws + WS_SK) + (size_t)l * 16 * 128 * 128, (int*)(ws + WS_IDX), (float*)(ws + WS_GATE), MR, lds);
#endif
    if constexpr (KIND == K_EXPU) phase_exp_u4(ws + WS_U + (size_t)l * NE * (D / 2), (const int*)(ws + WS_IDX), ws + WS_HQ, (bf16*)Y, MR, lds);
    if constexpr (KIND == K_EXPW) phase_exp_w((const bf16*)Y, (const float*)(ws + WS_GATE), (const int*)(ws + WS_IDX), (const float*)(ws + WS_USC) + (size_t)l * NE, (const float*)(ws + WS_HSC),
                                               (const float*)(ws + WS_VSC) + (size_t)l * NE, ws + WS_WQ, (float*)(ws + WS_WSC), MR);
    if constexpr (KIND == K_EXPV) phase_exp_v4(ws + WS_V + (size_t)l * NE * (D / 2), (const int*)(ws + WS_IDX), ws + WS_WQ, (const float*)(ws + WS_WSC), ATT, MR);
    if constexpr (KIND == K_LN2) {
        const float* modn = MOD + (size_t)(last ? l : l + 1) * 3 * NMOD; const float* lg = p.ln_g + (size_t)(l * 2 + 1) * D; const float* lb = p.ln_b + (size_t)(l * 2 + 1) * D;
        if (last) phase_ln<false, true>(X, X + (size_t)TL * D, ATT, modl, 5, lg, lb, p.out, p.out, nullptr, nullptr, modn, 0, 1, MR, lds);
        else      phase_ln<false, false>(X, X + (size_t)TL * D, ATT, modl, 5, lg, lb, X, X + (size_t)TL * D, nullptr, ws + WS_H8, modn, 0, 1, MR, lds);
    }
    if constexpr (KIND == K_EXP) {
        const float* modn = MOD + (size_t)(last ? l : l + 1) * 3 * NMOD;
        phase_experts(Hb, ws + WS_U + (size_t)l * NE * D, ws + WS_V + (size_t)l * NE * D, (const int*)(ws + WS_IDX), (const float*)(ws + WS_GATE), MR, lds,
                      (const float*)X, modl, p.ln_g + (size_t)(l * 2 + 1) * D, p.ln_b + (size_t)(l * 2 + 1) * D, last ? p.out : (float*)X, last ? nullptr : Hb, modn);
    }
}

template <int KIND>
__global__ void __launch_bounds__(512, 2) mk_phase(Params p, int l) {
    extern __shared__ __attribute__((aligned(16))) unsigned char lds[];
    run_phase<KIND>(p, l, lds);
}
typedef const __attribute__((address_space(4))) Params* KParams;
__device__ __forceinline__ Params load_params() {
#if defined(__HIP_DEVICE_COMPILE__)
    KParams q = (KParams)__builtin_amdgcn_kernarg_segment_ptr();
    asm volatile("" : "+s"(q));
    return *q;
#else
    return Params{};
#endif
}
#ifndef MK_DOUBLE
#define MK_DOUBLE 0
#endif
#define RUN(K, l) do { { const Params P_ = load_params(); run_phase<K>(P_, (l), lds); } if constexpr (((MK_DOUBLE) >> K) & 1) { xcd_barrier(bar); const Params P2_ = load_params(); run_phase<K>(P2_, (l), lds); } } while (0)
__global__ void __launch_bounds__(512, 2) mk_fwd(Params p) {
    extern __shared__ __attribute__((aligned(16))) unsigned char lds[];
    volatile LAS unsigned* misc = (volatile LAS unsigned*)((LAS unsigned char*)lds + LDS_MISC);
    if (threadIdx.x < 4) misc[threadIdx.x] = 0u;
    __syncthreads();
    const XcdBarrier bar = xcd_barrier_post((unsigned*)(p.ws + WS_CTL), misc);
    RUN(K_PRO, 0); xcd_barrier(bar);
    RUN(K_MOD0, 0); xcd_barrier(bar);
#pragma unroll 1
    for (int l = 0; l < DEPTH; ++l) {
        const bool odd = l & 1, last = (l == DEPTH - 1);
        RUN(K_GEMM_IN, l); xcd_barrier(bar);
        RUN(K_PREP, l); xcd_barrier(bar);
        if (odd) RUN(K_ATT_C, l); else RUN(K_ATT_AB, l);
        xcd_barrier(bar);
        RUN(K_GEMM_OUT, l); xcd_barrier(bar);
        RUN(K_LN1, l); xcd_barrier(bar);
        RUN(K_GEMM_PQ, l); xcd_barrier(bar);
        RUN(K_SEL1, l); xcd_barrier(bar);
#if MK_NAIVE_SEL
        RUN(K_SEL2, l); xcd_barrier(bar);
#endif
#if MK_SLICED
        RUN(K_EXPU, l); xcd_barrier(bar);
        RUN(K_EXPW, l); xcd_barrier(bar);
        RUN(K_EXPV, l); xcd_barrier(bar);
        RUN(K_LN2, l);
#else
        RUN(K_EXP, l);
#endif
        if (!last) xcd_barrier(bar);
    }
}
#undef RUN
}

template <int KIND> static void launch_phase(const mk::Params& p, int l, int grid, hipStream_t stream) {
    static bool attr = false;
    if (!attr) { (void)hipFuncSetAttribute((const void*)mk::mk_phase<KIND>, hipFuncAttributeMaxDynamicSharedMemorySize, mk::LDS_BYTES); attr = true; }
    hipLaunchKernelGGL(mk::mk_phase<KIND>, dim3(grid), dim3(512), mk::LDS_BYTES, stream, p, l);
}
extern "C" void kernel_launch(void* const* d_in, const int* in_sizes, int n_in, void* d_out, int out_size, void* d_ws, size_t ws_size, hipStream_t stream) {
    using namespace mk;
    static int grid = 0;
    if (grid == 0) {
        if (n_in != 20 || in_sizes[0] != TL * D || out_size != TL * D || ws_size < WS_END) {
            fprintf(stderr, "kernel_launch: unexpected shapes: n_in %d in0 %d out %d ws %zu (need %zu)\n", n_in, n_in > 0 ? in_sizes[0] : -1, out_size, ws_size, (size_t)WS_END); grid = -1; return; }
        int dev = 0, cus = 0;
        if (hipGetDevice(&dev) != hipSuccess || hipDeviceGetAttribute(&cus, hipDeviceAttributeMultiprocessorCount, dev) != hipSuccess) { grid = -1; return; }
        grid = cus;
    }
    if (grid < 0) return;
    (void)hipMemsetAsync((char*)d_ws + WS_CTL, 0, 16384, stream);
    Params p{};
    const float** pp = (const float**)&p;
    for (int i = 0; i < 20; ++i) pp[i] = (const float*)d_in[i];
    p.out = (float*)d_out; p.ws = (unsigned char*)d_ws; p.ph_lo = 0; p.ph_hi = 0;
#if MK_ONE_LAUNCH
    { static bool attr = false;
      if (!attr) { int per_cu = 0;
          if (hipFuncSetAttribute((const void*)mk_fwd, hipFuncAttributeMaxDynamicSharedMemorySize, LDS_BYTES) != hipSuccess) fprintf(stderr, "kernel_launch: hipFuncSetAttribute failed\n");
          if (hipOccupancyMaxActiveBlocksPerMultiprocessor(&per_cu, (const void*)mk_fwd, 512, LDS_BYTES) != hipSuccess || per_cu < 1) fprintf(stderr, "kernel_launch: occupancy query reports %d workgroups per CU\n", per_cu);
          (void)hipGetLastError(); attr = true; }
      hipLaunchKernelGGL(mk_fwd, dim3(grid), dim3(512), LDS_BYTES, stream, p); }
#else
    launch_phase<K_PRO>(p, 0, grid, stream);
    launch_phase<K_MOD0>(p, 0, grid, stream);
    for (int l = 0; l < DEPTH; ++l) {
        const bool odd = l & 1, last = (l == DEPTH - 1);
        launch_phase<K_GEMM_IN>(p, l, grid, stream);
        launch_phase<K_PREP>(p, l, grid, stream);
        if (odd) launch_phase<K_ATT_C>(p, l, grid, stream);
        else launch_phase<K_ATT_AB>(p, l, grid, stream);
        launch_phase<K_GEMM_OUT>(p, l, grid, stream);
        launch_phase<K_LN1>(p, l, grid, stream);
        launch_phase<K_GEMM_PQ>(p, l, grid, stream);
        launch_phase<K_SEL1>(p, l, grid, stream);
#if MK_NAIVE_SEL
        launch_phase<K_SEL2>(p, l, grid, stream);
#endif
#if MK_SLICED
        launch_phase<K_EXPU>(p, l, grid, stream); launch_phase<K_EXPW>(p, l, grid, stream); launch_phase<K_EXPV>(p, l, grid, stream); launch_phase<K_LN2>(p, l, grid, stream);
#else
        launch_phase<K_EXP>(p, l, grid, stream);
#endif
    }
#endif
    const hipError_t le = hipPeekAtLastError();
    if (le != hipSuccess) fprintf(stderr, "kernel_launch: launch failed: %s\n", hipGetErrorName(le));
}
```

```cpp
#include <hip/hip_runtime.h>
#include <cstdio>
#include <cstdint>

#ifndef MK_NAIVE_AB
#define MK_NAIVE_AB 0
#endif
#ifndef MK_SD_C
#define MK_SD_C 1
#endif
#ifndef MK_NAIVE_SEL
#define MK_NAIVE_SEL 0
#endif
#ifndef MK_SLICED
#define MK_SLICED 1
#endif
#ifndef MK_ATT_FP8
#define MK_ATT_FP8 1
#endif
#ifndef MK_ATT_I
#define MK_ATT_I 1
#endif
#ifndef MK_ONE_LAUNCH
#define MK_ONE_LAUNCH 1
#endif

__device__ __forceinline__ int mk_ltid() { int t; asm volatile("v_mov_b32 %0, %1" : "=v"(t) : "v"((int)threadIdx.x)); return t; }
#define XB_TMO      128
#define XB_XCNT(j)  (256  + 64 * (j))
#define XB_XSUB(j)  (1280 + 64 * (j))
#define XB_XGEN(j)  (2304 + 64 * (j))
#define XB_TOP      3328
#define XB_TOPGEN   3392
#define XCD_BAR_WORDS 3456
#define XB_SPIN_CAP (1u << 22)
#define LAS __attribute__((address_space(3)))

__device__ __forceinline__ unsigned xb_ld(unsigned* p)              { return __hip_atomic_load(p, __ATOMIC_RELAXED, __HIP_MEMORY_SCOPE_AGENT); }
__device__ __forceinline__ unsigned xb_add(unsigned* p, unsigned v) { return __hip_atomic_fetch_add(p, v, __ATOMIC_RELAXED, __HIP_MEMORY_SCOPE_AGENT); }
__device__ __forceinline__ unsigned xb_xcc_id() { return (unsigned)__builtin_amdgcn_s_getreg((3 << 11) | 20) & 0xFu; }
#define XB_SPIN(cond, bar) do { unsigned _sp = 0; while (cond) { __builtin_amdgcn_s_sleep(1); \
    if ((++_sp & 255u) == 0u) { if (xb_ld(&(bar)[XB_TMO])) break; if (_sp > XB_SPIN_CAP) { atomicAdd(&(bar)[XB_TMO], 1u); break; } } } } while (0)

struct XcdBarrier {
    unsigned* bar; unsigned x;
    volatile LAS unsigned* st;
};

__device__ __forceinline__ XcdBarrier xcd_barrier_post(unsigned* bar, volatile LAS unsigned* st) {
    XcdBarrier b; b.bar = bar; b.x = xb_xcc_id(); b.st = st;
    if (threadIdx.x == 0) (void)xb_add(&bar[XB_XCNT(b.x)], 1u);
    return b;
}
__device__ __forceinline__ void xcd_barrier_complete(unsigned* bar, unsigned x, unsigned& nloc, unsigned& nx) {
    const unsigned G = gridDim.x * gridDim.y * gridDim.z;
    unsigned sum, cnt, mine, sp = 0u;
    for (;;) {
        sum = 0u; cnt = 0u; mine = 0u;
#pragma unroll
        for (unsigned j = 0; j < 16; ++j) { const unsigned c = xb_ld(&bar[XB_XCNT(j)]); sum += c; cnt += (c > 0u) ? 1u : 0u; mine = (j == x) ? c : mine; }
        if (sum == G) break;
        __builtin_amdgcn_s_sleep(1);
        if ((++sp & 255u) == 0u) { if (xb_ld(&bar[XB_TMO])) break; if (sp > XB_SPIN_CAP) { atomicAdd(&bar[XB_TMO], 1u); break; } }
    }
    nloc = mine > 0u ? mine : 1u; nx = cnt > 0u ? cnt : 1u;
}

__device__ __forceinline__ void xcd_barrier(const XcdBarrier& b) {
    asm volatile("s_waitcnt vmcnt(0)" ::: "memory");
    __syncthreads();
    if (threadIdx.x == 0) {
        unsigned* bar = b.bar; unsigned bx = b.x; asm volatile("" : "+s"(bar), "+s"(bx));
        __builtin_amdgcn_s_waitcnt(0);
        unsigned nloc = b.st[0], nx = b.st[1];
        if (nloc == 0u) { xcd_barrier_complete(bar, bx, nloc, nx); b.st[0] = nloc; b.st[1] = nx; }
        const unsigned old = xb_add(&bar[XB_XSUB(bx)], 1u);
        const unsigned gen = old / nloc;
        if (old + 1u == (gen + 1u) * nloc) {
            __builtin_amdgcn_fence(__ATOMIC_RELEASE, "agent");
            asm volatile("s_waitcnt vmcnt(0)" ::: "memory");
            const unsigned og = xb_add(&bar[XB_TOP], 1u);
            const unsigned tg = og / nx;
            if (og + 1u == (tg + 1u) * nx) xb_add(&bar[XB_TOPGEN], 1u);
            else XB_SPIN(xb_ld(&bar[XB_TOPGEN]) == tg, bar);
            __builtin_amdgcn_fence(__ATOMIC_ACQUIRE, "agent");
            xb_add(&bar[XB_XGEN(bx)], 1u);
            asm volatile("s_waitcnt vmcnt(0)" ::: "memory");
        } else {
            XB_SPIN(xb_ld(&bar[XB_XGEN(bx)]) == gen, bar);
            __builtin_amdgcn_fence(__ATOMIC_ACQUIRE, "agent");
            asm volatile("s_waitcnt vmcnt(0)" ::: "memory");
        }
    }
    __syncthreads();
}


namespace pg8 {
#define PG8_LAS __attribute__((address_space(3)))
typedef unsigned short bf16_t;
typedef short bf16x8 __attribute__((ext_vector_type(8)));
typedef float f32x4 __attribute__((ext_vector_type(4)));
typedef unsigned u32x4 __attribute__((ext_vector_type(4)));
typedef int i32x4 __attribute__((ext_vector_type(4)));
typedef int i32x8 __attribute__((ext_vector_type(8)));
constexpr int BM = 256, BK = 64, HALF = 128, HTB = HALF * BK * 2  , STAGE_BYTES = 8 * HTB, NXCD = 8, WGM = 8;

__host__ __device__ __forceinline__ int lds_byte(int r, int c) { const int st = (r >> 4) * 2 + (c >> 5), rr = r & 15, cc = c & 31, ob = rr * 64 + cc * 2; return st * 1024 + (ob ^ (((ob >> 9) & 1) << 5)); }
__host__ __device__ __forceinline__ void stage_rc(int b, int& R, int& C) { const int st = b / 1024, sb = b % 1024, swz = sb ^ (((sb >> 9) & 1) << 5); R = (st >> 1) * 16 + swz / 64; C = (st & 1) * 32 + (swz % 64) / 2; }
__host__ __device__ __forceinline__ int perm32(int rho) { const int n = rho >> 4, i = rho & 15; return 8 * (i >> 2) + 4 * n + (i & 3); }

struct Unit { int pm, pn; };
struct Gemm { const bf16_t* A; const bf16_t* Bt; int M, N, K; int sa, sb; };

struct StaticOrder {
    int nM, nN, nwg, G, c;
    __host__ __device__ void init(int M, int N, int G_, int c_) { nM = M / BM; nN = N / BM; nwg = nM * nN; G = G_; c = c_; }
    __host__ __device__ bool next(int i, Unit& u) const {
        const long L = (long)i * G + c; if (L >= nwg) return false;
        int wgid = (int)L; { const int q = nwg / NXCD, r = nwg % NXCD, xcd = wgid % NXCD, off = wgid / NXCD; wgid = (xcd < r ? xcd * (q + 1) : r * (q + 1) + (xcd - r) * q) + off; }
        const int nig = WGM * nN, gid = wgid / nig, fm = gid * WGM, gsz = (nM - fm) < WGM ? (nM - fm) : WGM;
        u.pm = fm + ((wgid % nig) % gsz); u.pn = (wgid % nig) / gsz; return true;
    }
    __device__ __forceinline__ void a_ready(const Unit&) const {}
    __device__ __forceinline__ void done(const Unit&) const {}
};
__device__ __forceinline__ unsigned cvt_pk_bf16(float lo, float hi) { unsigned r; asm volatile("v_cvt_pk_bf16_f32 %0, %1, %2" : "=v"(r) : "v"(lo), "v"(hi)); return r; }
typedef float f32x2 __attribute__((ext_vector_type(2)));
__device__ __forceinline__ f32x2 gelu_pk(f32x2 v) {
    const f32x2 av = __builtin_elementwise_abs(v), d = av * 0.2316418882f + 1.0f;
    f32x2 t; t.x = __builtin_amdgcn_rcpf(d.x); t.y = __builtin_amdgcn_rcpf(d.y);
    f32x2 q = t * 0.5307027145f + (-0.7265760135f); q = q * t + 0.7107068705f; q = q * t + (-0.142248368f); q = q * t + 0.127414796f; q = q * t;
    const f32x2 s = (v * v) * (-0.72134752044f);
    f32x2 e; e.x = __builtin_amdgcn_exp2f(s.x); e.y = __builtin_amdgcn_exp2f(s.y);
    const f32x2 m = v * (q * e), r = v - m;
    f32x2 o; o.x = v.x < 0.f ? m.x : r.x; o.y = v.y < 0.f ? m.y : r.y; return o;
}

struct EpiF32 {
    static constexpr bool PERM = false, AFTER_DRAIN = false;
    float* C; int ldc; const float* bias;
    __device__ __forceinline__ void operator()(const f32x4 (&acc)[2][2][4][2], const Unit& u, int wr, int wc, int fr, int fq) const {
        const int row0 = u.pm * BM + wr * 64 + fr, col0 = u.pn * BM + wc * 32 + 4 * fq;
        f32x4 bv[2][2];
#pragma unroll
        for (int bj = 0; bj < 2; ++bj)
#pragma unroll
            for (int n = 0; n < 2; ++n) bv[bj][n] = bias ? *(const f32x4*)(bias + col0 + bj * HALF + n * 16) : (f32x4){0.f, 0.f, 0.f, 0.f};
#pragma unroll
        for (int ai = 0; ai < 2; ++ai)
#pragma unroll
            for (int m = 0; m < 4; ++m) { float* rowp = C + (size_t)(row0 + ai * HALF + m * 16) * ldc + col0;
#pragma unroll
                for (int bj = 0; bj < 2; ++bj)
#pragma unroll
                    for (int n = 0; n < 2; ++n) *(f32x4*)(rowp + bj * HALF + n * 16) = acc[ai][bj][m][n] + bv[bj][n]; }
    }
};
template <int ACT  > struct EpiBf16 {
    static constexpr bool PERM = true, AFTER_DRAIN = false;
    bf16_t* O; int ldc; const float* bias; int split_cols; size_t split_stride;
    __device__ __forceinline__ void operator()(const f32x4 (&acc)[2][2][4][2], const Unit& u, int wr, int wc, int fr, int fq) const {
        const int row0 = u.pm * BM + wr * 64 + fr; int colt = u.pn * BM; bf16_t* base = O;
        if (split_cols) { const int t = colt / split_cols; base += (size_t)t * split_stride; colt -= t * split_cols; }
        const int col0 = colt + wc * 32 + 8 * fq, bcol0 = u.pn * BM + wc * 32 + 8 * fq;
        f32x4 bv[2][2];
#pragma unroll
        for (int bj = 0; bj < 2; ++bj)
#pragma unroll
            for (int n = 0; n < 2; ++n) bv[bj][n] = bias ? *(const f32x4*)(bias + bcol0 + bj * HALF + 4 * n) : (f32x4){0.f, 0.f, 0.f, 0.f};
#pragma unroll
        for (int ai = 0; ai < 2; ++ai)
#pragma unroll
            for (int m = 0; m < 4; ++m) { bf16_t* rowp = base + (size_t)(row0 + ai * HALF + m * 16) * ldc + col0;
#pragma unroll
                for (int bj = 0; bj < 2; ++bj) { f32x4 v0 = acc[ai][bj][m][0] + bv[bj][0], v1 = acc[ai][bj][m][1] + bv[bj][1];
                    if (ACT == 1) { f32x2 a = gelu_pk((f32x2){v0[0], v0[1]}), b = gelu_pk((f32x2){v0[2], v0[3]}), c = gelu_pk((f32x2){v1[0], v1[1]}), d = gelu_pk((f32x2){v1[2], v1[3]});
                        v0 = (f32x4){a.x, a.y, b.x, b.y}; v1 = (f32x4){c.x, c.y, d.x, d.y}; }
                    if (ACT == 2) {
#pragma unroll
                        for (int j = 0; j < 4; ++j) { v0[j] = 0.5f * v0[j] * (1.0f + erff(v0[j] * 0.70710678f)); v1[j] = 0.5f * v1[j] * (1.0f + erff(v1[j] * 0.70710678f)); } }
                    u32x4 w; w.x = cvt_pk_bf16(v0[0], v0[1]); w.y = cvt_pk_bf16(v0[2], v0[3]); w.z = cvt_pk_bf16(v1[0], v1[1]); w.w = cvt_pk_bf16(v1[2], v1[3]);
                    *(u32x4*)(rowp + bj * HALF) = w; } }
    }
};

struct EpiI8Bf16 {
    static constexpr bool PERM = true, AFTER_DRAIN = false;
    bf16_t* O; int ldc; const float* rs; const float* cs;
    __device__ __forceinline__ void operator()(const f32x4 (&acc)[2][2][4][2], const Unit& u, int wr, int wc, int fr, int fq) const {
        const int row0 = u.pm * BM + wr * 64 + fr, col0 = u.pn * BM + wc * 32 + 8 * fq;
        f32x4 cv[2][2];
#pragma unroll
        for (int bj = 0; bj < 2; ++bj)
#pragma unroll
            for (int n = 0; n < 2; ++n) cv[bj][n] = *(const f32x4*)(cs + col0 + bj * HALF + 4 * n);
#pragma unroll
        for (int ai = 0; ai < 2; ++ai)
#pragma unroll
            for (int m = 0; m < 4; ++m) { const int row = row0 + ai * HALF + m * 16; const float rsv = rs[row]; bf16_t* rowp = O + (size_t)row * ldc + col0;
#pragma unroll
                for (int bj = 0; bj < 2; ++bj) { const i32x4 i0 = *(const i32x4*)&acc[ai][bj][m][0], i1 = *(const i32x4*)&acc[ai][bj][m][1];
                    f32x4 v0, v1;
#pragma unroll
                    for (int j = 0; j < 4; ++j) { v0[j] = (float)i0[j] * rsv * cv[bj][0][j]; v1[j] = (float)i1[j] * rsv * cv[bj][1][j]; }
                    u32x4 w; w.x = cvt_pk_bf16(v0[0], v0[1]); w.y = cvt_pk_bf16(v0[2], v0[3]); w.z = cvt_pk_bf16(v1[0], v1[1]); w.w = cvt_pk_bf16(v1[2], v1[3]);
                    *(u32x4*)(rowp + bj * HALF) = w; } }
    }
};

template <class Epi, class Sched, bool STAMP = false, int QMODE = 0>
__device__ __forceinline__ void gemm_phase(PG8_LAS unsigned char* lds, const Gemm g, const Sched& S, const Epi& E, unsigned long long* stamps) {
    constexpr bool FP8 = (QMODE == 1), I8 = (QMODE == 2);
    const int tid = mk_ltid(), wid = __builtin_amdgcn_readfirstlane(tid >> 6), lane = tid & 63, wr = wid >> 2, wc = wid & 3, fr = lane & 15, fq = lane >> 4;
    const int K = g.K, nt = K / BK;
    int ts_lo = 0, ts_hi = 0, nts = 0; const unsigned long long rt_entry = STAMP ? (unsigned long long)wall_clock64() : 0ull;
#define PG8_STAMP() do { if (STAMP && wid == 0 && nts < 64) { const unsigned long long _c = (unsigned long long)clock64(); \
        ts_lo = (lane == nts) ? (int)(unsigned)_c : ts_lo; ts_hi = (lane == nts) ? (int)(unsigned)(_c >> 32) : ts_hi; ++nts; } } while (0)
    PG8_STAMP();
    unsigned voffA[2], voffB[2];
#pragma unroll
    for (int i = 0; i < 2; ++i) { int R, C; stage_rc(tid * 16 + i * 8192, R, C); const int Rb = Epi::PERM ? ((R & ~31) + perm32(R & 31)) : R;
        voffA[i] = (unsigned)(R * K + C) * 2u; voffB[i] = (unsigned)(Rb * K + C) * 2u; }
    const size_t kstep = (size_t)(BK * 2);
    const size_t hstep = (size_t)HALF * K * 2;
    const size_t tstep = 2 * hstep;
    const unsigned ldsw = (unsigned)wid * 1024u;
    const int aoff = FP8 ? lds_byte(wr * 64 + fr, (fq >> 1) * 32 + (fq & 1) * 16) : lds_byte(wr * 64 + fr, fq * 8), boff = FP8 ? lds_byte(wc * 32 + fr, (fq >> 1) * 32 + (fq & 1) * 16) : lds_byte(wc * 32 + fr, fq * 8);
    constexpr int KST = FP8 ? 16 : 1024;
#define PG8_SA(b, h) (((b) * 2 + (h)) * HTB)
#define PG8_SB(b, h) ((4 + (b) * 2 + (h)) * HTB)
#define PG8_STAGE(bufoff, gbase, voff) do { _Pragma("unroll") for (int _i = 0; _i < 2; ++_i) \
        __builtin_amdgcn_global_load_lds((const unsigned*)((const char*)(gbase) + (voff)[_i]), (PG8_LAS unsigned*)(lds + (bufoff) + ldsw + _i * 8192), 16, 0, 0); } while (0)
#define PG8_LDA(dst, b, h) do { if constexpr (FP8) { _Pragma("unroll") for (int m = 0; m < 4; ++m) { const i32x4 lo_ = *(const PG8_LAS i32x4*)(lds + PG8_SA(b, h) + aoff + m * 2048), hi_ = *(const PG8_LAS i32x4*)(lds + PG8_SA(b, h) + aoff + m * 2048 + 16); \
        dst##8[m] = __builtin_shufflevector(lo_, hi_, 0, 1, 2, 3, 4, 5, 6, 7); } } \
    else { _Pragma("unroll") for (int m = 0; m < 4; ++m) _Pragma("unroll") for (int k = 0; k < 2; ++k) dst[m][k] = *(const PG8_LAS bf16x8*)(lds + PG8_SA(b, h) + aoff + m * 2048 + k * KST); } } while (0)
#define PG8_LDB(dst, b, h) do { if constexpr (FP8) { _Pragma("unroll") for (int n = 0; n < 2; ++n) { const i32x4 lo_ = *(const PG8_LAS i32x4*)(lds + PG8_SB(b, h) + boff + n * 2048), hi_ = *(const PG8_LAS i32x4*)(lds + PG8_SB(b, h) + boff + n * 2048 + 16); \
        dst##8[n] = __builtin_shufflevector(lo_, hi_, 0, 1, 2, 3, 4, 5, 6, 7); } } \
    else { _Pragma("unroll") for (int n = 0; n < 2; ++n) _Pragma("unroll") for (int k = 0; k < 2; ++k) dst[n][k] = *(const PG8_LAS bf16x8*)(lds + PG8_SB(b, h) + boff + n * 2048 + k * KST); } } while (0)
#define PG8_MMA(ai, bj, At, Bt) do { __builtin_amdgcn_s_setprio(1); \
    if constexpr (FP8) { _Pragma("unroll") for (int m = 0; m < 4; ++m) _Pragma("unroll") for (int n = 0; n < 2; ++n) \
        asm volatile("v_mfma_scale_f32_16x16x128_f8f6f4 %0, %1, %2, %0, %3, %4 op_sel_hi:[0,0,0]" : "+v"(acc[ai][bj][m][n]) : "v"(Bt##8[n]), "v"(At##8[m]), "v"(vsb), "v"(vsa)); } \
    else if constexpr (I8) { _Pragma("unroll") for (int m = 0; m < 4; ++m) _Pragma("unroll") for (int n = 0; n < 2; ++n) _Pragma("unroll") for (int k = 0; k < 2; ++k) { \
        const i32x4 r_ = __builtin_amdgcn_mfma_i32_16x16x64_i8(*(const i32x4*)&Bt[n][k], *(const i32x4*)&At[m][k], *(const i32x4*)&acc[ai][bj][m][n], 0, 0, 0); acc[ai][bj][m][n] = *(const f32x4*)&r_; } } \
    else { _Pragma("unroll") for (int m = 0; m < 4; ++m) _Pragma("unroll") for (int n = 0; n < 2; ++n) _Pragma("unroll") for (int k = 0; k < 2; ++k) \
        acc[ai][bj][m][n] = __builtin_amdgcn_mfma_f32_16x16x32_bf16(Bt[n][k], At[m][k], acc[ai][bj][m][n], 0, 0, 0); } \
    __builtin_amdgcn_s_setprio(0); } while (0)
#define PG8_WAIT_V(n) asm volatile("s_waitcnt vmcnt(" #n ")" ::: "memory")
#define PG8_WAIT_L(n) asm volatile("s_waitcnt lgkmcnt(" #n ")" ::: "memory")
#define PG8_BAR __builtin_amdgcn_s_barrier()
#define PG8_SCHED __builtin_amdgcn_sched_barrier(0)
    Unit cur, nxt; int ui = 0;
    if (!S.next(0, cur)) return;
    f32x4 acc[2][2][4][2];
#pragma unroll
    for (int a = 0; a < 2; ++a)
#pragma unroll
        for (int b = 0; b < 2; ++b)
#pragma unroll
            for (int m = 0; m < 4; ++m)
#pragma unroll
                for (int n = 0; n < 2; ++n) acc[a][b][m][n] = (f32x4){0.f, 0.f, 0.f, 0.f};
    const int vsa = g.sa, vsb = g.sb;
    bf16x8 At[4][2], B0[2][2], B1[2][2];
    i32x8 At8[4], B08[2], B18[2];
    const char* cA = (const char*)g.A + (size_t)cur.pm * tstep; const char* cB = (const char*)g.Bt + (size_t)cur.pn * tstep;
    S.a_ready(cur);
    PG8_STAGE(PG8_SB(0, 0), cB, voffB); PG8_STAGE(PG8_SA(0, 0), cA, voffA); PG8_STAGE(PG8_SB(0, 1), cB + hstep, voffB); PG8_STAGE(PG8_SA(0, 1), cA + hstep, voffA);
    if (wr == 1) PG8_BAR;
    PG8_WAIT_V(4); PG8_BAR;
    PG8_STAGE(PG8_SB(1, 0), cB + kstep, voffB); PG8_STAGE(PG8_SA(1, 0), cA + kstep, voffA); PG8_STAGE(PG8_SB(1, 1), cB + hstep + kstep, voffB);
    PG8_WAIT_V(6); PG8_BAR;
    PG8_STAMP();
    for (;;) {
        const bool has_next = S.next(ui + 1, nxt);
        const char* nA = has_next ? (const char*)g.A + (size_t)nxt.pm * tstep : cA; const char* nB = has_next ? (const char*)g.Bt + (size_t)nxt.pn * tstep : cB;
        for (int t = 0; t < nt; t += 2) {
            const bool last = (t == nt - 2);
            const char* a1 = cA + (size_t)(t + 1) * kstep;
            const char* a2 = last ? nA : cA + (size_t)(t + 2) * kstep; const char* b2 = last ? nB : cB + (size_t)(t + 2) * kstep;
            const char* a3 = a2 + kstep; const char* b3 = b2 + kstep;
            if (last && has_next) S.a_ready(nxt);
            PG8_LDB(B0, 0, 0); PG8_SCHED; PG8_LDA(At, 0, 0); PG8_STAGE(PG8_SA(1, 1), a1 + hstep, voffA);
            PG8_WAIT_L(8); PG8_BAR; PG8_WAIT_L(0); PG8_MMA(0, 0, At, B0); PG8_BAR; PG8_SCHED;
            PG8_LDB(B1, 0, 1); PG8_STAGE(PG8_SB(0, 0), b2, voffB);
            PG8_BAR; PG8_WAIT_L(0); PG8_MMA(0, 1, At, B1); PG8_BAR;
            PG8_LDA(At, 0, 1); PG8_STAGE(PG8_SA(0, 0), a2, voffA);
            PG8_BAR; PG8_WAIT_L(0); PG8_MMA(1, 0, At, B0); PG8_BAR; PG8_SCHED;
            PG8_STAGE(PG8_SB(0, 1), b2 + hstep, voffB);
            PG8_WAIT_V(6); PG8_BAR; PG8_MMA(1, 1, At, B1); PG8_BAR;
            PG8_LDB(B0, 1, 0); PG8_SCHED; PG8_LDA(At, 1, 0); PG8_STAGE(PG8_SA(0, 1), a2 + hstep, voffA);
            PG8_WAIT_L(8); PG8_BAR; PG8_WAIT_L(0); PG8_MMA(0, 0, At, B0); PG8_BAR; PG8_SCHED;
            PG8_LDB(B1, 1, 1); PG8_STAGE(PG8_SB(1, 0), b3, voffB);
            PG8_BAR; PG8_WAIT_L(0); PG8_MMA(0, 1, At, B1); PG8_BAR;
            PG8_LDA(At, 1, 1); PG8_STAGE(PG8_SA(1, 0), a3, voffA);
            PG8_BAR; PG8_WAIT_L(0); PG8_MMA(1, 0, At, B0); PG8_BAR; PG8_SCHED;
            PG8_STAGE(PG8_SB(1, 1), b3 + hstep, voffB);
            PG8_WAIT_V(6); PG8_BAR; PG8_MMA(1, 1, At, B1); PG8_BAR;
        }
        PG8_STAMP();
        if constexpr (FP8) asm volatile("s_nop 15\n\ts_nop 15" ::: "memory");
        if constexpr (!Epi::AFTER_DRAIN) { E(acc, cur, wr, wc, fr, fq); S.done(cur); }
        PG8_STAMP();
        if (!has_next) break;
#pragma unroll
        for (int a = 0; a < 2; ++a)
#pragma unroll
            for (int b = 0; b < 2; ++b)
#pragma unroll
                for (int m = 0; m < 4; ++m)
#pragma unroll
                    for (int n = 0; n < 2; ++n) acc[a][b][m][n] = (f32x4){0.f, 0.f, 0.f, 0.f};
        cur = nxt; cA = nA; cB = nB; ++ui;
    }
    PG8_WAIT_V(0);
    if (wr == 0) PG8_BAR;
    PG8_BAR;
    if constexpr (Epi::AFTER_DRAIN) { E.fused(acc, cur, wr, wc, fr, fq, lds, wid, lane); S.done(cur); }
    PG8_STAMP();
    if (STAMP && wid == 0) { stamps[lane] = lane < nts ? (((unsigned long long)(unsigned)ts_hi << 32) | (unsigned)ts_lo) : 0ull;
        if (lane == 62) stamps[62] = rt_entry; if (lane == 63) stamps[63] = (unsigned long long)wall_clock64(); }
#undef PG8_STAMP
#undef PG8_SA
#undef PG8_SB
#undef PG8_STAGE
#undef PG8_LDA
#undef PG8_LDB
#undef PG8_MMA
#undef PG8_WAIT_V
#undef PG8_WAIT_L
#undef PG8_BAR
#undef PG8_SCHED
}
}

namespace att {
typedef unsigned short bf16;
constexpr int   D = 128, NW = 8, QBLK = 32, KVBLK = 64;
constexpr float SCALE = 0.088388347648318440f;
constexpr float THR = 8.f;
constexpr int SDEPTH = 2;
constexpr size_t SHM_V = KVBLK * D * 2, SHM_K = KVBLK * D * 2, SHM_ATTN = 2 * SHM_V + 2 * SHM_K + NW * 64 * 4;
using bf16x8 = __attribute__((ext_vector_type(8))) short;
using s16x4  = __attribute__((ext_vector_type(4))) short;
using f32x16 = __attribute__((ext_vector_type(16))) float;
using u32x4  = __attribute__((ext_vector_type(4))) unsigned;
#define KSWZ(row, colB) ((row) * 256 + ((colB) ^ (((row) & 7) << 4)))
#define SBAR() __builtin_amdgcn_sched_barrier(0)
__device__ __forceinline__ int crow(int r, int hi) { return (r & 3) + 8 * (r >> 2) + 4 * hi; }
__device__ __forceinline__ unsigned cvtpk(float lo, float hi) {
  unsigned r; asm volatile("v_cvt_pk_bf16_f32 %0, %1, %2" : "=v"(r) : "v"(lo), "v"(hi)); return r;
}
__device__ __forceinline__ bf16x8 ld8(const bf16* p) { return *reinterpret_cast<const bf16x8*>(p); }

__device__ __forceinline__ void partialSM(f32x16& p0, f32x16& p1, float& m_reg, float& mn, float& alpha) {
  constexpr float C = SCALE * 1.4426950408889634f;
  float pmax = p0[0]; for (int r = 1; r < 16; ++r) pmax = fmaxf(pmax, p0[r]); for (int r = 0; r < 16; ++r) pmax = fmaxf(pmax, p1[r]);
  { auto rr = __builtin_amdgcn_permlane32_swap(__float_as_uint(pmax), __float_as_uint(pmax), false, false);
    pmax = fmaxf(__uint_as_float(rr[0]), __uint_as_float(rr[1])); }
  if (__builtin_expect(__all(pmax - m_reg <= THR / SCALE), 1)) { mn = m_reg; alpha = 1.f; }
  else { mn = fmaxf(m_reg, pmax); alpha = __builtin_amdgcn_exp2f((m_reg - mn) * C); m_reg = mn; }
  float mnC = -mn * C;
  for (int r = 0; r < 16; ++r) p0[r] = fmaf(p0[r], C, mnC); for (int r = 0; r < 16; ++r) p1[r] = fmaf(p1[r], C, mnC);
  for (int r = 0; r < 16; ++r) p0[r] = __builtin_amdgcn_exp2f(p0[r]);
}
__device__ __forceinline__ void finishSM(f32x16& p0, f32x16& p1, float alpha, float& l_reg, bf16x8& pa0, bf16x8& pa1, bf16x8& pa2, bf16x8& pa3) {
  for (int r = 0; r < 16; ++r) p1[r] = __builtin_amdgcn_exp2f(p1[r]);
  float ps = 0; for (int r = 0; r < 16; ++r) ps += p0[r]; for (int r = 0; r < 16; ++r) ps += p1[r];
  { auto rr = __builtin_amdgcn_permlane32_swap(__float_as_uint(ps), __float_as_uint(ps), false, false);
    ps = __uint_as_float(rr[0]) + __uint_as_float(rr[1]); }
  l_reg = l_reg * alpha + ps;
#define PK4(P, BASE, OUT) do { unsigned a0 = cvtpk(P[BASE + 0], P[BASE + 1]), a1 = cvtpk(P[BASE + 2], P[BASE + 3]);   \
    unsigned b0 = cvtpk(P[BASE + 4], P[BASE + 5]), b1 = cvtpk(P[BASE + 6], P[BASE + 7]);                              \
    auto r0 = __builtin_amdgcn_permlane32_swap(a0, b0, false, false); auto r1 = __builtin_amdgcn_permlane32_swap(a1, b1, false, false); \
    u32x4 w = {r0[0], r1[0], r0[1], r1[1]}; OUT = *reinterpret_cast<bf16x8*>(&w); } while (0)
  PK4(p0, 0, pa0); PK4(p0, 8, pa1); PK4(p1, 0, pa2); PK4(p1, 8, pa3);
#undef PK4
}
__device__ __forceinline__ void qkt(f32x16& p0, f32x16& p1, const bf16* Ks, const bf16x8* qr, int r32, int hi) {
  p0 = f32x16{}; p1 = f32x16{};
  for (int d0 = 0; d0 < 8; ++d0) { int cb = (d0 * 16 + hi * 8) * 2;
    bf16x8 b0 = *reinterpret_cast<const bf16x8*>((const char*)Ks + KSWZ(r32, cb));
    bf16x8 b1 = *reinterpret_cast<const bf16x8*>((const char*)Ks + KSWZ(32 + r32, cb));
    p0 = __builtin_amdgcn_mfma_f32_32x32x16_bf16(b0, qr[d0], p0, 0, 0, 0);
    p1 = __builtin_amdgcn_mfma_f32_32x32x16_bf16(b1, qr[d0], p1, 0, 0, 0); }
}
__device__ __forceinline__ int v_st(int k, int c) { const int kk = (k & ~0xC) | ((k & 4) << 1) | ((k & 8) >> 1); return ((kk >> 3) * 4 + (c >> 5)) * 512 + ((kk & 7) * 32 + (c & 31)) * 2; }
__device__ __forceinline__ int v_rd_base(int lane) { return ((lane & 3) << 3) | (((lane >> 2) & 3) << 6) | (((lane >> 4) & 1) << 5) | (((lane >> 5) & 1) << 8); }
constexpr int v_rd_off(int d0, int ks, int half) { return d0 * 512 + ks * 4096 + half * 2048; }
template <int OFF> __device__ __forceinline__ s16x4 tr_read(int vb) {
  s16x4 r; asm volatile("ds_read_b64_tr_b16 %0, %1 offset:%2" : "=&v"(r) : "v"(vb), "i"(OFF) : "memory"); return r;
}
template <int D0> __device__ __forceinline__ void pv_one(f32x16& od, int vb, bf16x8 pa0, bf16x8 pa1, bf16x8 pa2, bf16x8 pa3) {
  const s16x4 l0 = tr_read<v_rd_off(D0, 0, 0)>(vb), h0 = tr_read<v_rd_off(D0, 0, 1)>(vb), l1 = tr_read<v_rd_off(D0, 1, 0)>(vb), h1 = tr_read<v_rd_off(D0, 1, 1)>(vb);
  const s16x4 l2 = tr_read<v_rd_off(D0, 2, 0)>(vb), h2 = tr_read<v_rd_off(D0, 2, 1)>(vb), l3 = tr_read<v_rd_off(D0, 3, 0)>(vb), h3 = tr_read<v_rd_off(D0, 3, 1)>(vb);
  asm volatile("s_waitcnt lgkmcnt(0)" ::: "memory"); SBAR();
#define PK(L, H) (bf16x8){L[0], L[1], L[2], L[3], H[0], H[1], H[2], H[3]}
  od = __builtin_amdgcn_mfma_f32_32x32x16_bf16(pa0, PK(l0, h0), od, 0, 0, 0);
  od = __builtin_amdgcn_mfma_f32_32x32x16_bf16(pa1, PK(l1, h1), od, 0, 0, 0);
  od = __builtin_amdgcn_mfma_f32_32x32x16_bf16(pa2, PK(l2, h2), od, 0, 0, 0);
  od = __builtin_amdgcn_mfma_f32_32x32x16_bf16(pa3, PK(l3, h3), od, 0, 0, 0);
#undef PK
}
__device__ __forceinline__ void pv_d0(f32x16* o, int vb, bf16x8 pa0, bf16x8 pa1, bf16x8 pa2, bf16x8 pa3) {
  pv_one<0>(o[0], vb, pa0, pa1, pa2, pa3); pv_one<1>(o[1], vb, pa0, pa1, pa2, pa3); pv_one<2>(o[2], vb, pa0, pa1, pa2, pa3); pv_one<3>(o[3], vb, pa0, pa1, pa2, pa3);
}

struct MaskArgs { int kpos0, qpos0, krow0, qrow0; const float* bt; float sink; bool has_sink; };
struct QPrep { const float* qg; const float* rope; int qp0; bool norm, dorope; };
__device__ __forceinline__ void q_prepare(bf16x8 (&qr)[8], const QPrep qp, int rowpos, int hi) {
  if (!qp.norm && !qp.dorope) return;
  float x[8][8];
#pragma unroll
  for (int d0 = 0; d0 < 8; ++d0) { const u32x4 w = *reinterpret_cast<const u32x4*>(&qr[d0]);
#pragma unroll
    for (int e = 0; e < 4; ++e) { x[d0][2 * e] = __uint_as_float(w[e] << 16); x[d0][2 * e + 1] = __uint_as_float(w[e] & 0xffff0000u); } }
  if (qp.norm) {
    float ss = 0.f;
#pragma unroll
    for (int d0 = 0; d0 < 8; ++d0)
#pragma unroll
      for (int e = 0; e < 8; ++e) ss += x[d0][e] * x[d0][e];
    { auto rr = __builtin_amdgcn_permlane32_swap(__float_as_uint(ss), __float_as_uint(ss), false, false); ss = __uint_as_float(rr[0]) + __uint_as_float(rr[1]); }
    const float r = rsqrtf(ss * (1.f / 128.f) + 1e-6f);
#pragma unroll
    for (int d0 = 0; d0 < 8; ++d0) { const float* g = qp.qg + d0 * 16 + hi * 8;
#pragma unroll
      for (int e = 0; e < 8; ++e) x[d0][e] = x[d0][e] * r * g[e]; }
  }
  if (qp.dorope) {
    const int prow = rowpos >> 6, pcol = rowpos & 63;
#pragma unroll
    for (int dd = 0; dd < 2; ++dd) {
      const float* cr = qp.rope + prow * 32 + dd * 16 + hi * 8; const float* sr = cr + 128 * 32;
      const float* cc = qp.rope + pcol * 32 + dd * 16 + hi * 8; const float* sc = cc + 128 * 32;
#pragma unroll
      for (int e = 0; e < 8; ++e) {
        const float a = x[dd][e], b = x[2 + dd][e], c = x[4 + dd][e], d = x[6 + dd][e];
        x[dd][e] = a * cr[e] - b * sr[e]; x[2 + dd][e] = b * cr[e] + a * sr[e];
        x[4 + dd][e] = c * cc[e] - d * sc[e]; x[6 + dd][e] = d * cc[e] + c * sc[e]; } }
  }
#pragma unroll
  for (int d0 = 0; d0 < 8; ++d0) { u32x4 w;
#pragma unroll
    for (int e = 0; e < 4; ++e) w[e] = cvtpk(x[d0][2 * e], x[d0][2 * e + 1]);
    qr[d0] = *reinterpret_cast<bf16x8*>(&w); }
}

template <int MODE, int SDEPTH, int LDQ, int LDK, int LDO>
__device__ __forceinline__ void attn_body(const bf16* __restrict__ Qb, const bf16* __restrict__ Kc, const bf16* __restrict__ Kl, int voff, int nct,
                                          unsigned char* __restrict__ Ob, int NT, char* lds, const MaskArgs ma, const QPrep qp) {
  const int tid = mk_ltid(), wid = tid >> 6, lane = tid & 63, r32 = lane & 31, hi = lane >> 5;
  bf16* V_lds = (bf16*)lds; bf16* K_lds = (bf16*)(lds + 2 * SHM_V);
  float* ws = (float*)(lds + 2 * SHM_V + 2 * SHM_K) + wid * 64; float* li_l = ws; float* al_l = ws + 32;
  float m_reg = -1e30f, l_reg = 0; f32x16 o[4] = {}; bf16x8 qr[8];
  const bf16* Qw = Qb + (long)(wid * QBLK + r32) * LDQ + hi * 8;
#pragma unroll
  for (int d0 = 0; d0 < 8; ++d0) qr[d0] = ld8(Qw + d0 * 16);
  q_prepare(qr, qp, qp.qp0 + wid * QBLK + r32, hi);
  const int sr = tid >> 4, sc = (tid & 15) * 8, vst0 = v_st(sr, sc), vst1 = v_st(32 + sr, sc);
  const int vb0 = (int)(uintptr_t)V_lds + v_rd_base(lane);
  struct { bf16x8 vs0, vs1, ks0, ks1; } sr_[SDEPTH];
  const int mA = ma.kpos0 - ma.qpos0 - wid * 32 - r32 + 128 + 4 * hi;
  const int mrow = ma.qrow0 + (wid >> 1), mcol = (wid & 1) * 32 + r32;
  const int mrs = min(max(mrow - 4, 0), 120), mws = min(max(mcol - 8, 0), 48);
#define CC(r) (((r) & 3) + 8 * ((r) >> 2))
#define MASK(P0, P1, t) do { \
    if constexpr (MODE == 1) { if ((t) >= nct) { const int bd_ = mA + ((t) - nct) * 64; \
        _Pragma("unroll") for (int r_ = 0; r_ < 16; ++r_) { const unsigned u0_ = (unsigned)(bd_ + CC(r_)); P0[r_] = (u0_ <= 256u) ? P0[r_] : -1e30f; P1[r_] = (u0_ + 32u <= 256u) ? P1[r_] : -1e30f; } } } \
    if constexpr (MODE == 2) { if ((t) >= nct) { const int kr_ = ma.krow0 + ((t) - nct); \
        if (kr_ < mrs || kr_ >= mrs + 8) { _Pragma("unroll") for (int r_ = 0; r_ < 16; ++r_) { P0[r_] = -1e30f; P1[r_] = -1e30f; } } \
        else { const float* bt_ = ma.bt + (kr_ - mrow + 7) * 32; const int kb_ = 4 * hi - mws, db_ = 4 * hi - mcol + 15; \
          _Pragma("unroll") for (int r_ = 0; r_ < 16; ++r_) { \
            const float b0_ = bt_[min(max(db_ + CC(r_), 0), 30)], b1_ = bt_[min(max(db_ + CC(r_) + 32, 0), 30)]; \
            P0[r_] = ((unsigned)(kb_ + CC(r_)) < 16u) ? P0[r_] + b0_ : -1e30f; P1[r_] = ((unsigned)(kb_ + CC(r_) + 32) < 16u) ? P1[r_] + b1_ : -1e30f; \
            if ((r_ & 3) == 3) SBAR(); } } } } \
  } while (0)
#define TBASE(t) (((t) < nct) ? (Kc + (long)(t) * KVBLK * LDK) : (Kl + (long)((t) - nct) * KVBLK * LDK))
#define SLOAD(i, t) do { const bf16* kb_ = TBASE(t); sr_[i].vs0 = ld8(&kb_[(long)(sr) * LDK + sc + voff]); sr_[i].vs1 = ld8(&kb_[(long)(32 + sr) * LDK + sc + voff]); \
    sr_[i].ks0 = ld8(&kb_[(long)(sr) * LDK + sc]); sr_[i].ks1 = ld8(&kb_[(long)(32 + sr) * LDK + sc]); } while (0)
#define SWRITE(b, i) do { *(bf16x8*)((char*)V_lds + (b) * SHM_V + vst0) = sr_[i].vs0;          \
    *(bf16x8*)((char*)V_lds + (b) * SHM_V + vst1) = sr_[i].vs1; int kc = sc * 2;               \
    *(bf16x8*)((char*)K_lds + (b) * SHM_K + KSWZ(sr, kc)) = sr_[i].ks0;                       \
    *(bf16x8*)((char*)K_lds + (b) * SHM_K + KSWZ(32 + sr, kc)) = sr_[i].ks1; } while (0)
#define SWAIT() do { if constexpr (SDEPTH == 2) asm volatile("s_waitcnt vmcnt(4)" ::: "memory"); else asm volatile("s_waitcnt vmcnt(0)" ::: "memory"); } while (0)
#define RESC(a) do { if (__any((a) < 1.f)) { if (hi == 0) al_l[r32] = (a); asm volatile("s_waitcnt lgkmcnt(0)" ::: "memory"); \
    for (int d = 0; d < 4; ++d) for (int r = 0; r < 16; ++r) o[d][r] *= al_l[crow(r, hi)]; } } while (0)
  f32x16 pA0, pA1, pB0, pB1; float mnA, mnB, alA, alB; bf16x8 pa0, pa1, pa2, pa3;
  constexpr int SE = 0, SO = SDEPTH - 1;
  SLOAD(SE, 0); asm volatile("s_waitcnt vmcnt(0)" ::: "memory"); SWRITE(0, SE); __syncthreads();
  qkt(pA0, pA1, K_lds, qr, r32, hi); MASK(pA0, pA1, 0); partialSM(pA0, pA1, m_reg, mnA, alA);
  SLOAD(SO, 1); if constexpr (SDEPTH == 2) { if (2 < NT) SLOAD(SE, 2); }
  SWAIT(); SWRITE(1, SO); __syncthreads();
  for (int j = 1; j + 1 < NT; j += 2) {
    SBAR(); qkt(pB0, pB1, (bf16*)((char*)K_lds + SHM_K), qr, r32, hi);
    finishSM(pA0, pA1, alA, l_reg, pa0, pa1, pa2, pa3); SBAR();
    SLOAD(SO, (j + SDEPTH)); SBAR();
    pv_d0(o, vb0, pa0, pa1, pa2, pa3); MASK(pB0, pB1, j); partialSM(pB0, pB1, m_reg, mnB, alB);
    __syncthreads(); SWAIT(); SWRITE(0, SE);
    RESC(alB); __syncthreads();
    SBAR(); qkt(pA0, pA1, K_lds, qr, r32, hi);
    finishSM(pB0, pB1, alB, l_reg, pa0, pa1, pa2, pa3); SBAR();
    if (SDEPTH == 1 || j + 3 < NT) SLOAD(SE, (j + 1 + SDEPTH)); SBAR();
    pv_d0(o, vb0 + (int)SHM_V, pa0, pa1, pa2, pa3); MASK(pA0, pA1, j + 1); partialSM(pA0, pA1, m_reg, mnA, alA);
    __syncthreads(); SWAIT(); SWRITE(1, SO);
    RESC(alA); __syncthreads();
  }
  SBAR(); qkt(pB0, pB1, (bf16*)((char*)K_lds + SHM_K), qr, r32, hi);
  finishSM(pA0, pA1, alA, l_reg, pa0, pa1, pa2, pa3); SBAR();
  pv_d0(o, vb0, pa0, pa1, pa2, pa3); MASK(pB0, pB1, NT - 1); partialSM(pB0, pB1, m_reg, mnB, alB);
  __syncthreads(); RESC(alB);
  finishSM(pB0, pB1, alB, l_reg, pa0, pa1, pa2, pa3); SBAR();
  pv_d0(o, vb0 + (int)SHM_V, pa0, pa1, pa2, pa3);
  if (ma.has_sink) l_reg += __builtin_amdgcn_exp2f(ma.sink * 1.4426950408889634f - m_reg * (SCALE * 1.4426950408889634f));
  if (hi == 0) li_l[r32] = l_reg; asm volatile("s_waitcnt lgkmcnt(0)" ::: "memory");
  float rli[16];
#pragma unroll
  for (int r = 0; r < 16; ++r) rli[r] = __builtin_amdgcn_rcpf(li_l[crow(r, hi)]);
  unsigned char* Ow = Ob + (long)(wid * QBLK) * LDO;
#pragma unroll
  for (int r = 0; r < 16; ++r) { int orow = crow(r, hi);
#pragma unroll
    for (int d0 = 0; d0 < 4; d0 += 1) { const float f = o[d0][r] * rli[r] * 32.f;
      Ow[(long)orow * LDO + d0 * 32 + r32] = (unsigned char)((unsigned)__builtin_amdgcn_cvt_pk_fp8_f32(f, f, 0, false) & 0xffu); } }
#undef CC
#undef MASK
#undef TBASE
#undef SLOAD
#undef SWRITE
#undef SWAIT
#undef RESC
}

template <int MODE, int LDQ, int LDK, int LDO>
__device__ __forceinline__ void attn_body_simple(const bf16* __restrict__ Qb, const bf16* __restrict__ Kc, const bf16* __restrict__ Kl, int voff, int nct,
                                                 unsigned char* __restrict__ Ob, int NT, char* lds, const MaskArgs ma, const QPrep qp) {
  const int tid = mk_ltid(), wid = __builtin_amdgcn_readfirstlane(tid >> 6), lane = tid & 63, r32 = lane & 31, hi = lane >> 5;
  bf16* V_lds = (bf16*)lds; bf16* K_lds = (bf16*)(lds + 2 * SHM_V);
  float* ws = (float*)(lds + 2 * SHM_V + 2 * SHM_K) + wid * 64; float* li_l = ws; float* al_l = ws + 32;
  float m_reg = -1e30f, l_reg = 0; f32x16 o[4] = {}; bf16x8 qr[8];
  const bf16* Qw = Qb + (long)(wid * QBLK + r32) * LDQ + hi * 8;
#pragma unroll
  for (int d0 = 0; d0 < 8; ++d0) qr[d0] = ld8(Qw + d0 * 16);
  q_prepare(qr, qp, qp.qp0 + wid * QBLK + r32, hi);
  const int sr = tid >> 4, sc = (tid & 15) * 8, vst0 = v_st(sr, sc), vst1 = v_st(32 + sr, sc);
  const int vb0 = (int)(uintptr_t)V_lds + v_rd_base(lane);
  bf16x8 vs0, vs1, ks0, ks1;
  const int mA = ma.kpos0 - ma.qpos0 - wid * 32 - r32 + 128 + 4 * hi;
  const int mA0 = ma.kpos0 - ma.qpos0 - wid * 32;
  const int mrow = ma.qrow0 + (wid >> 1), mcol = (wid & 1) * 32 + r32;
  const int mrs = min(max(mrow - 4, 0), 120), mws = min(max(mcol - 8, 0), 48);
#define CC(r) (((r) & 3) + 8 * ((r) >> 2))
#define TBASE(t) (((t) < nct) ? (Kc + (long)(t) * KVBLK * LDK) : (Kl + (long)((t) - nct) * KVBLK * LDK))
#define SLOAD(t) do { const bf16* kb_ = TBASE(t); vs0 = ld8(&kb_[(long)(sr) * LDK + sc + voff]); vs1 = ld8(&kb_[(long)(32 + sr) * LDK + sc + voff]); \
    ks0 = ld8(&kb_[(long)(sr) * LDK + sc]); ks1 = ld8(&kb_[(long)(32 + sr) * LDK + sc]); } while (0)
#define SWRITE(b) do { *(bf16x8*)((char*)V_lds + (b) * SHM_V + vst0) = vs0; *(bf16x8*)((char*)V_lds + (b) * SHM_V + vst1) = vs1; const int kc = sc * 2; \
    *(bf16x8*)((char*)K_lds + (b) * SHM_K + KSWZ(sr, kc)) = ks0; *(bf16x8*)((char*)K_lds + (b) * SHM_K + KSWZ(32 + sr, kc)) = ks1; } while (0)
  SLOAD(0); SWRITE(0); __syncthreads();
  for (int j = 0; j < NT; ++j) {
    const int b = j & 1;
    if (j + 1 < NT) SLOAD(j + 1);
    bool active = true;
    if constexpr (MODE == 1) { if (j >= nct) { const int b0 = mA0 + (j - nct) * 64; active = (b0 + 63 >= -128) && (b0 - 31 <= 128); } }
    if constexpr (MODE == 2) { if (j >= nct) { const int kr = ma.krow0 + (j - nct); active = (kr >= mrs) && (kr < mrs + 8); } }
    if (active) {
      f32x16 p0, p1; float mn, al; bf16x8 pa0, pa1, pa2, pa3;
      qkt(p0, p1, (bf16*)((char*)K_lds + b * SHM_K), qr, r32, hi);
      if constexpr (MODE == 1) { if (j >= nct) { const int bd = mA + (j - nct) * 64;
#pragma unroll
          for (int r = 0; r < 16; ++r) { const unsigned u0 = (unsigned)(bd + CC(r)); p0[r] = (u0 <= 256u) ? p0[r] : -1e30f; p1[r] = (u0 + 32u <= 256u) ? p1[r] : -1e30f; } } }
      if constexpr (MODE == 2) { if (j >= nct) { const int kr = ma.krow0 + (j - nct);
          const float* bt = ma.bt + (kr - mrow + 7) * 32; const int kb = 4 * hi - mws, db = 4 * hi - mcol + 15;
#pragma unroll
          for (int r = 0; r < 16; ++r) {
            const float b0 = bt[min(max(db + CC(r), 0), 30)], b1 = bt[min(max(db + CC(r) + 32, 0), 30)];
            p0[r] = ((unsigned)(kb + CC(r)) < 16u) ? p0[r] + b0 : -1e30f; p1[r] = ((unsigned)(kb + CC(r) + 32) < 16u) ? p1[r] + b1 : -1e30f; } } }
      partialSM(p0, p1, m_reg, mn, al);
      if (__any(al < 1.f)) { if (hi == 0) al_l[r32] = al; asm volatile("s_waitcnt lgkmcnt(0)" ::: "memory");
        for (int d = 0; d < 4; ++d) for (int r = 0; r < 16; ++r) o[d][r] *= al_l[crow(r, hi)]; }
      finishSM(p0, p1, al, l_reg, pa0, pa1, pa2, pa3);
      pv_d0(o, vb0 + b * (int)SHM_V, pa0, pa1, pa2, pa3);
    }
    if (j + 1 < NT) SWRITE(b ^ 1);
    __syncthreads();
  }
  if (ma.has_sink) l_reg += __builtin_amdgcn_exp2f(ma.sink * 1.4426950408889634f - m_reg * (SCALE * 1.4426950408889634f));
  if (hi == 0) li_l[r32] = l_reg; asm volatile("s_waitcnt lgkmcnt(0)" ::: "memory");
  float rli[16];
#pragma unroll
  for (int r = 0; r < 16; ++r) rli[r] = __builtin_amdgcn_rcpf(li_l[crow(r, hi)]);
  unsigned char* Ow = Ob + (long)(wid * QBLK) * LDO;
#pragma unroll
  for (int r = 0; r < 16; ++r) { int orow = crow(r, hi);
#pragma unroll
    for (int d0 = 0; d0 < 4; d0 += 1) { const float f = o[d0][r] * rli[r] * 32.f;
      Ow[(long)orow * LDO + d0 * 32 + r32] = (unsigned char)((unsigned)__builtin_amdgcn_cvt_pk_fp8_f32(f, f, 0, false) & 0xffu); } }
#undef CC
#undef TBASE
#undef SLOAD
#undef SWRITE
}

using i32x8 = __attribute__((ext_vector_type(8))) int;
using i32x4 = __attribute__((ext_vector_type(4))) int;
#define MF8_ACC(ACC, A8, B8) asm volatile("v_mfma_scale_f32_32x32x64_f8f6f4 %0, %1, %2, %0, %3, %4 op_sel_hi:[0,0,0]" : "+v"(ACC) : "v"(A8), "v"(B8), "v"(sc1), "v"(sc1))
#define MF8_NEW(ACC, A8, B8) asm volatile("v_mfma_scale_f32_32x32x64_f8f6f4 %0, %1, %2, 0, %3, %4 op_sel_hi:[0,0,0]" : "=&v"(ACC) : "v"(A8), "v"(B8), "v"(sc1), "v"(sc1))
#define NOP16 "s_nop 15\n\t"
#define PIN2_LONG(X, Y) asm volatile(NOP16 NOP16 NOP16 NOP16 NOP16 NOP16 NOP16 NOP16 NOP16 NOP16 NOP16 NOP16 NOP16 NOP16 NOP16 NOP16 NOP16 NOP16 NOP16 NOP16 : "+v"(X), "+v"(Y))
#define PIN2_SHORT(X, Y) asm volatile(NOP16 NOP16 : "+v"(X), "+v"(Y))
#define PIN4(O) asm volatile(NOP16 NOP16 NOP16 NOP16 NOP16 NOP16 NOP16 NOP16 NOP16 NOP16 NOP16 NOP16 NOP16 NOP16 NOP16 NOP16 NOP16 NOP16 NOP16 NOP16 : "+v"(O[0]), "+v"(O[1]), "+v"(O[2]), "+v"(O[3]))
__device__ __forceinline__ void partialSM8(f32x16& p0, f32x16& p1, float& m_reg, float& mn, float& alpha) {
  constexpr float C = SCALE * 1.4426950408889634f; constexpr float THR8 = 3.f;
  float pmax = p0[0]; for (int r = 1; r < 16; ++r) pmax = fmaxf(pmax, p0[r]); for (int r = 0; r < 16; ++r) pmax = fmaxf(pmax, p1[r]);
  { auto rr = __builtin_amdgcn_permlane32_swap(__float_as_uint(pmax), __float_as_uint(pmax), false, false);
    pmax = fmaxf(__uint_as_float(rr[0]), __uint_as_float(rr[1])); }
  if (__builtin_expect(__all(pmax - m_reg <= THR8 / SCALE), 1)) { mn = m_reg; alpha = 1.f; }
  else { mn = fmaxf(m_reg, pmax); alpha = __builtin_amdgcn_exp2f((m_reg - mn) * C); m_reg = mn; }
  float mnC = -mn * C + 4.f;
  for (int r = 0; r < 16; ++r) p0[r] = fmaf(p0[r], C, mnC); for (int r = 0; r < 16; ++r) p1[r] = fmaf(p1[r], C, mnC);
  for (int r = 0; r < 16; ++r) p0[r] = __builtin_amdgcn_exp2f(p0[r]);
}
__device__ __forceinline__ void finishSM8(f32x16& p0, f32x16& p1, float alpha, float& l_reg, i32x8& pa) {
  for (int r = 0; r < 16; ++r) p1[r] = __builtin_amdgcn_exp2f(p1[r]);
  float ps = 0; for (int r = 0; r < 16; ++r) ps += p0[r]; for (int r = 0; r < 16; ++r) ps += p1[r];
  { auto rr = __builtin_amdgcn_permlane32_swap(__float_as_uint(ps), __float_as_uint(ps), false, false);
    ps = __uint_as_float(rr[0]) + __uint_as_float(rr[1]); }
  l_reg = l_reg * alpha + ps;
#pragma unroll
  for (int j = 0; j < 4; ++j) { int w = 0; w = __builtin_amdgcn_cvt_pk_fp8_f32(p0[4 * j], p0[4 * j + 1], w, false); w = __builtin_amdgcn_cvt_pk_fp8_f32(p0[4 * j + 2], p0[4 * j + 3], w, true); pa[j] = w;
    int v = 0; v = __builtin_amdgcn_cvt_pk_fp8_f32(p1[4 * j], p1[4 * j + 1], v, false); v = __builtin_amdgcn_cvt_pk_fp8_f32(p1[4 * j + 2], p1[4 * j + 3], v, true); pa[4 + j] = v; }
}
__device__ __forceinline__ void qkt8(f32x16& p0, f32x16& p1, const char* Kb, const i32x8 (&qf)[2], int r32, int hi, int sc1) {
  i32x8 kf[2][2];
#pragma unroll
  for (int kc = 0; kc < 2; ++kc)
#pragma unroll
    for (int kh = 0; kh < 2; ++kh) { const int row = kh * 32 + r32, c16 = kc * 4 + hi * 2;
      const i32x4 lo = *reinterpret_cast<const i32x4*>(Kb + row * 128 + ((c16 ^ ((row >> 1) & 7)) << 4)), hh = *reinterpret_cast<const i32x4*>(Kb + row * 128 + (((c16 + 1) ^ ((row >> 1) & 7)) << 4));
      kf[kc][kh] = __builtin_shufflevector(lo, hh, 0, 1, 2, 3, 4, 5, 6, 7); }
  asm volatile("s_waitcnt lgkmcnt(0)" ::: "memory");
  MF8_NEW(p0, kf[0][0], qf[0]); MF8_NEW(p1, kf[0][1], qf[0]); MF8_ACC(p0, kf[1][0], qf[1]); MF8_ACC(p1, kf[1][1], qf[1]);
}
__device__ __forceinline__ void pv8(f32x16* o, const char* Vb, const i32x8 pa, int r32, int hi, int sc1) {
  i32x8 vf[4];
#pragma unroll
  for (int d0 = 0; d0 < 4; ++d0) { const int col = d0 * 32 + r32, ch = hi * 2, sw = (col >> 2) & 3;
    const i32x4 lo = *reinterpret_cast<const i32x4*>(Vb + col * 64 + ((ch ^ sw) << 4)), hh = *reinterpret_cast<const i32x4*>(Vb + col * 64 + (((ch + 1) ^ sw) << 4));
    vf[d0] = __builtin_shufflevector(lo, hh, 0, 1, 2, 3, 4, 5, 6, 7); }
  asm volatile("s_waitcnt lgkmcnt(0)" ::: "memory");
  MF8_ACC(o[0], pa, vf[0]); MF8_ACC(o[1], pa, vf[1]); MF8_ACC(o[2], pa, vf[2]); MF8_ACC(o[3], pa, vf[3]);
}
template <int LDQ, int LDO>
__device__ __forceinline__ void attn_body_fp8(const bf16* __restrict__ Qb, const unsigned char* __restrict__ Kimg, const unsigned char* __restrict__ Vimg,
                                              unsigned char* __restrict__ Ob, int NT, char* lds, const QPrep qp) {
  const int tid = mk_ltid(), wid = tid >> 6, lane = tid & 63, r32 = lane & 31, hi = lane >> 5;
  constexpr int SHM8 = 8192;
  char* V_lds = lds; char* K_lds = lds + 2 * SHM8;
  float* ws = (float*)(lds + 4 * SHM8) + wid * 64; float* li_l = ws; float* al_l = ws + 32;
  const int sc1 = 0x7F7F7F7F;
  float m_reg = -1e30f, l_reg = 0; f32x16 o[4] = {}; bf16x8 qr[8];
  const bf16* Qw = Qb + (long)(wid * QBLK + r32) * LDQ + hi * 8;
#pragma unroll
  for (int d0 = 0; d0 < 8; ++d0) qr[d0] = ld8(Qw + d0 * 16);
  q_prepare(qr, qp, qp.qp0 + wid * QBLK + r32, hi);
  i32x8 qf[2];
#pragma unroll
  for (int kc = 0; kc < 2; ++kc)
#pragma unroll
    for (int i = 0; i < 4; ++i) { const u32x4 w = *reinterpret_cast<const u32x4*>(&qr[4 * kc + i]);
      const float f0 = __uint_as_float(w[0] << 16), f1 = __uint_as_float(w[0] & 0xffff0000u), f2 = __uint_as_float(w[1] << 16), f3 = __uint_as_float(w[1] & 0xffff0000u);
      const float f4 = __uint_as_float(w[2] << 16), f5 = __uint_as_float(w[2] & 0xffff0000u), f6 = __uint_as_float(w[3] << 16), f7 = __uint_as_float(w[3] & 0xffff0000u);
      int a = 0; a = __builtin_amdgcn_cvt_pk_fp8_f32(f0, f1, a, false); a = __builtin_amdgcn_cvt_pk_fp8_f32(f2, f3, a, true);
      int b = 0; b = __builtin_amdgcn_cvt_pk_fp8_f32(f4, f5, b, false); b = __builtin_amdgcn_cvt_pk_fp8_f32(f6, f7, b, true);
      qf[kc][2 * i] = a; qf[kc][2 * i + 1] = b; }
  struct { u32x4 vs, ks; } sr_[2];
#define SLOAD8(i, t) do { sr_[i].vs = *reinterpret_cast<const u32x4*>(Vimg + (size_t)(t) * 8192 + tid * 16); sr_[i].ks = *reinterpret_cast<const u32x4*>(Kimg + (size_t)(t) * 8192 + tid * 16); } while (0)
#define SWRITE8(b, i) do { *reinterpret_cast<u32x4*>(V_lds + (b) * SHM8 + tid * 16) = sr_[i].vs; *reinterpret_cast<u32x4*>(K_lds + (b) * SHM8 + tid * 16) = sr_[i].ks; } while (0)
#define SWAIT8() asm volatile("s_waitcnt vmcnt(2)" ::: "memory")
#define RESC8(a) do { if (__any((a) < 1.f)) { if (hi == 0) al_l[r32] = (a); asm volatile("s_waitcnt lgkmcnt(0)" ::: "memory"); PIN4(o); \
    for (int d = 0; d < 4; ++d) for (int r = 0; r < 16; ++r) o[d][r] *= al_l[crow(r, hi)]; } } while (0)
  f32x16 pA0, pA1, pB0, pB1; float mnA, mnB, alA, alB; i32x8 pa;
  SLOAD8(0, 0); asm volatile("s_waitcnt vmcnt(0)" ::: "memory"); SWRITE8(0, 0); __syncthreads();
  qkt8(pA0, pA1, K_lds, qf, r32, hi, sc1); PIN2_LONG(pA0, pA1); partialSM8(pA0, pA1, m_reg, mnA, alA);
  SLOAD8(1, 1); if (2 < NT) SLOAD8(0, 2);
  SWAIT8(); SWRITE8(1, 1); __syncthreads();
  for (int j = 1; j + 1 < NT; j += 2) {
    SBAR(); qkt8(pB0, pB1, K_lds + SHM8, qf, r32, hi, sc1);
    finishSM8(pA0, pA1, alA, l_reg, pa); SBAR();
    SLOAD8(1, (j + 2)); SBAR();
    pv8(o, V_lds, pa, r32, hi, sc1); PIN2_SHORT(pB0, pB1); partialSM8(pB0, pB1, m_reg, mnB, alB);
    __syncthreads(); SWAIT8(); SWRITE8(0, 0);
    RESC8(alB); __syncthreads();
    SBAR(); qkt8(pA0, pA1, K_lds, qf, r32, hi, sc1);
    finishSM8(pB0, pB1, alB, l_reg, pa); SBAR();
    if (j + 3 < NT) SLOAD8(0, (j + 3)); SBAR();
    pv8(o, V_lds + SHM8, pa, r32, hi, sc1); PIN2_SHORT(pA0, pA1); partialSM8(pA0, pA1, m_reg, mnA, alA);
    __syncthreads(); SWAIT8(); SWRITE8(1, 1);
    RESC8(alA); __syncthreads();
  }
  SBAR(); qkt8(pB0, pB1, K_lds + SHM8, qf, r32, hi, sc1);
  finishSM8(pA0, pA1, alA, l_reg, pa); SBAR();
  pv8(o, V_lds, pa, r32, hi, sc1); PIN2_LONG(pB0, pB1); partialSM8(pB0, pB1, m_reg, mnB, alB);
  __syncthreads(); RESC8(alB);
  finishSM8(pB0, pB1, alB, l_reg, pa); SBAR();
  pv8(o, V_lds + SHM8, pa, r32, hi, sc1);
  PIN4(o);
  if (hi == 0) li_l[r32] = l_reg; asm volatile("s_waitcnt lgkmcnt(0)" ::: "memory");
  float rli[16];
#pragma unroll
  for (int r = 0; r < 16; ++r) rli[r] = __builtin_amdgcn_rcpf(li_l[crow(r, hi)]);
  unsigned char* Ow = Ob + (long)(wid * QBLK) * LDO;
#pragma unroll
  for (int r = 0; r < 16; ++r) { int orow = crow(r, hi);
#pragma unroll
    for (int d0 = 0; d0 < 4; d0 += 1) { const float f = o[d0][r] * rli[r] * 32.f;
      Ow[(long)orow * LDO + d0 * 32 + r32] = (unsigned char)((unsigned)__builtin_amdgcn_cvt_pk_fp8_f32(f, f, 0, false) & 0xffu); } }
#undef SLOAD8
#undef SWRITE8
#undef SWAIT8
#undef RESC8
}
#define AS3 __attribute__((address_space(3)))
__device__ __forceinline__ void mq_new(f32x16& acc, const i32x8& a, const i32x8& b, const f32x16& c, f32x16& t1, float& t2, i32x8& t3, int sa, int sb) {
  asm volatile("v_mfma_scale_f32_32x32x64_f8f6f4 %[acc], %[a], %[b], %[c], %[sa], %[sb] op_sel_hi:[0,0,0]"
               : [acc] "=&v"(acc), "+v"(t1), "+v"(t2), "+v"(t3) : [a] "v"(a), [b] "v"(b), [c] "v"(c), [sa] "v"(sa), [sb] "v"(sb)); }
__device__ __forceinline__ void mq_acc(f32x16& acc, const i32x8& a, const i32x8& b, f32x16& t1, float& t2, i32x8& t3, int sa, int sb) {
  asm volatile("v_mfma_scale_f32_32x32x64_f8f6f4 %[acc], %[a], %[b], %[acc], %[sa], %[sb] op_sel_hi:[0,0,0]"
               : [acc] "+v"(acc), "+v"(t1), "+v"(t2), "+v"(t3) : [a] "v"(a), [b] "v"(b), [sa] "v"(sa), [sb] "v"(sb)); }
__device__ __forceinline__ void mp_acc(f32x16& acc, const i32x8& a, const i32x8& b, f32x16& t1, float& t2, int sc) {
  asm volatile("v_mfma_scale_f32_32x32x64_f8f6f4 %[acc], %[a], %[b], %[acc], %[sa], %[sa] op_sel_hi:[0,0,0]"
               : [acc] "+v"(acc), "+v"(t1), "+v"(t2) : [a] "v"(a), [b] "v"(b), [sa] "v"(sc)); }
__device__ __forceinline__ int pk8(float a, float b, float c, float d, int w = 0) { w = __builtin_amdgcn_cvt_pk_fp8_f32(a, b, w, false); w = __builtin_amdgcn_cvt_pk_fp8_f32(c, d, w, true); return w; }
template <int K>
__device__ __forceinline__ void fin_chunk(const f32x16& p0, f32x16& p1, float& ps, i32x8& pa) {
#pragma unroll
  for (int r = 4 * K; r < 4 * K + 4; ++r) p1[r] = __builtin_amdgcn_exp2f(p1[r]);
  if constexpr (K < 2) { pa[2 * K] = pk8(p0[8 * K], p0[8 * K + 1], p0[8 * K + 2], p0[8 * K + 3], pa[2 * K]); pa[2 * K + 1] = pk8(p0[8 * K + 4], p0[8 * K + 5], p0[8 * K + 6], p0[8 * K + 7], pa[2 * K + 1]); }
  else { constexpr int b = 8 * (K - 2);
#pragma unroll
    for (int r = b; r < b + 8; ++r) ps += p1[r];
    pa[2 * K] = pk8(p1[b], p1[b + 1], p1[b + 2], p1[b + 3], pa[2 * K]); pa[2 * K + 1] = pk8(p1[b + 4], p1[b + 5], p1[b + 6], p1[b + 7], pa[2 * K + 1]); }
}
template <int R0, int R1>
__device__ __forceinline__ void exp_chunk(f32x16& p0, float& ps) {
#pragma unroll
  for (int r = R0; r < R1; ++r) p0[r] = __builtin_amdgcn_exp2f(p0[r]);
#pragma unroll
  for (int r = R0; r < R1; ++r) ps += p0[r];
}
template <bool FIRST>
__device__ __forceinline__ void max_phase(f32x16& p0, f32x16& p1, f32x16& negm, float& alpha) {
  constexpr float T8 = 3.f * 1.4426950408889634f;
  float pmax = p0[0];
#pragma unroll
  for (int r = 1; r < 16; ++r) pmax = fmaxf(pmax, p0[r]);
#pragma unroll
  for (int r = 0; r < 16; ++r) pmax = fmaxf(pmax, p1[r]);
  { auto rr = __builtin_amdgcn_permlane32_swap(__float_as_uint(pmax), __float_as_uint(pmax), false, false);
    pmax = fmaxf(__uint_as_float(rr[0]), __uint_as_float(rr[1])); }
  alpha = 1.f;
  if (FIRST || __builtin_expect(!__all(pmax <= 4.f + T8), 0)) {
    const float delta = FIRST ? pmax - 4.f : fmaxf(pmax - 4.f, 0.f);
    if (!FIRST) alpha = __builtin_amdgcn_exp2f(-delta);
#pragma unroll
    for (int r = 0; r < 16; ++r) { p0[r] -= delta; p1[r] -= delta; negm[r] -= delta; }
  }
}
template <int LDQ, int LDO, int NT>
__device__ __forceinline__ void attn_body_fp8i(const bf16* __restrict__ Qb, const unsigned char* __restrict__ Kimg, const unsigned char* __restrict__ Vimg,
                                               unsigned char* __restrict__ Ob, char* lds_g, const QPrep qp) {
  const int tid = mk_ltid(), wid = __builtin_amdgcn_readfirstlane(tid >> 6), lane = tid & 63, r32 = lane & 31, hi = lane >> 5;
  constexpr int SLOT = 16384;
  AS3 unsigned char* lds = (AS3 unsigned char*)lds_g;
  float* ws = (float*)(lds_g + 4 * SLOT) + wid * 64; float* li_l = ws; float* al_l = ws + 32;
  const int sc1 = 0x7F7F7F7F, scq = 0x7C7C7C7C;
#define DMA8(t) do { const int so_ = ((t) & 3) * SLOT + wid * 1024; \
    __builtin_amdgcn_global_load_lds((const unsigned*)(Vimg + (size_t)(t) * 8192 + tid * 16), (AS3 unsigned*)(lds + so_), 16, 0, 0); \
    __builtin_amdgcn_global_load_lds((const unsigned*)(Kimg + (size_t)(t) * 8192 + tid * 16), (AS3 unsigned*)(lds + so_ + 8192), 16, 0, 0); } while (0)
#define DMA8V(t) do { const int so_ = ((t) & 3) * SLOT + wid * 1024; \
    __builtin_amdgcn_global_load_lds((const unsigned*)(Vimg + (size_t)(t) * 8192 + tid * 16), (AS3 unsigned*)(lds + so_), 16, 0, 0); } while (0)
#define DMA8K(t) do { const int so_ = ((t) & 3) * SLOT + wid * 1024; \
    __builtin_amdgcn_global_load_lds((const unsigned*)(Kimg + (size_t)(t) * 8192 + tid * 16), (AS3 unsigned*)(lds + so_ + 8192), 16, 0, 0); } while (0)
  DMA8(0); DMA8(1); DMA8(2);
  float l_reg = 0; f32x16 o[4] = {}; f32x16 negm = {};
  i32x8 qf[2];
  { bf16x8 qr[8];
    const bf16* Qw = Qb + (long)(wid * QBLK + r32) * LDQ + hi * 8;
#pragma unroll
    for (int d0 = 0; d0 < 8; ++d0) qr[d0] = ld8(Qw + d0 * 16);
    q_prepare(qr, qp, qp.qp0 + wid * QBLK + r32, hi);
    constexpr float QS = SCALE * 1.4426950408889634f * 8.f;
#pragma unroll
    for (int kc = 0; kc < 2; ++kc)
#pragma unroll
      for (int i = 0; i < 4; ++i) { const u32x4 w = *reinterpret_cast<const u32x4*>(&qr[4 * kc + i]);
        const float f0 = __uint_as_float(w[0] << 16) * QS, f1 = __uint_as_float(w[0] & 0xffff0000u) * QS, f2 = __uint_as_float(w[1] << 16) * QS, f3 = __uint_as_float(w[1] & 0xffff0000u) * QS;
        const float f4 = __uint_as_float(w[2] << 16) * QS, f5 = __uint_as_float(w[2] & 0xffff0000u) * QS, f6 = __uint_as_float(w[3] << 16) * QS, f7 = __uint_as_float(w[3] & 0xffff0000u) * QS;
        qf[kc][2 * i] = pk8(f0, f1, f2, f3); qf[kc][2 * i + 1] = pk8(f4, f5, f6, f7); } }
  int ka[4], va[2];
#pragma unroll
  for (int kc = 0; kc < 2; ++kc)
#pragma unroll
    for (int x = 0; x < 2; ++x) ka[kc * 2 + x] = 8192 + r32 * 128 + (((kc * 4 + hi * 2 + x) ^ ((r32 >> 1) & 7)) << 4);
#pragma unroll
  for (int x = 0; x < 2; ++x) va[x] = r32 * 64 + (((hi * 2 + x) ^ ((r32 >> 2) & 3)) << 4);
  i32x8 kf[2][2], vf[4], pa = {};
#define LDK8(t) do { const int so_ = ((t) & 3) * SLOT; _Pragma("unroll") for (int kc = 0; kc < 2; ++kc) _Pragma("unroll") for (int kh = 0; kh < 2; ++kh) { \
    const i32x4 lo_ = *(const AS3 i32x4*)(lds + so_ + ka[kc * 2] + kh * 4096), hh_ = *(const AS3 i32x4*)(lds + so_ + ka[kc * 2 + 1] + kh * 4096); \
    kf[kc][kh] = __builtin_shufflevector(lo_, hh_, 0, 1, 2, 3, 4, 5, 6, 7); } } while (0)
#define LDV8(t) do { const int so_ = ((t) & 3) * SLOT; _Pragma("unroll") for (int d0 = 0; d0 < 4; ++d0) { \
    const i32x4 lo_ = *(const AS3 i32x4*)(lds + so_ + va[0] + d0 * 2048), hh_ = *(const AS3 i32x4*)(lds + so_ + va[1] + d0 * 2048); \
    vf[d0] = __builtin_shufflevector(lo_, hh_, 0, 1, 2, 3, 4, 5, 6, 7); } } while (0)
#define LGK0() asm volatile("s_waitcnt lgkmcnt(0)" ::: "memory")
#define MEMB() asm volatile("" ::: "memory")
#define PINQ(X, Y, Z, W) asm volatile("s_nop 7" : "+v"(X), "+v"(Y), "+v"(Z), "+v"(W))
#define RESC8I(a) do { if (__any((a) < 1.f)) { if (hi == 0) al_l[r32] = (a); LGK0(); PIN4(o); \
    _Pragma("unroll") for (int d = 0; d < 4; ++d) _Pragma("unroll") for (int r = 0; r < 16; ++r) o[d][r] *= al_l[crow(r, hi)]; } } while (0)
#if defined(MK_PROBE_A)
  float dmy = 1.f;
#define PROBE_HOOK() asm volatile("v_exp_f32 %0, %0\n v_exp_f32 %0, %0\n v_exp_f32 %0, %0\n v_exp_f32 %0, %0\n v_exp_f32 %0, %0\n v_exp_f32 %0, %0\n v_exp_f32 %0, %0\n v_exp_f32 %0, %0\n v_exp_f32 %0, %0\n v_exp_f32 %0, %0\n v_exp_f32 %0, %0\n v_exp_f32 %0, %0\n v_exp_f32 %0, %0\n v_exp_f32 %0, %0\n v_exp_f32 %0, %0\n v_exp_f32 %0, %0" : "+v"(dmy))
#elif defined(MK_PROBE_A2)
  float dmy = 1.f;
#define PROBE_HOOK() asm volatile("v_add_f32 %0, %0, %0\n v_add_f32 %0, %0, %0\n v_add_f32 %0, %0, %0\n v_add_f32 %0, %0, %0\n v_add_f32 %0, %0, %0\n v_add_f32 %0, %0, %0\n v_add_f32 %0, %0, %0\n v_add_f32 %0, %0, %0\n v_add_f32 %0, %0, %0\n v_add_f32 %0, %0, %0\n v_add_f32 %0, %0, %0\n v_add_f32 %0, %0, %0\n v_add_f32 %0, %0, %0\n v_add_f32 %0, %0, %0\n v_add_f32 %0, %0, %0\n v_add_f32 %0, %0, %0\n v_add_f32 %0, %0, %0\n v_add_f32 %0, %0, %0\n v_add_f32 %0, %0, %0\n v_add_f32 %0, %0, %0\n v_add_f32 %0, %0, %0\n v_add_f32 %0, %0, %0\n v_add_f32 %0, %0, %0\n v_add_f32 %0, %0, %0\n v_add_f32 %0, %0, %0\n v_add_f32 %0, %0, %0\n v_add_f32 %0, %0, %0\n v_add_f32 %0, %0, %0\n v_add_f32 %0, %0, %0\n v_add_f32 %0, %0, %0\n v_add_f32 %0, %0, %0\n v_add_f32 %0, %0, %0" : "+v"(dmy))
#elif defined(MK_PROBE_B)
  i32x8 z8 = {};
#define PROBE_HOOK() do { asm volatile("" : "+v"(z8)); mp_acc(o[0], z8, kf[0][0], o[2], l_reg, sc1); mp_acc(o[1], z8, kf[0][0], o[2], l_reg, sc1); } while (0)
#elif defined(MK_PROBE_C)
  i32x4 dq;
#define PROBE_HOOK() do { _Pragma("unroll") for (int q_ = 0; q_ < 8; ++q_) asm volatile("ds_read_b128 %0, %1" : "=v"(dq) : "v"((int)(size_t)(lds + ka[q_ & 3] + (q_ >> 2) * 4096)) : "memory"); asm volatile("s_waitcnt lgkmcnt(0)" : "+v"(dq) :: "memory"); } while (0)
#elif defined(MK_PROBE_D)
#define PROBE_HOOK() __builtin_amdgcn_s_barrier()
#else
#define PROBE_HOOK() do {} while (0)
#endif
#define STEP8I(s, N0, N1, O0, O1, psN, psO, alN, alO) do { \
    __builtin_amdgcn_s_barrier(); \
      \
    if (wid < 4) { LDK8((s) + 1); asm volatile("" : "+v"(O0), "+v"(psO) :: "memory"); exp_chunk<8, 16>(O0, psO); } \
    else { asm volatile("" : "+v"(O0), "+v"(psO) :: "memory"); exp_chunk<8, 16>(O0, psO); asm volatile("" : "+v"(O0), "+v"(psO) :: "memory"); LDK8((s) + 1); } \
    asm volatile("s_waitcnt lgkmcnt(0)" : "+v"(O0), "+v"(psO) :: "memory"); \
    PROBE_HOOK(); mq_new(N0, kf[0][0], qf[0], negm, O1, psO, pa, sc1, scq); fin_chunk<0>(O0, O1, psO, pa); \
    mq_new(N1, kf[0][1], qf[0], negm, O1, psO, pa, sc1, scq); fin_chunk<1>(O0, O1, psO, pa); \
    mq_acc(N0, kf[1][0], qf[1], O1, psO, pa, sc1, scq);       fin_chunk<2>(O0, O1, psO, pa); \
    mq_acc(N1, kf[1][1], qf[1], O1, psO, pa, sc1, scq);       MEMB(); LDV8(s); fin_chunk<3>(O0, O1, psO, pa); \
    { auto rr_ = __builtin_amdgcn_permlane32_swap(__float_as_uint(psO), __float_as_uint(psO), false, false); l_reg = l_reg * alO + (__uint_as_float(rr_[0]) + __uint_as_float(rr_[1])); } \
    LGK0(); psN = 0.f; \
    mp_acc(o[0], pa, vf[0], N0, psN, sc1); PINQ(N0, N1, l_reg, psN); max_phase<false>(N0, N1, negm, alN); \
    mp_acc(o[1], pa, vf[1], N0, psN, sc1); if ((s) + 3 < NT) DMA8V((s) + 3);     \
    exp_chunk<0, 3>(N0, psN); \
    mp_acc(o[2], pa, vf[2], N0, psN, sc1); if ((s) + 3 < NT) DMA8K((s) + 3); \
    exp_chunk<3, 6>(N0, psN); \
    mp_acc(o[3], pa, vf[3], N0, psN, sc1); exp_chunk<6, 8>(N0, psN); \
    RESC8I(alN); \
    if ((s) + 3 < NT) asm volatile("s_waitcnt vmcnt(2)" ::: "memory"); else asm volatile("s_waitcnt vmcnt(0)" ::: "memory"); \
  } while (0)
  f32x16 pA0, pA1, pB0, pB1; float psA = 0.f, psB = 0.f, alA = 1.f, alB = 1.f;
  asm volatile("s_waitcnt vmcnt(4)" ::: "memory"); __builtin_amdgcn_s_barrier();
  LDK8(0); LGK0();
  mq_new(pA0, kf[0][0], qf[0], negm, o[0], psA, pa, sc1, scq); mq_new(pA1, kf[0][1], qf[0], negm, o[0], psA, pa, sc1, scq);
  mq_acc(pA0, kf[1][0], qf[1], o[0], psA, pa, sc1, scq); mq_acc(pA1, kf[1][1], qf[1], o[0], psA, pa, sc1, scq);
  PIN2_SHORT(pA0, pA1); max_phase<true>(pA0, pA1, negm, alA); exp_chunk<0, 8>(pA0, psA);
  asm volatile("s_waitcnt vmcnt(2)" ::: "memory");
  for (int s = 0; s + 2 < NT; s += 2) {
    STEP8I(s, pB0, pB1, pA0, pA1, psB, psA, alB, alA);
    STEP8I(s + 1, pA0, pA1, pB0, pB1, psA, psB, alA, alB);
  }
  STEP8I(NT - 2, pB0, pB1, pA0, pA1, psB, psA, alB, alA);
  exp_chunk<8, 16>(pB0, psB);
  fin_chunk<0>(pB0, pB1, psB, pa); fin_chunk<1>(pB0, pB1, psB, pa); fin_chunk<2>(pB0, pB1, psB, pa); fin_chunk<3>(pB0, pB1, psB, pa);
  { auto rr_ = __builtin_amdgcn_permlane32_swap(__float_as_uint(psB), __float_as_uint(psB), false, false); l_reg = l_reg * alB + (__uint_as_float(rr_[0]) + __uint_as_float(rr_[1])); }
  LDV8(NT - 1); LGK0();
  mp_acc(o[0], pa, vf[0], pB0, psB, sc1); mp_acc(o[1], pa, vf[1], pB0, psB, sc1); mp_acc(o[2], pa, vf[2], pB0, psB, sc1); mp_acc(o[3], pa, vf[3], pB0, psB, sc1);
  PIN4(o);
  if (hi == 0) li_l[r32] = l_reg; asm volatile("s_waitcnt lgkmcnt(0)" ::: "memory");
  float rli[16];
#pragma unroll
  for (int r = 0; r < 16; ++r) rli[r] = __builtin_amdgcn_rcpf(li_l[crow(r, hi)]);
  unsigned char* Ow = Ob + (long)(wid * QBLK) * LDO;
#pragma unroll
  for (int r = 0; r < 16; ++r) { int orow = crow(r, hi);
#pragma unroll
    for (int d0 = 0; d0 < 4; d0 += 1) { const float f = o[d0][r] * rli[r] * 32.f;
      Ow[(long)orow * LDO + d0 * 32 + r32] = (unsigned char)((unsigned)__builtin_amdgcn_cvt_pk_fp8_f32(f, f, 0, false) & 0xffu); } }
#undef DMA8
#undef DMA8V
#undef DMA8K
#undef LDK8
#undef LDV8
#undef STEP8I
#undef RESC8I
#undef PINQ
}
#undef KSWZ
#undef SBAR
}

namespace mk {
typedef unsigned short bf16;
typedef unsigned u32x4v __attribute__((ext_vector_type(4)));
typedef float f32x4v __attribute__((ext_vector_type(4)));
constexpr int D = 2048, NB = 2, L = 8192, CL = 256, TL = NB * L, TC = NB * CL, T = TL + TC, HD = 128, DEPTH = 4;
constexpr int NQ_AB = 4608, NQ_C = 3072, NE = 16384, NMOD = 6 * D;
constexpr float ALPHA = 1.6817928305074290f;
constexpr float SCALE = 0.088388347648318440f;
constexpr float NEG = -1e30f;
constexpr float U_SCALE = 64.f, V_SCALE = 8.f;
constexpr float W8_SCALE = 64.f, ATT8_SCALE = 32.f;
constexpr int SC_ONE = 0x7F7F7F7F, SC_W8 = 0x79797979  , SC_ATT8 = 0x7A7A7A7A  ;

constexpr size_t al256(size_t x) { return (x + 255) & ~(size_t)255; }
constexpr size_t WS_CTL    = 0;
constexpr size_t WS_MOD    = 16384;
constexpr size_t WS_ROPE   = al256(WS_MOD + (size_t)DEPTH * 3 * NMOD * 4);
constexpr size_t WS_WIN_AB = al256(WS_ROPE + 2 * 128 * 32 * 4);
constexpr size_t WS_WOUT_AB= al256(WS_WIN_AB + (size_t)2 * NQ_AB * D * 2);
constexpr size_t WS_WIN_C  = al256(WS_WOUT_AB + (size_t)2 * D * D * 2);
constexpr size_t WS_WOUT_C = al256(WS_WIN_C + (size_t)2 * NQ_C * D * 2);
constexpr size_t WS_WPQ    = al256(WS_WOUT_C + (size_t)2 * D * D * 2);
constexpr size_t WS_SK     = al256(WS_WPQ + (size_t)4 * D * D * 2);
constexpr size_t WS_U      = al256(WS_SK + (size_t)4 * 16 * 128 * 128 * 2);
constexpr size_t WS_V      = al256(WS_U + (size_t)4 * NE * D * 2);
constexpr size_t WS_X      = al256(WS_V + (size_t)4 * NE * D * 2);
constexpr size_t WS_H      = al256(WS_X + (size_t)T * D * 4);
constexpr size_t WS_QKV    = al256(WS_H + (size_t)T * D * 2);
constexpr size_t WS_ATT    = al256(WS_QKV + (size_t)T * NQ_AB * 2);
constexpr size_t WS_Y      = al256(WS_ATT + (size_t)T * D * 2);
constexpr size_t WS_PQ     = al256(WS_Y + (size_t)T * D * 4);
constexpr size_t WS_TOPV   = al256(WS_PQ + (size_t)T * D * 2);
constexpr size_t WS_TOPI   = al256(WS_TOPV + (size_t)T * 256 * 4);
constexpr size_t WS_IDX    = al256(WS_TOPI + (size_t)T * 256 * 4);
constexpr size_t WS_GATE   = al256(WS_IDX + (size_t)T * 128 * 4);
constexpr size_t WS_H8     = al256(WS_GATE + (size_t)T * 128 * 4);
constexpr int NTC = (CL + L) / 64;
constexpr size_t WS_K8     = al256(WS_H8 + (size_t)T * D);
constexpr size_t WS_VT8    = al256(WS_K8 + (size_t)NB * 4 * NTC * 8192);
constexpr size_t WS_USC    = al256(WS_VT8 + (size_t)NB * 4 * NTC * 8192);
constexpr size_t WS_HQ     = al256(WS_USC + (size_t)DEPTH * NE * 4);
constexpr size_t WS_HSC    = al256(WS_HQ + (size_t)T * D);
constexpr size_t WS_VSC    = al256(WS_HSC + (size_t)T * 4);
constexpr size_t WS_WQ     = al256(WS_VSC + (size_t)DEPTH * NE * 4);
constexpr size_t WS_WSC    = al256(WS_WQ + (size_t)T * 128);
constexpr size_t WS_PQSC   = al256(WS_WSC + (size_t)T * 4);
constexpr size_t WS_END    = al256(WS_PQSC + (size_t)DEPTH * D * 4);

constexpr int LDS_GEMM = 131072, LDS_MISC = LDS_GEMM, LDS_BYTES = LDS_GEMM + 256;

struct Params {
    const float *x, *c, *ctx, *c_ctx, *mod_w, *mod_b, *ln_g, *ln_b, *ab_w_in, *ab_w_out, *a_sink, *b_rpb, *c_w_in, *c_w_out, *c_q_gain, *c_k_gain, *peer_wq, *peer_sk, *peer_u, *peer_v;
    float* out; unsigned char* ws; int ph_lo, ph_hi;
};

__device__ __forceinline__ bf16 f2bf_rne(float f) { unsigned u = __float_as_uint(f); u += 0x7FFFu + ((u >> 16) & 1u); return (bf16)(u >> 16); }
__device__ __forceinline__ unsigned fp8_1(float f) { return (unsigned)__builtin_amdgcn_cvt_pk_fp8_f32(f, f, 0, false) & 0xffu; }
__device__ __forceinline__ unsigned fp8_4(float a, float b, float c, float d) { int w = 0; w = __builtin_amdgcn_cvt_pk_fp8_f32(a, b, w, false); w = __builtin_amdgcn_cvt_pk_fp8_f32(c, d, w, true); return (unsigned)w; }
__device__ __forceinline__ float bflo(unsigned u) { return __uint_as_float(u << 16); }
__device__ __forceinline__ float bfhi(unsigned u) { return __uint_as_float(u & 0xffff0000u); }
__device__ __forceinline__ unsigned pk2(float lo, float hi) { return pg8::cvt_pk_bf16(lo, hi); }
__device__ __forceinline__ float wave_sum(float v) {
#pragma unroll
    for (int o = 32; o >= 1; o >>= 1) v += __shfl_xor(v, o); return v; }
__device__ __forceinline__ float wave_max(float v) {
#pragma unroll
    for (int o = 32; o >= 1; o >>= 1) v = fmaxf(v, __shfl_xor(v, o)); return v; }

__device__ __forceinline__ void tr_tile_wave(const float* __restrict__ W, unsigned char* __restrict__ Wt, int K, int N, int tile, unsigned char* ldsw, int lane) {
    const int ntn = N >> 6, tk = tile / ntn, tn = tile - tk * ntn;
    const float* src = W + (size_t)(tk * 64 + (lane >> 4)) * N + tn * 64 + (lane & 15) * 4;
    f32x4v v[16];
#pragma unroll
    for (int i = 0; i < 16; ++i) v[i] = __builtin_nontemporal_load((const f32x4v*)(src + (size_t)(4 * i) * N));
#pragma unroll
    for (int i = 0; i < 16; ++i) { const int k = 4 * i + (lane >> 4), n = (lane & 15) * 4;
#pragma unroll
        for (int j = 0; j < 4; ++j) ldsw[(n + j) * 80 + k] = (unsigned char)fp8_1(v[i][j] * W8_SCALE); }
    asm volatile("s_waitcnt lgkmcnt(0)" ::: "memory");
#pragma unroll
    for (int i = 0; i < 4; ++i) { const int n = 16 * i + (lane >> 2), kc = (lane & 3) * 16;
        const u32x4v w = *(const u32x4v*)(ldsw + n * 80 + kc);
        *(u32x4v*)(Wt + (size_t)(tn * 64 + n) * K + tk * 64 + kc) = w; }
    asm volatile("s_waitcnt lgkmcnt(0)" ::: "memory");
}
__device__ __forceinline__ void tr_tile_wave_bf16(const float* __restrict__ W, bf16* __restrict__ Wt, int K, int N, int tile, bf16* ldsw, int lane) {
    const int ntn = N >> 6, tk = tile / ntn, tn = tile - tk * ntn;
    const float* src = W + (size_t)(tk * 64 + (lane >> 4)) * N + tn * 64 + (lane & 15) * 4;
    f32x4v v[16];
#pragma unroll
    for (int i = 0; i < 16; ++i) v[i] = *(const f32x4v*)(src + (size_t)(4 * i) * N);
#pragma unroll
    for (int i = 0; i < 16; ++i) { const int k = 4 * i + (lane >> 4), n = (lane & 15) * 4;
#pragma unroll
        for (int j = 0; j < 4; ++j) ldsw[(n + j) * 72 + k] = f2bf_rne(v[i][j]); }
    asm volatile("s_waitcnt lgkmcnt(0)" ::: "memory");
#pragma unroll
    for (int i = 0; i < 8; ++i) { const int n = 8 * i + (lane >> 3), kc = (lane & 7) * 8;
        const u32x4v w = *(const u32x4v*)(ldsw + n * 72 + kc);
        *(u32x4v*)(Wt + (size_t)(tn * 64 + n) * K + tk * 64 + kc) = w; }
    asm volatile("s_waitcnt lgkmcnt(0)" ::: "memory");
}
template <bool SHI>
__device__ __forceinline__ void cvt_rows_u4(const float* __restrict__ src, unsigned char* __restrict__ dst, float* __restrict__ steps, int nrows, int part, int nparts) {
    const int tid = mk_ltid(), wave = __builtin_amdgcn_readfirstlane(tid >> 6), lane = tid & 63;
    int row = part * 8 + wave; const int rstep = nparts * 8;
    f32x4v x[8], nx[8];
#define U4_FETCH(X, rr) do { _Pragma("unroll") for (int c_ = 0; c_ < 4; ++c_) { X[2 * c_] = __builtin_nontemporal_load((const f32x4v*)(src + (size_t)(rr) * D + c_ * 512 + lane * 8)); X[2 * c_ + 1] = __builtin_nontemporal_load((const f32x4v*)(src + (size_t)(rr) * D + c_ * 512 + lane * 8 + 4)); } } while (0)
    if (row < nrows) U4_FETCH(nx, row);
    while (row < nrows) {
#pragma unroll
        for (int j = 0; j < 8; ++j) x[j] = nx[j];
        const int nrow = row + rstep;
        if (nrow < nrows) U4_FETCH(nx, nrow);
        asm volatile("" ::: "memory");
        float ss = 0.f;
#pragma unroll
        for (int j = 0; j < 8; ++j) ss += (x[j][0] * x[j][0] + x[j][1] * x[j][1]) + (x[j][2] * x[j][2] + x[j][3] * x[j][3]);
        ss = wave_sum(ss);
        const float rms = sqrtf(ss * (1.f / D)), step = (rms > 0.f) ? 0.335f * rms : 1.f, inv = 1.f / step;
#pragma unroll
        for (int c = 0; c < 4; ++c) { unsigned w = 0u;
#pragma unroll
            for (int b = 0; b < 4; ++b) { const int lo = (int)fminf(fmaxf(rintf(x[2 * c][b] * inv) + 8.f, 0.f), 15.f); int hi = (int)fminf(fmaxf(rintf(x[2 * c + 1][b] * inv) + 8.f, 0.f), 15.f);
                if (SHI) hi = (hi - 8) & 15;
                w |= (unsigned)(lo | (hi << 4)) << (8 * b); }
            *(unsigned*)(dst + (size_t)(c * 2 + (lane >> 5)) * ((size_t)nrows * 128) + (size_t)row * 128 + (lane & 31) * 4) = w; }
        if (lane == 0) steps[row] = step;
        row = nrow;
    }
#undef U4_FETCH
}
__device__ __forceinline__ void tr_strip_i8(const float* __restrict__ W, unsigned char* __restrict__ Wt, float* __restrict__ steps, int N, int tn, unsigned char* lds_raw) {
    const int tid = mk_ltid(), wave = __builtin_amdgcn_readfirstlane(tid >> 6), lane = tid & 63;
    unsigned char* ldsw = lds_raw + wave * 5120; float* pmax = (float*)(lds_raw + 8 * 5120); float* stp = pmax + 8 * 64;
    float cm[4] = {0.f, 0.f, 0.f, 0.f};
    for (int tk = wave; tk < D / 64; tk += 8) { const float* src = W + (size_t)(tk * 64 + (lane >> 4)) * N + tn * 64 + (lane & 15) * 4;
#pragma unroll
        for (int i = 0; i < 16; ++i) { const f32x4v v = *(const f32x4v*)(src + (size_t)(4 * i) * N);
#pragma unroll
            for (int j = 0; j < 4; ++j) cm[j] = fmaxf(cm[j], fabsf(v[j])); } }
#pragma unroll
    for (int j = 0; j < 4; ++j) { cm[j] = fmaxf(cm[j], __shfl_xor(cm[j], 16)); cm[j] = fmaxf(cm[j], __shfl_xor(cm[j], 32)); }
    if (lane < 16) {
#pragma unroll
        for (int j = 0; j < 4; ++j) pmax[wave * 64 + lane * 4 + j] = cm[j]; }
    __syncthreads();
    if (tid < 64) { float mx = 0.f;
#pragma unroll
        for (int w = 0; w < 8; ++w) mx = fmaxf(mx, pmax[w * 64 + tid]);
        const float s = (mx > 0.f) ? mx * (1.f / 127.f) : 1.f; stp[tid] = s; steps[tn * 64 + tid] = s; }
    __syncthreads();
    float inv[4];
#pragma unroll
    for (int j = 0; j < 4; ++j) inv[j] = 1.f / stp[(lane & 15) * 4 + j];
    for (int tk = wave; tk < D / 64; tk += 8) { const float* src = W + (size_t)(tk * 64 + (lane >> 4)) * N + tn * 64 + (lane & 15) * 4;
        f32x4v v[16];
#pragma unroll
        for (int i = 0; i < 16; ++i) v[i] = *(const f32x4v*)(src + (size_t)(4 * i) * N);
#pragma unroll
        for (int i = 0; i < 16; ++i) { const int k = 4 * i + (lane >> 4), n = (lane & 15) * 4;
#pragma unroll
            for (int j = 0; j < 4; ++j) ldsw[(n + j) * 80 + k] = (unsigned char)((int)rintf(v[i][j] * inv[j]) & 255); }
        asm volatile("s_waitcnt lgkmcnt(0)" ::: "memory");
#pragma unroll
        for (int i = 0; i < 4; ++i) { const int n = 16 * i + (lane >> 2), kc = (lane & 3) * 16;
            const u32x4v w = *(const u32x4v*)(ldsw + n * 80 + kc);
            *(u32x4v*)(Wt + (size_t)(tn * 64 + n) * D + tk * 64 + kc) = w; }
        asm volatile("s_waitcnt lgkmcnt(0)" ::: "memory"); }
    __syncthreads();
}
__device__ __forceinline__ void cvt_stream_fp8(const float* __restrict__ src, unsigned char* __restrict__ dst, size_t n16, float scale, int part, int nparts) {
    const size_t stride = (size_t)nparts * 512;
    for (size_t i = (size_t)part * 512 + mk_ltid(); i < n16; i += 4 * stride) {
        f32x4v a[4][4]; bool ok[4];
#pragma unroll
        for (int u = 0; u < 4; ++u) { const size_t j = i + u * stride; ok[u] = j < n16;
            if (ok[u]) {
#pragma unroll
                for (int q = 0; q < 4; ++q) a[u][q] = *(const f32x4v*)(src + j * 16 + q * 4); } }
#pragma unroll
        for (int u = 0; u < 4; ++u) if (ok[u]) { const size_t j = i + u * stride; u32x4v w;
#pragma unroll
            for (int q = 0; q < 4; ++q) { const f32x4v x = a[u][q] * scale; int d = 0;
                d = __builtin_amdgcn_cvt_pk_fp8_f32(x[0], x[1], d, false); d = __builtin_amdgcn_cvt_pk_fp8_f32(x[2], x[3], d, true); w[q] = (unsigned)d; }
            *(u32x4v*)(dst + j * 16) = w; }
    }
}
__device__ __forceinline__ void cvt_stream(const float* __restrict__ src, bf16* __restrict__ dst, size_t n8) {
    for (size_t i = (size_t)blockIdx.x * 512 + mk_ltid(); i < n8; i += (size_t)gridDim.x * 512) {
        const f32x4v a = *(const f32x4v*)(src + i * 8), b = *(const f32x4v*)(src + i * 8 + 4);
        u32x4v w; w[0] = pk2(a[0], a[1]); w[1] = pk2(a[2], a[3]); w[2] = pk2(b[0], b[1]); w[3] = pk2(b[2], b[3]);
        *(u32x4v*)(dst + i * 8) = w; }
}
__device__ __forceinline__ void sincos_d(double a, double& s, double& c) {
    const double k = __builtin_rint(a * 0.63661977236758134308);
    double r = __builtin_fma(-k, 1.57079632679489655800, a); r = __builtin_fma(-k, 6.12323399573676603587e-17, r);
    const double r2 = r * r;
    double sp = -7.6471637318198164759e-13; sp = sp * r2 + 1.6059043836821614599e-10; sp = sp * r2 - 2.5052108385441718775e-08; sp = sp * r2 + 2.7557319223985890653e-06;
    sp = sp * r2 - 1.9841269841269841270e-04; sp = sp * r2 + 8.3333333333333333333e-03; sp = sp * r2 - 1.6666666666666666667e-01; const double sr = r + r * r2 * sp;
    double cp = 4.7794773323873852974e-14; cp = cp * r2 - 1.1470745597729724714e-11; cp = cp * r2 + 2.0876756987868098979e-09; cp = cp * r2 - 2.7557319223985890653e-07;
    cp = cp * r2 + 2.4801587301587301587e-05; cp = cp * r2 - 1.3888888888888888889e-03; cp = cp * r2 + 4.1666666666666666667e-02; cp = cp * r2 - 0.5; const double cr = 1.0 + r2 * cp;
    const int q = ((int)k) & 3;
    s = (q == 0) ? sr : (q == 1) ? cr : (q == 2) ? -sr : -cr;
    c = (q == 0) ? cr : (q == 1) ? -sr : (q == 2) ? -cr : sr;
}

__device__ __forceinline__ void phase_prologue(const Params& p, unsigned char* lds_raw) {
    float* lds = (float*)lds_raw; unsigned char* ws = p.ws; const int tid = mk_ltid();
    { const int nt_inab = 32 * (NQ_AB / 64), nt_sq = 32 * 32, nt_inc = 32 * (NQ_C / 64);
      const int o1 = 2 * nt_inab, o2 = o1 + 2 * nt_sq, o3 = o2 + 2 * nt_inc, o4 = o3 + 2 * nt_sq, o5 = o4;
      const int wv_ = __builtin_amdgcn_readfirstlane(tid >> 6); unsigned char* ldsw = lds_raw + wv_ * (64 * 72 * 2);
      for (int t = blockIdx.x * 8 + wv_; t < o5; t += gridDim.x * 8) {
          const float* W; unsigned char* Wt; int N, tile;
          if (t < o1)      { const int i = t / nt_inab; tile = t - i * nt_inab; N = NQ_AB; W = p.ab_w_in + (size_t)i * D * NQ_AB; Wt = (ws + WS_WIN_AB) + (size_t)i * NQ_AB * D; }
          else if (t < o2) { const int u = t - o1, i = u / nt_sq; tile = u - i * nt_sq; N = D; W = p.ab_w_out + (size_t)i * D * D; Wt = (ws + WS_WOUT_AB) + (size_t)i * D * D; }
          else if (t < o3) { const int u = t - o2, i = u / nt_inc; tile = u - i * nt_inc; N = NQ_C; W = p.c_w_in + (size_t)i * D * NQ_C; Wt = (ws + WS_WIN_C) + (size_t)i * NQ_C * D; }
          else if (t < o4) { const int u = t - o3, i = u / nt_sq; tile = u - i * nt_sq; N = D; W = p.c_w_out + (size_t)i * D * D; Wt = (ws + WS_WOUT_C) + (size_t)i * D * D; }
          else             { const int u = t - o4, i = u / nt_sq; tile = u - i * nt_sq; N = D; W = p.peer_wq + (size_t)i * D * D; Wt = nullptr;
                             tr_tile_wave_bf16(W, (bf16*)(ws + WS_WPQ) + (size_t)i * D * D, D, N, tile, (bf16*)ldsw, tid & 63); }
          if (Wt != nullptr) tr_tile_wave(W, Wt, D, N, tile, ldsw, tid & 63);
      }
      __syncthreads();
      for (int t = blockIdx.x; t < DEPTH * (D / 64); t += gridDim.x) { const int i = t / (D / 64), tn = t - i * (D / 64);
          tr_strip_i8(p.peer_wq + (size_t)i * D * D, ws + WS_WPQ + (size_t)i * D * D, (float*)(ws + WS_PQSC) + (size_t)i * D, D, tn, lds_raw); } }
    cvt_rows_u4<false>(p.peer_u, ws + WS_U, (float*)(ws + WS_USC), NE, blockIdx.x, gridDim.x);
    cvt_rows_u4<true>(p.peer_v, ws + WS_V, (float*)(ws + WS_VSC), NE, blockIdx.x, gridDim.x);
    cvt_stream(p.peer_sk, (bf16*)(ws + WS_SK), (size_t)4 * 16 * 128 * 128 / 8);
    for (int i = blockIdx.x * 512 + tid; i < 128 * 32; i += gridDim.x * 512) {
        const int pp = i >> 5, j = i & 31;
        double fd = 1.0; for (int q = 0; q < j; ++q) fd *= 0.74989420933245582730;
        const float invf = (float)fd;
        const float ang = (float)pp * invf; double s, c; sincos_d((double)ang, s, c);
        ((float*)(ws + WS_ROPE))[i] = (float)c; ((float*)(ws + WS_ROPE))[128 * 32 + i] = (float)s; }
    { float* sv = lds;
      float* part = lds + 3 * D;
      for (int i = tid; i < 3 * D; i += 512) { const int r = i / D, k = i - r * D; const float v = (r < 2) ? p.c[r * D + k] : p.c_ctx[k]; sv[i] = v / (1.f + __expf(-v)); }
      __syncthreads();
      const int kq = tid >> 4, nq = tid & 15;
      for (int t = blockIdx.x; t < DEPTH * (NMOD / 64); t += gridDim.x) {
          const int l = t / (NMOD / 64), n0 = (t - l * (NMOD / 64)) * 64;
          const float* Wp = p.mod_w + (size_t)l * D * NMOD + (size_t)(kq * 64) * NMOD + n0 + nq * 4;
          f32x4v a0 = {0.f, 0.f, 0.f, 0.f}, a1 = a0, a2 = a0;
#pragma unroll 8
          for (int k = 0; k < 64; ++k) { const f32x4v w = __builtin_nontemporal_load((const f32x4v*)(Wp + (size_t)k * NMOD)); const int kk = kq * 64 + k;
              a0 += w * sv[kk]; a1 += w * sv[D + kk]; a2 += w * sv[2 * D + kk]; }
          float* pp = part + (kq * 3) * 64 + nq * 4;
#pragma unroll
          for (int e = 0; e < 4; ++e) { pp[e] = a0[e]; pp[64 + e] = a1[e]; pp[128 + e] = a2[e]; }
          __syncthreads();
          if (tid < 192) { const int r = tid >> 6, n = tid & 63; float s = 0.f;
#pragma unroll 8
              for (int q = 0; q < 32; ++q) s += part[(q * 3 + r) * 64 + n];
              ((float*)(ws + WS_MOD))[((size_t)l * 3 + r) * NMOD + n0 + n] = s + p.mod_b[(size_t)l * NMOD + n0 + n]; }
          __syncthreads();
      } }
}

__device__ __forceinline__ void phase_mod0(const Params& p) {
    const int tid_ = mk_ltid(); const int wave = __builtin_amdgcn_readfirstlane(tid_ >> 6), lane = tid_ & 63; const float* MOD = (const float*)(p.ws + WS_MOD); unsigned char* H8 = p.ws + WS_H8;
    const int rstride = gridDim.x * 8;
    for (int row = blockIdx.x * 8 + wave; row < T; row += 2 * rstride) {
        const int row2 = row + rstride; const bool has2 = row2 < T; const int rb = has2 ? row2 : row;
        const float* xa = (row < TL) ? p.x + (size_t)row * D : p.ctx + (size_t)(row - TL) * D;
        const float* xb = (rb < TL) ? p.x + (size_t)rb * D : p.ctx + (size_t)(rb - TL) * D;
        f32x4v va[8], vb[8];
#pragma unroll
        for (int i = 0; i < 8; ++i) { const int col = (i >> 1) * 512 + lane * 8 + (i & 1) * 4; va[i] = __builtin_nontemporal_load((const f32x4v*)(xa + col)); vb[i] = __builtin_nontemporal_load((const f32x4v*)(xb + col)); }
#pragma unroll
        for (int u = 0; u < 2; ++u) { const int rw = u ? rb : row; if (u && !has2) break;
            const int b = (rw < TL) ? (rw / L) : 2; const float* m = MOD + (size_t)b * NMOD;
#pragma unroll
            for (int j = 0; j < 4; ++j) { const int col = j * 512 + lane * 8; uint2 w;
#pragma unroll
                for (int hf = 0; hf < 2; ++hf) { const f32x4v xv = u ? vb[2 * j + hf] : va[2 * j + hf], sh = *(const f32x4v*)(m + col + hf * 4), sc = *(const f32x4v*)(m + D + col + hf * 4);
                    const f32x4v h = xv * (1.f + sc) + sh; const unsigned q = fp8_4(h[0], h[1], h[2], h[3]); if (hf == 0) w.x = q; else w.y = q; }
                *(uint2*)(H8 + (size_t)rw * D + col) = w; } }
    }
}
template <bool XIN_F32, bool XOUT_F32>
__device__ __forceinline__ void phase_ln(const void* xl, const void* xc, const bf16* __restrict__ y, const float* __restrict__ modg, int gidx,
                         const float* __restrict__ lng, const float* __restrict__ lnb, void* xol, void* xoc,
                         bf16* __restrict__ H, unsigned char* __restrict__ H8, const float* __restrict__ modn, int shi, int sci, int nrows, unsigned char* lds_raw,
                         unsigned char* __restrict__ HQ = nullptr, float* __restrict__ HSC = nullptr) {
    const int tid_ = mk_ltid(); const int wave = __builtin_amdgcn_readfirstlane(tid_ >> 6), lane = tid_ & 63;
    float* vec = (float*)lds_raw;
    constexpr int NXW = XIN_F32 ? 8 : 4;
    constexpr int RB = XIN_F32 ? 1 : 2;
    u32x4v xw[RB][NXW], yw[RB][4];
    int row = blockIdx.x * 8 + wave; const int rstride = gridDim.x * 8;
#define LN_ROFF(rr) (((rr) < TL) ? (size_t)(rr) * D : (size_t)((rr) - TL) * D)
#define LN_COL(i) (((i) >> 1) * 512 + lane * 8 + ((i) & 1) * 4)
#define LN_FETCH(u_, rr) do { const bool lat_ = (rr) < TL; const size_t ro_ = LN_ROFF(rr); \
        if constexpr (XIN_F32) { _Pragma("unroll") for (int i_ = 0; i_ < 8; ++i_) xw[u_][i_] = __builtin_nontemporal_load((const u32x4v*)((const float*)(lat_ ? xl : xc) + ro_ + LN_COL(i_))); } \
        else { _Pragma("unroll") for (int i_ = 0; i_ < 4; ++i_) xw[u_][i_] = *(const u32x4v*)((const bf16*)(lat_ ? xl : xc) + ro_ + i_ * 512 + lane * 8); } \
        _Pragma("unroll") for (int i_ = 0; i_ < 4; ++i_) yw[u_][i_] = *(const u32x4v*)(y + (size_t)(rr) * D + i_ * 512 + lane * 8); } while (0)
#pragma unroll
    for (int u = 0; u < RB; ++u) if (row + u * rstride < nrows) LN_FETCH(u, row + u * rstride);
    for (int i = tid_; i < 2048 / 4; i += 512) { const int di = ((i >> 7) * 2 + (i & 1)) * 64 + ((i >> 1) & 63);
        ((f32x4v*)vec)[di] = ((const f32x4v*)lng)[i]; ((f32x4v*)(vec + 2048))[di] = ((const f32x4v*)lnb)[i];
#pragma unroll
        for (int b = 0; b < 3; ++b) { ((f32x4v*)(vec + 4096 + b * 6144))[di] = ((const f32x4v*)(modg + (size_t)b * NMOD + (size_t)gidx * D))[i];
            ((f32x4v*)(vec + 4096 + b * 6144 + 2048))[di] = ((const f32x4v*)(modn + (size_t)b * NMOD + (size_t)shi * D))[i];
            ((f32x4v*)(vec + 4096 + b * 6144 + 4096))[di] = ((const f32x4v*)(modn + (size_t)b * NMOD + (size_t)sci * D))[i]; } }
    __syncthreads();
    while (row < nrows) {
        f32x4v z[RB][8]; float s[RB];
#pragma unroll
        for (int u = 0; u < RB; ++u) { const int rw = row + u * rstride; const int b = (rw < TL) ? (rw / L) : 2; s[u] = 0.f;
            const float* gv = vec + 4096 + b * 6144;
            if (rw < nrows) {
#pragma unroll
                for (int i = 0; i < 8; ++i) { const int col = i * 256 + lane * 4; f32x4v xv;
                    if constexpr (XIN_F32) xv = (f32x4v){__uint_as_float(xw[u][i][0]), __uint_as_float(xw[u][i][1]), __uint_as_float(xw[u][i][2]), __uint_as_float(xw[u][i][3])};
                    else { const unsigned x0 = xw[u][i >> 1][(i & 1) * 2], x1 = xw[u][i >> 1][(i & 1) * 2 + 1]; xv = (f32x4v){bflo(x0), bfhi(x0), bflo(x1), bfhi(x1)}; }
                    const f32x4v g = *(const f32x4v*)(gv + col); const unsigned y0 = yw[u][i >> 1][(i & 1) * 2], y1 = yw[u][i >> 1][(i & 1) * 2 + 1];
                    const f32x4v yv = {bflo(y0), bfhi(y0), bflo(y1), bfhi(y1)};
                    z[u][i] = xv * ALPHA + g * yv; s[u] += (z[u][i][0] + z[u][i][1]) + (z[u][i][2] + z[u][i][3]);
                    if ((i & 3) == 3) asm volatile("" ::: "memory"); } }
            asm volatile("" ::: "memory"); }
        const int nrow = row + RB * rstride;
#pragma unroll
        for (int u = 0; u < RB; ++u) if (nrow + u * rstride < nrows) LN_FETCH(u, nrow + u * rstride);
        asm volatile("" ::: "memory");
#pragma unroll
        for (int u = 0; u < RB; ++u) { const int rw = row + u * rstride;
            if (rw < nrows) {
                const bool lat = rw < TL; const int b = lat ? (rw / L) : 2; const size_t roff = LN_ROFF(rw);
                const float mean = wave_sum(s[u]) * (1.f / D); float q = 0.f;
#pragma unroll
                for (int i = 0; i < 8; ++i) { const f32x4v d = z[u][i] - mean; q += (d[0] * d[0] + d[1] * d[1]) + (d[2] * d[2] + d[3] * d[3]); }
                const float rstd = rsqrtf(wave_sum(q) * (1.f / D) + 1e-5f);
                f32x4v hk[8]; float amax = 0.f;
#pragma unroll
                for (int j = 0; j < 4; ++j) { const int gcol = j * 512 + lane * 8; f32x4v o2[2], h2[2];
#pragma unroll
                    for (int hf = 0; hf < 2; ++hf) { const int i = 2 * j + hf, col = i * 256 + lane * 4;
                        const f32x4v g = *(const f32x4v*)(vec + col), bb = *(const f32x4v*)(vec + 2048 + col);
                        o2[hf] = (z[u][i] - mean) * rstd * g + bb;
                        if (H8 || H || HQ) { const float* mm = vec + 4096 + b * 6144; const f32x4v sh = *(const f32x4v*)(mm + 2048 + col), sc = *(const f32x4v*)(mm + 4096 + col);
                            h2[hf] = o2[hf] * (1.f + sc) + sh;
                            if (HQ) { hk[i] = h2[hf]; amax = fmaxf(amax, fmaxf(fmaxf(fabsf(h2[hf][0]), fabsf(h2[hf][1])), fmaxf(fabsf(h2[hf][2]), fabsf(h2[hf][3])))); } } }
                    if constexpr (XOUT_F32) { __builtin_nontemporal_store(o2[0], (f32x4v*)((float*)(lat ? xol : xoc) + roff + gcol)); __builtin_nontemporal_store(o2[1], (f32x4v*)((float*)(lat ? xol : xoc) + roff + gcol + 4)); }
                    else { u32x4v w; w[0] = pk2(o2[0][0], o2[0][1]); w[1] = pk2(o2[0][2], o2[0][3]); w[2] = pk2(o2[1][0], o2[1][1]); w[3] = pk2(o2[1][2], o2[1][3]); *(u32x4v*)((bf16*)(lat ? xol : xoc) + roff + gcol) = w; }
                    if (H) { u32x4v w; w[0] = pk2(h2[0][0], h2[0][1]); w[1] = pk2(h2[0][2], h2[0][3]); w[2] = pk2(h2[1][0], h2[1][1]); w[3] = pk2(h2[1][2], h2[1][3]); *(u32x4v*)(H + (size_t)rw * D + gcol) = w; }
                    if (H8) { uint2 w; w.x = fp8_4(h2[0][0], h2[0][1], h2[0][2], h2[0][3]); w.y = fp8_4(h2[1][0], h2[1][1], h2[1][2], h2[1][3]); *(uint2*)(H8 + (size_t)rw * D + gcol) = w; }
                    asm volatile("" ::: "memory"); }
                if (HQ) {
                    amax = wave_max(amax); const float stp = (amax > 0.f) ? amax * (1.f / 127.f) : 1.f, inv = 1.f / stp;
#pragma unroll
                    for (int j = 0; j < 4; ++j) { uint2 w;
#pragma unroll
                        for (int hf = 0; hf < 2; ++hf) { const int i = 2 * j + hf;
                            const int q0 = (int)rintf(hk[i][0] * inv), q1 = (int)rintf(hk[i][1] * inv), q2 = (int)rintf(hk[i][2] * inv), q3 = (int)rintf(hk[i][3] * inv);
                            const unsigned v = (unsigned)(q0 & 255) | ((unsigned)(q1 & 255) << 8) | ((unsigned)(q2 & 255) << 16) | ((unsigned)(q3 & 255) << 24);
                            if (hf == 0) w.x = v; else w.y = v; }
                        *(uint2*)(HQ + (size_t)rw * D + j * 512 + lane * 8) = w; }
                    if (lane == 0) HSC[rw] = stp; } }
            asm volatile("" ::: "memory"); }
        row = nrow;
    }
#undef LN_ROFF
#undef LN_FETCH
#undef LN_COL
}

__device__ __forceinline__ void phase_prep(bf16* __restrict__ QKV, int ld, int cbase, int nheads, int nqh, bool isC, const float* __restrict__ qg, const float* __restrict__ kg, const float* __restrict__ rope, int ntok, unsigned char* __restrict__ K8img) {
    const long total = (long)ntok * nheads * 4;
    for (long task = (long)blockIdx.x * 512 + mk_ltid(); task < total; task += (long)gridDim.x * 512) {
        const int j = (int)(task & 3); const long th = task >> 2; const int hh = (int)(th % nheads); const int t = (int)(th / nheads);
        bf16* base = QKV + (size_t)t * ld + cbase + hh * 128 + j * 8;
        float x[4][8];
#pragma unroll
        for (int s = 0; s < 4; ++s) { const u32x4v w = *(const u32x4v*)(base + s * 32);
#pragma unroll
            for (int e = 0; e < 4; ++e) { x[s][2 * e] = bflo(w[e]); x[s][2 * e + 1] = bfhi(w[e]); } }
        if (isC) {
            float ss = 0.f;
#pragma unroll
            for (int s = 0; s < 4; ++s)
#pragma unroll
                for (int e = 0; e < 8; ++e) ss += x[s][e] * x[s][e];
            ss += __shfl_xor(ss, 1); ss += __shfl_xor(ss, 2);
            const float r = rsqrtf(ss * (1.f / 128.f) + 1e-6f); const float* gn = (hh < nqh) ? qg : kg;
#pragma unroll
            for (int s = 0; s < 4; ++s)
#pragma unroll
                for (int e = 0; e < 8; ++e) x[s][e] = x[s][e] * r * gn[s * 32 + j * 8 + e];
        }
        if (t < TL) {
            const int pos = t & (L - 1), prow = pos >> 6, pcol = pos & 63;
            const float* cr = rope + prow * 32 + j * 8; const float* sr = rope + 128 * 32 + prow * 32 + j * 8;
            const float* cc = rope + pcol * 32 + j * 8; const float* sc = rope + 128 * 32 + pcol * 32 + j * 8;
#pragma unroll
            for (int e = 0; e < 8; ++e) {
                const float a = x[0][e], b = x[1][e], c = x[2][e], d = x[3][e];
                x[0][e] = a * cr[e] - b * sr[e]; x[1][e] = b * cr[e] + a * sr[e];
                x[2][e] = c * cc[e] - d * sc[e]; x[3][e] = d * cc[e] + c * sc[e]; }
        }
#pragma unroll
        for (int s = 0; s < 4; ++s) { u32x4v w;
#pragma unroll
            for (int e = 0; e < 4; ++e) w[e] = pk2(x[s][2 * e], x[s][2 * e + 1]);
            *(u32x4v*)(base + s * 32) = w; }
        if (K8img) {
            const int b = (t < TL) ? (t >> 13) : ((t - TL) >> 8), kk = (t < TL) ? CL + (t & (L - 1)) : ((t - TL) & (CL - 1)), r = kk & 63;
            unsigned char* tb = K8img + ((size_t)((b * 4 + hh) * NTC + (kk >> 6))) * 8192 + r * 128;
#pragma unroll
            for (int s = 0; s < 4; ++s) { const int blk = s * 4 + j, pos = (blk >> 3) * 64 + (blk & 1) * 32 + ((blk & 7) >> 1) * 8;
                uint2 w; w.x = fp8_4(x[s][0], x[s][1], x[s][2], x[s][3]); w.y = fp8_4(x[s][4], x[s][5], x[s][6], x[s][7]);
                *(uint2*)(tb + (((pos >> 4) ^ ((r >> 1) & 7)) << 4) + (pos & 15)) = w; } }
    }
}
__device__ __forceinline__ void phase_vt8(const bf16* __restrict__ QKV, unsigned char* __restrict__ Vimg) {
    const int total = NB * 4 * ((CL + L) / 4) * 16;
    for (int task = blockIdx.x * 512 + mk_ltid(); task < total; task += gridDim.x * 512) {
        const int cb = task & 15, rest = task >> 4, q4 = rest % ((CL + L) / 4), bh = rest / ((CL + L) / 4), b = bh >> 2, kvh = bh & 3, kk = q4 * 4;
        const int trow = (kk < CL) ? TL + b * CL + kk : b * L + (kk - CL);
        const bf16* vp = QKV + (size_t)trow * NQ_C + 2560 + kvh * 128 + cb * 8;
        float v[4][8];
#pragma unroll
        for (int q = 0; q < 4; ++q) { const u32x4v w = *(const u32x4v*)(vp + (size_t)q * NQ_C);
#pragma unroll
            for (int e = 0; e < 4; ++e) { v[q][2 * e] = bflo(w[e]); v[q][2 * e + 1] = bfhi(w[e]); } }
        const int r0 = kk & 63, posk = ((r0 >> 2) & 1) * 32 + (((r0 & 31) >> 3) + 4 * (r0 >> 5)) * 4;
        unsigned char* tb = Vimg + ((size_t)(bh * NTC + (kk >> 6))) * 8192;
#pragma unroll
        for (int i = 0; i < 8; ++i) { const int c = cb * 8 + i;
            *(unsigned*)(tb + c * 64 + (((posk >> 4) ^ ((c >> 2) & 3)) << 4) + (posk & 15)) = fp8_4(v[0][i], v[1][i], v[2][i], v[3][i]); }
    }
}

struct NaiveQ { const bf16* q; bf16* o; float sink; bool has_sink; };
__device__ __forceinline__ float dot128(const u32x4v (&qv)[16], const bf16* __restrict__ kp) {
    float acc = 0.f;
#pragma unroll
    for (int i = 0; i < 16; ++i) { const u32x4v kv = *(const u32x4v*)(kp + i * 8);
#pragma unroll
        for (int e = 0; e < 4; ++e) { acc = fmaf(bflo(qv[i][e]), bflo(kv[e]), acc); acc = fmaf(bfhi(qv[i][e]), bfhi(kv[e]), acc); } }
    return acc;
}
struct SoftState { float m, l, o0, o1; };
__device__ __forceinline__ void naive_step(SoftState& st, const u32x4v (&qv)[16], const bf16* __restrict__ base, int off, bool valid, float bias, int voff, int lane) {
    float s = valid ? dot128(qv, base + off) * SCALE + bias : NEG;
    const float bm = wave_max(s), mn = fmaxf(st.m, bm);
    const float pr = valid ? __expf(s - mn) : 0.f, alpha = __expf(st.m - mn);
    st.l = st.l * alpha + wave_sum(pr); st.o0 *= alpha; st.o1 *= alpha; st.m = mn;
#pragma unroll 4
    for (int kk = 0; kk < 64; ++kk) {
        const float pk = __shfl(pr, kk); const int ok = __shfl(off, kk);
        const unsigned w = *(const unsigned*)(base + ok + voff + 2 * lane);
        st.o0 = fmaf(pk, bflo(w), st.o0); st.o1 = fmaf(pk, bfhi(w), st.o1); }
}
__device__ __forceinline__ void naive_finish(const SoftState& st, bool has_sink, float sink, bf16* op, int lane) {
    float l = st.l; if (has_sink) l += __expf(sink - st.m);
    const float inv = 1.f / l; *(unsigned*)(op + 2 * lane) = pk2(st.o0 * inv, st.o1 * inv);
}
__device__ __forceinline__ void load_q(u32x4v (&qv)[16], const bf16* qp) {
#pragma unroll
    for (int i = 0; i < 16; ++i) qv[i] = *(const u32x4v*)(qp + i * 8);
}

__device__ __forceinline__ void phase_attn_ab_naive(const bf16* __restrict__ QKV, bf16* __restrict__ ATT, const float* __restrict__ sinkv, const float* __restrict__ rpb, bool with_ctx) {
    constexpr int LD = NQ_AB; const int tid_ = mk_ltid(); const int wave = __builtin_amdgcn_readfirstlane(tid_ >> 6), lane = tid_ & 63;
    const long ntask = (long)(with_ctx ? T : TL) * 16;
    for (long task = (long)blockIdx.x * 8 + wave; task < ntask; task += (long)gridDim.x * 8) {
        const int t = (int)(task >> 4), hd = (int)(task & 15); const bool isA = hd < 8; const int h = hd & 7;
        const bool lat = t < TL; const int b = lat ? (t >> 13) : ((t - TL) >> 8);
        const int qcol = isA ? h * 128 : 1536 + h * 128, kcol = isA ? 1024 + (h >> 2) * 128 : 2560 + h * 128, voff = isA ? 256 : 1024;
        u32x4v qv[16]; load_q(qv, QKV + (size_t)t * LD + qcol);
        SoftState st{NEG, 0.f, 0.f, 0.f};
        const bf16* kc0 = QKV + (size_t)(TL + b * CL) * LD + kcol;
        if (lat) {
            const int pos = t & (L - 1); const bf16* kl0 = QKV + (size_t)(b * L) * LD + kcol;
            if (isA) {
                for (int s = 0; s < 5; ++s) { const int kp = pos - 128 + s * 64 + lane; const bool valid = kp >= 0 && kp < L && kp <= pos + 128;
                    naive_step(st, qv, kl0, (valid ? kp : 0) * LD, valid, 0.f, voff, lane); }
            } else {
                const int r = pos >> 6, c = pos & 63;
                const int rs = min(max(r - 4, 0), 120), wsx = min(max(c - 8, 0), 48);
                for (int s = 0; s < 2; ++s) { const int e = s * 64 + lane, kr = rs + (e >> 4), kcx = wsx + (e & 15);
                    const int dr = kr - r + 7, dc = min(max(kcx - c + 15, 0), 30);
                    const float bias = rpb[(h * 15 + dr) * 31 + dc];
                    naive_step(st, qv, kl0, (kr * 64 + kcx) * LD, true, bias, voff, lane); }
            }
        }
        for (int s = 0; s < 4; ++s) naive_step(st, qv, kc0, (s * 64 + lane) * LD, true, 0.f, voff, lane);
        naive_finish(st, isA, isA ? sinkv[h] : 0.f, ATT + (size_t)t * D + (isA ? h * 128 : 1024 + h * 128), lane);
    }
}
__device__ __forceinline__ void phase_attn_c_ctx_naive(const bf16* __restrict__ QKV, bf16* __restrict__ ATT) {
    constexpr int LD = NQ_C; const int tid_ = mk_ltid(); const int wave = __builtin_amdgcn_readfirstlane(tid_ >> 6), lane = tid_ & 63;
    for (int task = blockIdx.x * 8 + wave; task < TC * 16; task += gridDim.x * 8) {
        const int t = TL + (task >> 4), h = task & 15, b = (t - TL) >> 8;
        u32x4v qv[16]; load_q(qv, QKV + (size_t)t * LD + h * 128);
        SoftState st{NEG, 0.f, 0.f, 0.f};
        const bf16* kc0 = QKV + (size_t)(TL + b * CL) * LD + 2048 + (h >> 2) * 128;
        for (int s = 0; s < 4; ++s) naive_step(st, qv, kc0, (s * 64 + lane) * LD, true, 0.f, 512, lane);
        naive_finish(st, false, 0.f, ATT + (size_t)t * D + h * 128, lane);
    }
}
__device__ __forceinline__ void phase_attn_c_dense(const bf16* __restrict__ QKV, bf16* __restrict__ ATT, char* lds, bool with_ctx, const float* qg, const float* rope, const unsigned char* K8img, const unsigned char* Vt8img) {
    const att::MaskArgs ma{0, 0, 0, 0, nullptr, 0.f, false};
    for (int u = blockIdx.x; u < NB * 16 * (L / 256); u += gridDim.x) {
        const int g = u & 7, rest = u >> 3, b = g >> 2, kvh = g & 3, hq = kvh * 4 + (rest >> 5), qb = rest & 31;
        const bf16* Qb = QKV + (size_t)(b * L + qb * 256) * NQ_C + hq * 128;
        const bf16* Kc = QKV + (size_t)(TL + b * CL) * NQ_C + 2048 + kvh * 128;
        const bf16* Kl = QKV + (size_t)(b * L) * NQ_C + 2048 + kvh * 128;
#if MK_ATT_FP8
#if MK_ATT_I
        att::attn_body_fp8i<NQ_C, D, NTC>(Qb, K8img + (size_t)((b * 4 + kvh) * NTC) * 8192, Vt8img + (size_t)((b * 4 + kvh) * NTC) * 8192, (unsigned char*)ATT + (size_t)(b * L + qb * 256) * D + hq * 128, lds, att::QPrep{qg, rope, qb * 256, true, true});
#else
        att::attn_body_fp8<NQ_C, D>(Qb, K8img + (size_t)((b * 4 + kvh) * NTC) * 8192, Vt8img + (size_t)((b * 4 + kvh) * NTC) * 8192, (unsigned char*)ATT + (size_t)(b * L + qb * 256) * D + hq * 128, NTC, lds, att::QPrep{qg, rope, qb * 256, true, true});
#endif
#else
        att::attn_body<0, MK_SD_C, NQ_C, NQ_C, D>(Qb, Kc, Kl, 512, CL / 64, (unsigned char*)ATT + (size_t)(b * L + qb * 256) * D + hq * 128, (CL + L) / 64, lds, ma, att::QPrep{qg, rope, qb * 256, true, true});
#endif
        __syncthreads();
    }
    if (with_ctx) for (int u = blockIdx.x; u < NB * 16; u += gridDim.x) {
        const int b = u >> 4, hq = u & 15, kvh = hq >> 2;
        const bf16* Qb = QKV + (size_t)(TL + b * CL) * NQ_C + hq * 128;
        const bf16* Kc = QKV + (size_t)(TL + b * CL) * NQ_C + 2048 + kvh * 128;
        att::attn_body<0, MK_SD_C, NQ_C, NQ_C, D>(Qb, Kc, Kc, 512, CL / 64, (unsigned char*)ATT + (size_t)(TL + b * CL) * D + hq * 128, CL / 64, lds, ma, att::QPrep{qg, rope, 0, true, false});
        __syncthreads();
    }
}
__device__ __forceinline__ void phase_attn_ab(const bf16* __restrict__ QKV, bf16* __restrict__ ATT, const float* __restrict__ sinkv, const float* __restrict__ rpb, char* lds, bool with_ctx, const float* rope) {
    constexpr int LD = NQ_AB; float* bt = (float*)(lds + 69632);
    const int tid = mk_ltid();
    const int nunits = 1024 + (with_ctx ? 32 : 0);
    for (int u = blockIdx.x; u < nunits; u += gridDim.x) {
#ifndef MK_ABM
#define MK_ABM 7
#endif
        if (u < 512) {  if constexpr (MK_ABM & 1) {
            const int b = u >> 8, h = (u >> 5) & 7, qb = u & 31, r0 = qb * 4;
            int first = min(max(r0 - 4, 0), 120), lastr = min(max(r0 - 1, 0), 120) + 7;
            if (tid < 480) bt[tid] = rpb[(h * 15 + (tid >> 5)) * 31 + min(tid & 31, 30)] * (1.f / SCALE);
            const bf16* Qb = QKV + (size_t)(b * L + qb * 256) * LD + 1536 + h * 128;
            const bf16* Kc = QKV + (size_t)(TL + b * CL) * LD + 2560 + h * 128;
            const bf16* Kl = QKV + (size_t)(b * L + first * 64) * LD + 2560 + h * 128;
            const att::MaskArgs ma{0, 0, first, r0, bt, 0.f, false};
            att::attn_body_simple<2, LD, LD, D>(Qb, Kc, Kl, 1024, CL / 64, (unsigned char*)ATT + (size_t)(b * L + qb * 256) * D + 1024 + h * 128, CL / 64 + (lastr - first + 1), lds, ma, att::QPrep{nullptr, rope, 0, false, false});
        } } else if (u < 1024) {  if constexpr (MK_ABM & 2) {
            const int v = u - 512, b = v >> 8, hq = (v >> 5) & 7, qb = v & 31, kvh = hq >> 2, q0 = qb * 256;
            const int k0 = max(q0 - 128, 0), k1 = min(q0 + 384, L);
            const bf16* Qb = QKV + (size_t)(b * L + q0) * LD + hq * 128;
            const bf16* Kc = QKV + (size_t)(TL + b * CL) * LD + 1024 + kvh * 128;
            const bf16* Kl = QKV + (size_t)(b * L + k0) * LD + 1024 + kvh * 128;
            const att::MaskArgs ma{k0, q0, 0, 0, nullptr, sinkv[hq], true};
            att::attn_body_simple<1, LD, LD, D>(Qb, Kc, Kl, 256, CL / 64, (unsigned char*)ATT + (size_t)(b * L + q0) * D + hq * 128, CL / 64 + (k1 - k0) / 64, lds, ma, att::QPrep{nullptr, rope, q0, false, true});
        } } else {  if constexpr (MK_ABM & 4) {
            const int v = u - 1024, b = v >> 4, hd = v & 15, h = hd & 7; const bool isA = hd < 8;
            const int qcol = isA ? h * 128 : 1536 + h * 128, kcol = isA ? 1024 + (h >> 2) * 128 : 2560 + h * 128;
            const bf16* Qb = QKV + (size_t)(TL + b * CL) * LD + qcol;
            const bf16* Kc = QKV + (size_t)(TL + b * CL) * LD + kcol;
            const att::MaskArgs ma{0, 0, 0, 0, nullptr, isA ? sinkv[h] : 0.f, isA};
            att::attn_body_simple<0, LD, LD, D>(Qb, Kc, Kc, isA ? 256 : 1024, CL / 64, (unsigned char*)ATT + (size_t)(TL + b * CL) * D + (isA ? h * 128 : 1024 + h * 128), CL / 64, lds, ma, att::QPrep{nullptr, rope, 0, false, false});
        } }
        __syncthreads();
    }
}

#define MK_INSERT16(tv, ti, v_, id_) do { float v__ = (v_); int id__ = (id_); _Pragma("unroll") for (int k_ = 0; k_ < 16; ++k_) { const bool gt_ = v__ > tv[k_]; \
    const float ov_ = tv[k_]; const int oi_ = ti[k_]; tv[k_] = gt_ ? v__ : ov_; ti[k_] = gt_ ? id__ : oi_; v__ = gt_ ? ov_ : v__; id__ = gt_ ? oi_ : id__; } } while (0)
__device__ __forceinline__ void phase_sel1_naive(const bf16* __restrict__ PQ, const bf16* __restrict__ SK, float* __restrict__ TOPV, int* __restrict__ TOPI, int ntok) {
    const int tid_ = mk_ltid(); const int wave = __builtin_amdgcn_readfirstlane(tid_ >> 6), lane = tid_ & 63; const int ntile = ntok >> 6;
    for (int wt = blockIdx.x * 8 + wave; wt < ntile * 16; wt += gridDim.x * 8) {
        const int hp = __builtin_amdgcn_readfirstlane(wt & 15), t = (wt >> 4) * 64 + lane;
        u32x4v qv[16]; load_q(qv, PQ + (size_t)t * D + hp * 128);
        float tv[16]; int ti[16];
#pragma unroll
        for (int k = 0; k < 16; ++k) { tv[k] = -3.0e38f; ti[k] = 0; }
        const bf16* skb = SK + (size_t)hp * 128 * 128;
        for (int n = 0; n < 128; ++n) { const float s = dot128(qv, skb + n * 128); MK_INSERT16(tv, ti, s, n); }
        float* ov = TOPV + ((size_t)t * 16 + hp) * 16; int* oi = TOPI + ((size_t)t * 16 + hp) * 16;
#pragma unroll
        for (int k = 0; k < 16; ++k) { ov[k] = tv[k]; oi[k] = ti[k]; }
    }
}
__device__ __forceinline__ void phase_sel2_naive(const float* __restrict__ TOPV, const int* __restrict__ TOPI, int* __restrict__ IDX, float* __restrict__ GATE, int ntok) {
    for (int task = blockIdx.x * 512 + mk_ltid(); task < ntok * 8; task += gridDim.x * 512) {
        const float* av = TOPV + (size_t)task * 32; const int* ai = TOPI + (size_t)task * 32;
        float bv[16]; int bi[16];
#pragma unroll
        for (int k = 0; k < 16; ++k) { bv[k] = av[16 + k]; bi[k] = ai[16 + k]; }
        float tv[16]; int ti[16];
#pragma unroll
        for (int k = 0; k < 16; ++k) { tv[k] = -3.0e38f; ti[k] = 0; }
#pragma unroll 1
        for (int i = 0; i < 16; ++i) { const float a = av[i]; const int ia = ai[i] * 128;
#pragma unroll
            for (int j = 0; j < 16; ++j) MK_INSERT16(tv, ti, a + bv[j], ia + bi[j]); }
        float e[16], sum = 0.f;
#pragma unroll
        for (int k = 0; k < 16; ++k) { e[k] = __expf(tv[k] - tv[0]); sum += e[k]; }
        const float inv = 1.f / sum;
#pragma unroll
        for (int k = 0; k < 16; ++k) { IDX[(size_t)task * 16 + k] = ti[k]; GATE[(size_t)task * 16 + k] = e[k] * inv; }
    }
}

__device__ __forceinline__ unsigned key_of(float s, unsigned tag, unsigned mask) { unsigned u = __float_as_uint(s); u = (u & 0x80000000u) ? ~u : (u | 0x80000000u); return (u & ~mask) | tag; }
__device__ __forceinline__ float score_of(unsigned key, unsigned mask) { const unsigned m = key & ~mask; return __uint_as_float((m & 0x80000000u) ? (m ^ 0x80000000u) : ~m); }
#define CE(a, b) do { const unsigned hi__ = max((a), (b)), lo__ = min((a), (b)); (a) = hi__; (b) = lo__; } while (0)
#define SORT16(A, B0) do { CE(A[(B0) + 0], A[(B0) + 1]); CE(A[(B0) + 3], A[(B0) + 2]); CE(A[(B0) + 4], A[(B0) + 5]); CE(A[(B0) + 7], A[(B0) + 6]); CE(A[(B0) + 8], A[(B0) + 9]); CE(A[(B0) + 11], A[(B0) + 10]); CE(A[(B0) + 12], A[(B0) + 13]); CE(A[(B0) + 15], A[(B0) + 14]); CE(A[(B0) + 0], A[(B0) + 2]); CE(A[(B0) + 1], A[(B0) + 3]); CE(A[(B0) + 6], A[(B0) + 4]); CE(A[(B0) + 7], A[(B0) + 5]); CE(A[(B0) + 8], A[(B0) + 10]); CE(A[(B0) + 9], A[(B0) + 11]); CE(A[(B0) + 14], A[(B0) + 12]); CE(A[(B0) + 15], A[(B0) + 13]); CE(A[(B0) + 0], A[(B0) + 1]); CE(A[(B0) + 2], A[(B0) + 3]); CE(A[(B0) + 5], A[(B0) + 4]); CE(A[(B0) + 7], A[(B0) + 6]); CE(A[(B0) + 8], A[(B0) + 9]); CE(A[(B0) + 10], A[(B0) + 11]); CE(A[(B0) + 13], A[(B0) + 12]); CE(A[(B0) + 15], A[(B0) + 14]); CE(A[(B0) + 0], A[(B0) + 4]); CE(A[(B0) + 1], A[(B0) + 5]); CE(A[(B0) + 2], A[(B0) + 6]); CE(A[(B0) + 3], A[(B0) + 7]); CE(A[(B0) + 12], A[(B0) + 8]); CE(A[(B0) + 13], A[(B0) + 9]); CE(A[(B0) + 14], A[(B0) + 10]); CE(A[(B0) + 15], A[(B0) + 11]); CE(A[(B0) + 0], A[(B0) + 2]); CE(A[(B0) + 1], A[(B0) + 3]); CE(A[(B0) + 4], A[(B0) + 6]); CE(A[(B0) + 5], A[(B0) + 7]); CE(A[(B0) + 10], A[(B0) + 8]); CE(A[(B0) + 11], A[(B0) + 9]); CE(A[(B0) + 14], A[(B0) + 12]); CE(A[(B0) + 15], A[(B0) + 13]); CE(A[(B0) + 0], A[(B0) + 1]); CE(A[(B0) + 2], A[(B0) + 3]); CE(A[(B0) + 4], A[(B0) + 5]); CE(A[(B0) + 6], A[(B0) + 7]); CE(A[(B0) + 9], A[(B0) + 8]); CE(A[(B0) + 11], A[(B0) + 10]); CE(A[(B0) + 13], A[(B0) + 12]); CE(A[(B0) + 15], A[(B0) + 14]); CE(A[(B0) + 0], A[(B0) + 8]); CE(A[(B0) + 1], A[(B0) + 9]); CE(A[(B0) + 2], A[(B0) + 10]); CE(A[(B0) + 3], A[(B0) + 11]); CE(A[(B0) + 4], A[(B0) + 12]); CE(A[(B0) + 5], A[(B0) + 13]); CE(A[(B0) + 6], A[(B0) + 14]); CE(A[(B0) + 7], A[(B0) + 15]); CE(A[(B0) + 0], A[(B0) + 4]); CE(A[(B0) + 1], A[(B0) + 5]); CE(A[(B0) + 2], A[(B0) + 6]); CE(A[(B0) + 3], A[(B0) + 7]); CE(A[(B0) + 8], A[(B0) + 12]); CE(A[(B0) + 9], A[(B0) + 13]); CE(A[(B0) + 10], A[(B0) + 14]); CE(A[(B0) + 11], A[(B0) + 15]); CE(A[(B0) + 0], A[(B0) + 2]); CE(A[(B0) + 1], A[(B0) + 3]); CE(A[(B0) + 4], A[(B0) + 6]); CE(A[(B0) + 5], A[(B0) + 7]); CE(A[(B0) + 8], A[(B0) + 10]); CE(A[(B0) + 9], A[(B0) + 11]); CE(A[(B0) + 12], A[(B0) + 14]); CE(A[(B0) + 13], A[(B0) + 15]); CE(A[(B0) + 0], A[(B0) + 1]); CE(A[(B0) + 2], A[(B0) + 3]); CE(A[(B0) + 4], A[(B0) + 5]); CE(A[(B0) + 6], A[(B0) + 7]); CE(A[(B0) + 8], A[(B0) + 9]); CE(A[(B0) + 10], A[(B0) + 11]); CE(A[(B0) + 12], A[(B0) + 13]); CE(A[(B0) + 14], A[(B0) + 15]); } while (0)
#define MERGE16(A, B0) do { CE(A[(B0) + 0], A[(B0) + 8]); CE(A[(B0) + 1], A[(B0) + 9]); CE(A[(B0) + 2], A[(B0) + 10]); CE(A[(B0) + 3], A[(B0) + 11]); CE(A[(B0) + 4], A[(B0) + 12]); CE(A[(B0) + 5], A[(B0) + 13]); CE(A[(B0) + 6], A[(B0) + 14]); CE(A[(B0) + 7], A[(B0) + 15]); CE(A[(B0) + 0], A[(B0) + 4]); CE(A[(B0) + 1], A[(B0) + 5]); CE(A[(B0) + 2], A[(B0) + 6]); CE(A[(B0) + 3], A[(B0) + 7]); CE(A[(B0) + 8], A[(B0) + 12]); CE(A[(B0) + 9], A[(B0) + 13]); CE(A[(B0) + 10], A[(B0) + 14]); CE(A[(B0) + 11], A[(B0) + 15]); CE(A[(B0) + 0], A[(B0) + 2]); CE(A[(B0) + 1], A[(B0) + 3]); CE(A[(B0) + 4], A[(B0) + 6]); CE(A[(B0) + 5], A[(B0) + 7]); CE(A[(B0) + 8], A[(B0) + 10]); CE(A[(B0) + 9], A[(B0) + 11]); CE(A[(B0) + 12], A[(B0) + 14]); CE(A[(B0) + 13], A[(B0) + 15]); CE(A[(B0) + 0], A[(B0) + 1]); CE(A[(B0) + 2], A[(B0) + 3]); CE(A[(B0) + 4], A[(B0) + 5]); CE(A[(B0) + 6], A[(B0) + 7]); CE(A[(B0) + 8], A[(B0) + 9]); CE(A[(B0) + 10], A[(B0) + 11]); CE(A[(B0) + 12], A[(B0) + 13]); CE(A[(B0) + 14], A[(B0) + 15]); } while (0)
#define SEL_XLANE(SRC, OUT) do { unsigned lo_[16], hi_[16]; \
    _Pragma("unroll") for (int i_ = 0; i_ < 16; ++i_) { auto rr_ = __builtin_amdgcn_permlane32_swap(SRC[i_], SRC[i_], false, false); lo_[i_] = (unsigned)rr_[0]; hi_[i_] = (unsigned)rr_[1]; } \
    _Pragma("unroll") for (int i_ = 0; i_ < 16; ++i_) OUT[i_] = max(lo_[i_], hi_[15 - i_]); \
    MERGE16(OUT, 0); } while (0)
#define SEL_TOP16_OF64(KA, OUT) do { SORT16(KA, 0); SORT16(KA, 16); SORT16(KA, 32); SORT16(KA, 48); \
    _Pragma("unroll") for (int i_ = 0; i_ < 16; ++i_) KA[i_] = max(KA[i_], KA[31 - i_]); MERGE16(KA, 0); \
    _Pragma("unroll") for (int i_ = 0; i_ < 16; ++i_) KA[32 + i_] = max(KA[32 + i_], KA[63 - i_]); MERGE16(KA, 32); \
    _Pragma("unroll") for (int i_ = 0; i_ < 16; ++i_) KA[i_] = max(KA[i_], KA[47 - i_]); MERGE16(KA, 0); \
    SEL_XLANE(KA, OUT); } while (0)
__device__ __forceinline__ void phase_select(const bf16* __restrict__ PQ, const bf16* __restrict__ SK, int* __restrict__ IDX, float* __restrict__ GATE, int ntok, unsigned char* lds_raw) {
    typedef short bf16x8v __attribute__((ext_vector_type(8)));
    typedef float f32x16v __attribute__((ext_vector_type(16)));
    const int tid = mk_ltid(), wave = __builtin_amdgcn_readfirstlane(tid >> 6), lane = tid & 63, r32 = lane & 31, hi = lane >> 5;
    const int h = blockIdx.x & 7, rank = blockIdx.x >> 3, nrank = (gridDim.x + 7 - h) >> 3;
    unsigned char* sk_lds = lds_raw;
    int* tab = (int*)(lds_raw + 65536) + wave * (32 * 33) + r32 * 33;
    const int ntile = ntok >> 5;
    bf16x8v qn[8];
#define SEL_QLOAD(tl, pp) do { const bf16* qp_ = PQ + (size_t)((tl) * 32 + r32) * D + (h * 2 + (pp)) * 128 + hi * 8; \
        _Pragma("unroll") for (int ks_ = 0; ks_ < 8; ++ks_) qn[ks_] = *(const bf16x8v*)(qp_ + ks_ * 16); } while (0)
    if (rank * 8 + wave < ntile) SEL_QLOAD(rank * 8 + wave, 0);
    for (int i = tid; i < 2 * 128 * 16; i += 512) { const int row = i >> 4, ch = i & 15;
        const u32x4v w = *(const u32x4v*)(SK + (size_t)(h * 256 + row) * 128 + ch * 8);
        *(u32x4v*)(sk_lds + row * 256 + ((ch ^ (row & 7)) << 4)) = w; }
    __syncthreads();
    for (int tile = rank * 8 + wave; tile < ntile; tile += nrank * 8) {
        const int t0 = tile * 32;
        unsigned la[16], lb[16];
#pragma unroll
        for (int p = 0; p < 2; ++p) {
            bf16x8v qf[8];
#pragma unroll
            for (int ks = 0; ks < 8; ++ks) qf[ks] = qn[ks];
            if (p == 0) SEL_QLOAD(tile, 1); else if (tile + nrank * 8 < ntile) SEL_QLOAD(tile + nrank * 8, 0);
            asm volatile("" ::: "memory");
            f32x16v acc[4];
#pragma unroll
            for (int nb = 0; nb < 4; ++nb) acc[nb] = f32x16v{};
#pragma unroll
            for (int ks = 0; ks < 8; ++ks) {
#pragma unroll
                for (int nb = 0; nb < 4; ++nb) { const int row = p * 128 + nb * 32 + r32;
                    const bf16x8v kf = *(const bf16x8v*)(sk_lds + row * 256 + (((ks * 2 + hi) ^ (row & 7)) << 4));
                    acc[nb] = __builtin_amdgcn_mfma_f32_32x32x16_bf16(kf, qf[ks], acc[nb], 0, 0, 0); } }
            unsigned K[64];
#pragma unroll
            for (int nb = 0; nb < 4; ++nb)
#pragma unroll
                for (int r = 0; r < 16; ++r) { const int n = 32 * nb + (r & 3) + 8 * (r >> 2); K[nb * 16 + r] = key_of(acc[nb][r], 127u - (unsigned)(n + 4 * hi), 127u); }
            asm volatile("" ::: "memory"); __builtin_amdgcn_sched_barrier(0);
            if (p == 0) SEL_TOP16_OF64(K, la); else SEL_TOP16_OF64(K, lb);
            asm volatile("" ::: "memory"); __builtin_amdgcn_sched_barrier(0);
        }
        if (hi == 0) {
#pragma unroll
            for (int k = 0; k < 16; ++k) { tab[k] = 127 - (int)(la[k] & 127u); tab[16 + k] = 127 - (int)(lb[k] & 127u); } }
        float sa[16], sb[16];
#pragma unroll
        for (int k = 0; k < 16; ++k) { sa[k] = score_of(la[k], 127u); sb[k] = score_of(lb[k], 127u); }
        unsigned CK[32], best[16];
#pragma unroll
        for (int c = 25; c < 32; ++c) CK[c] = 0u;
        CK[0] = hi ? key_of(sa[2] + sb[1], 255u - 33u, 255u) : key_of(sa[0] + sb[0], 255u - 0u, 255u);
        CK[1] = hi ? key_of(sa[2] + sb[2], 255u - 34u, 255u) : key_of(sa[0] + sb[1], 255u - 1u, 255u);
        CK[2] = hi ? key_of(sa[2] + sb[3], 255u - 35u, 255u) : key_of(sa[0] + sb[2], 255u - 2u, 255u);
        CK[3] = hi ? key_of(sa[2] + sb[4], 255u - 36u, 255u) : key_of(sa[0] + sb[3], 255u - 3u, 255u);
        CK[4] = hi ? key_of(sa[3] + sb[0], 255u - 48u, 255u) : key_of(sa[0] + sb[4], 255u - 4u, 255u);
        CK[5] = hi ? key_of(sa[3] + sb[1], 255u - 49u, 255u) : key_of(sa[0] + sb[5], 255u - 5u, 255u);
        CK[6] = hi ? key_of(sa[3] + sb[2], 255u - 50u, 255u) : key_of(sa[0] + sb[6], 255u - 6u, 255u);
        CK[7] = hi ? key_of(sa[3] + sb[3], 255u - 51u, 255u) : key_of(sa[0] + sb[7], 255u - 7u, 255u);
        CK[8] = hi ? key_of(sa[4] + sb[0], 255u - 64u, 255u) : key_of(sa[0] + sb[8], 255u - 8u, 255u);
        CK[9] = hi ? key_of(sa[4] + sb[1], 255u - 65u, 255u) : key_of(sa[0] + sb[9], 255u - 9u, 255u);
        CK[10] = hi ? key_of(sa[4] + sb[2], 255u - 66u, 255u) : key_of(sa[0] + sb[10], 255u - 10u, 255u);
        CK[11] = hi ? key_of(sa[5] + sb[0], 255u - 80u, 255u) : key_of(sa[0] + sb[11], 255u - 11u, 255u);
        CK[12] = hi ? key_of(sa[5] + sb[1], 255u - 81u, 255u) : key_of(sa[0] + sb[12], 255u - 12u, 255u);
        CK[13] = hi ? key_of(sa[6] + sb[0], 255u - 96u, 255u) : key_of(sa[0] + sb[13], 255u - 13u, 255u);
        CK[14] = hi ? key_of(sa[6] + sb[1], 255u - 97u, 255u) : key_of(sa[0] + sb[14], 255u - 14u, 255u);
        CK[15] = hi ? key_of(sa[7] + sb[0], 255u - 112u, 255u) : key_of(sa[0] + sb[15], 255u - 15u, 255u);
        CK[16] = hi ? key_of(sa[7] + sb[1], 255u - 113u, 255u) : key_of(sa[1] + sb[0], 255u - 16u, 255u);
        CK[17] = hi ? key_of(sa[8] + sb[0], 255u - 128u, 255u) : key_of(sa[1] + sb[1], 255u - 17u, 255u);
        CK[18] = hi ? key_of(sa[9] + sb[0], 255u - 144u, 255u) : key_of(sa[1] + sb[2], 255u - 18u, 255u);
        CK[19] = hi ? key_of(sa[10] + sb[0], 255u - 160u, 255u) : key_of(sa[1] + sb[3], 255u - 19u, 255u);
        CK[20] = hi ? key_of(sa[11] + sb[0], 255u - 176u, 255u) : key_of(sa[1] + sb[4], 255u - 20u, 255u);
        CK[21] = hi ? key_of(sa[12] + sb[0], 255u - 192u, 255u) : key_of(sa[1] + sb[5], 255u - 21u, 255u);
        CK[22] = hi ? key_of(sa[13] + sb[0], 255u - 208u, 255u) : key_of(sa[1] + sb[6], 255u - 22u, 255u);
        CK[23] = hi ? key_of(sa[14] + sb[0], 255u - 224u, 255u) : key_of(sa[1] + sb[7], 255u - 23u, 255u);
        CK[24] = hi ? key_of(sa[15] + sb[0], 255u - 240u, 255u) : key_of(sa[2] + sb[0], 255u - 32u, 255u);
        SORT16(CK, 0); SORT16(CK, 16);
#pragma unroll
        for (int i = 0; i < 16; ++i) CK[i] = max(CK[i], CK[31 - i]);
        MERGE16(CK, 0);
        SEL_XLANE(CK, best);
        asm volatile("s_waitcnt lgkmcnt(0)" ::: "memory");
        float e[16], sum = 0.f; int eid[16]; const float mx = score_of(best[0], 255u);
#pragma unroll
        for (int k = 0; k < 16; ++k) { const int id = 255 - (int)(best[k] & 255u); eid[k] = tab[id >> 4] * 128 + tab[16 + (id & 15)];
            e[k] = __expf(score_of(best[k], 255u) - mx); sum += e[k]; }
        const float inv = 1.f / sum;
        typedef int i32x4v __attribute__((ext_vector_type(4)));
        int* ip = IDX + (size_t)(t0 + r32) * 128 + h * 16 + hi * 8; float* gp = GATE + (size_t)(t0 + r32) * 128 + h * 16 + hi * 8;
#pragma unroll
        for (int q = 0; q < 2; ++q) {
            i32x4v iv; f32x4v gv;
#pragma unroll
            for (int j = 0; j < 4; ++j) { iv[j] = hi ? eid[8 + q * 4 + j] : eid[q * 4 + j]; gv[j] = (hi ? e[8 + q * 4 + j] : e[q * 4 + j]) * inv; }
            *(i32x4v*)(ip + q * 4) = iv; *(f32x4v*)(gp + q * 4) = gv; }
        asm volatile("s_waitcnt lgkmcnt(0)" ::: "memory");
    }
}

typedef float f32x2v __attribute__((ext_vector_type(2)));
#define EXP_LOAD(R, tab, wi, s0) do { _Pragma("unroll") for (int e_ = 0; e_ < 8; ++e_) { const int id_ = __builtin_amdgcn_readfirstlane((wi)[(s0) + e_]); const unsigned char* rb_ = (tab) + (size_t)id_ * D; \
    R[e_ * 2] = *(const u32x4v*)(rb_ + loff); R[e_ * 2 + 1] = *(const u32x4v*)(rb_ + loff + 1024); } } while (0)
#define EXP_DOT(R, s0) do { float p_[8]; _Pragma("unroll") for (int e_ = 0; e_ < 8; ++e_) { float a_ = 0.f; \
    _Pragma("unroll") for (int c_ = 0; c_ < 2; ++c_) { _Pragma("unroll") for (int q_ = 0; q_ < 4; ++q_) { const int x_ = (int)R[e_ * 2 + c_][q_]; \
        const f32x2v lo_ = __builtin_amdgcn_cvt_pk_f32_fp8(x_, false), hi_ = __builtin_amdgcn_cvt_pk_f32_fp8(x_, true); \
        a_ = fmaf(lo_[0], hf[c_][4 * q_], a_); a_ = fmaf(lo_[1], hf[c_][4 * q_ + 1], a_); a_ = fmaf(hi_[0], hf[c_][4 * q_ + 2], a_); a_ = fmaf(hi_[1], hf[c_][4 * q_ + 3], a_); } } p_[e_] = a_; } \
    float r_[4], s2_[2]; \
    _Pragma("unroll") for (int i_ = 0; i_ < 4; ++i_) r_[i_] = (b5 ? p_[i_ + 4] : p_[i_]) + __shfl_xor(b5 ? p_[i_] : p_[i_ + 4], 32); \
    _Pragma("unroll") for (int i_ = 0; i_ < 2; ++i_) s2_[i_] = (b4 ? r_[i_ + 2] : r_[i_]) + __shfl_xor(b4 ? r_[i_] : r_[i_ + 2], 16); \
    float t_ = (b3 ? s2_[1] : s2_[0]) + __shfl_xor(b3 ? s2_[0] : s2_[1], 8); t_ += __shfl_xor(t_, 4); t_ += __shfl_xor(t_, 2); t_ += __shfl_xor(t_, 1); \
    if ((lane & 7) == 0) wsm[(s0) + (lane >> 3)] = t_ * (1.f / U_SCALE); } while (0)
#define EXP_FMA(R, s0) do { _Pragma("unroll") for (int e_ = 0; e_ < 8; ++e_) { const float w_ = wsm[(s0) + e_]; \
    _Pragma("unroll") for (int c_ = 0; c_ < 2; ++c_) { _Pragma("unroll") for (int q_ = 0; q_ < 4; ++q_) { const int x_ = (int)R[e_ * 2 + c_][q_]; \
        const f32x2v lo_ = __builtin_amdgcn_cvt_pk_f32_fp8(x_, false), hi_ = __builtin_amdgcn_cvt_pk_f32_fp8(x_, true); \
        acc[c_][4 * q_] = fmaf(w_, lo_[0], acc[c_][4 * q_]); acc[c_][4 * q_ + 1] = fmaf(w_, lo_[1], acc[c_][4 * q_ + 1]); \
        acc[c_][4 * q_ + 2] = fmaf(w_, hi_[0], acc[c_][4 * q_ + 2]); acc[c_][4 * q_ + 3] = fmaf(w_, hi_[1], acc[c_][4 * q_ + 3]); } } } } while (0)
#define EXP_SB() do { asm volatile("" ::: "memory"); __builtin_amdgcn_sched_barrier(0); } while (0)
#define EXP_PIN() do { _Pragma("unroll") for (int c_ = 0; c_ < 2; ++c_) { \
    asm volatile("" : "+v"(acc[c_][0]), "+v"(acc[c_][1]), "+v"(acc[c_][2]), "+v"(acc[c_][3]), "+v"(acc[c_][4]), "+v"(acc[c_][5]), "+v"(acc[c_][6]), "+v"(acc[c_][7]) :: "memory"); \
    asm volatile("" : "+v"(acc[c_][8]), "+v"(acc[c_][9]), "+v"(acc[c_][10]), "+v"(acc[c_][11]), "+v"(acc[c_][12]), "+v"(acc[c_][13]), "+v"(acc[c_][14]), "+v"(acc[c_][15]) :: "memory"); } } while (0)
__device__ __forceinline__ void phase_experts(const bf16* H, const unsigned char* __restrict__ U, const unsigned char* __restrict__ V, const int* __restrict__ IDX, const float* __restrict__ GATE,
                              int ntok, unsigned char* lds_raw,
                              const float* X, const float* __restrict__ modg, const float* __restrict__ lng, const float* __restrict__ lnb, float* XO, bf16* HO, const float* __restrict__ modn) {
    const int tid0 = mk_ltid(); const int wave = __builtin_amdgcn_readfirstlane(tid0 >> 6);
    float* vec = (float*)lds_raw + 3072;
    for (int i = tid0; i < 2048 / 4; i += 512) {
        ((f32x4v*)vec)[i] = ((const f32x4v*)lng)[i]; ((f32x4v*)(vec + 2048))[i] = ((const f32x4v*)lnb)[i];
#pragma unroll
        for (int b = 0; b < 3; ++b) { ((f32x4v*)(vec + 4096 + b * 6144))[i] = ((const f32x4v*)(modg + (size_t)b * NMOD + 5 * D))[i];
            ((f32x4v*)(vec + 4096 + b * 6144 + 2048))[i] = ((const f32x4v*)(modn + (size_t)b * NMOD))[i];
            ((f32x4v*)(vec + 4096 + b * 6144 + 4096))[i] = ((const f32x4v*)(modn + (size_t)b * NMOD + D))[i]; } }
    __syncthreads();
    int t = blockIdx.x * 8 + wave; const int tstride = gridDim.x * 8;
    if (t >= ntok) return;
    int* widx0 = (int*)lds_raw + wave * 384; float* wsm = (float*)lds_raw + wave * 384 + 256;
    u32x4v nH[4]; u32x4v RA[16], RB[16]; int pb = 0;
    { const int lane = tid0 & 63; const unsigned loff = (unsigned)lane * 16u;
      widx0[lane] = IDX[(size_t)t * 128 + lane]; widx0[64 + lane] = IDX[(size_t)t * 128 + 64 + lane];
#pragma unroll
      for (int c = 0; c < 4; ++c) nH[c] = *(const u32x4v*)(H + (size_t)t * D + (c >> 1) * 1024 + lane * 16 + (c & 1) * 8);
      asm volatile("s_waitcnt lgkmcnt(0)" ::: "memory");
      EXP_LOAD(RA, U, widx0, 0); EXP_SB(); }
    for (;;) {
        const int lane = mk_ltid() & 63;
        int* widx = widx0 + pb * 128; int* widxn = widx0 + (pb ^ 1) * 128;
        const bool b5 = lane & 32, b4 = lane & 16, b3 = lane & 8; const unsigned loff = (unsigned)lane * 16u;
        const int tn = t + tstride; const bool hasn = tn < ntok; const int tnc = hasn ? tn : t;
        float hf[2][16];
#pragma unroll
        for (int c = 0; c < 4; ++c)
#pragma unroll
            for (int e = 0; e < 4; ++e) { hf[c >> 1][(c & 1) * 8 + 2 * e] = bflo(nH[c][e]); hf[c >> 1][(c & 1) * 8 + 2 * e + 1] = bfhi(nH[c][e]); }
        const int nia = IDX[(size_t)tnc * 128 + lane], nib = IDX[(size_t)tnc * 128 + 64 + lane];
        const float g0 = GATE[(size_t)t * 128 + lane], g1 = GATE[(size_t)t * 128 + 64 + lane];
#pragma unroll
        for (int c = 0; c < 4; ++c) nH[c] = *(const u32x4v*)(H + (size_t)tnc * D + (c >> 1) * 1024 + lane * 16 + (c & 1) * 8);
        EXP_SB();
#pragma unroll 1
        for (int i = 0; i < 16; i += 2) {
            EXP_LOAD(RB, U, widx, i * 8 + 8); EXP_SB(); EXP_DOT(RA, i * 8); EXP_SB();
            { const unsigned char* tb_ = (i < 14) ? U : V; const int sn_ = (i < 14) ? i * 8 + 16 : 0; EXP_LOAD(RA, tb_, widx, sn_); }
            EXP_SB(); EXP_DOT(RB, i * 8 + 8); EXP_SB();
        }
        asm volatile("s_waitcnt lgkmcnt(0)" ::: "memory");
        { const float a0 = wsm[lane], a1 = wsm[64 + lane];
          asm volatile("s_waitcnt lgkmcnt(0)" ::: "memory");
          wsm[lane] = g0 * 0.5f * a0 * (1.f + erff(a0 * 0.70710678118654752f)); wsm[64 + lane] = g1 * 0.5f * a1 * (1.f + erff(a1 * 0.70710678118654752f));
          widxn[lane] = nia; widxn[64 + lane] = nib; }
        asm volatile("s_waitcnt lgkmcnt(0)" ::: "memory");
        f32x4v xr[8];
#pragma unroll
        for (int c = 0; c < 2; ++c)
#pragma unroll
            for (int q = 0; q < 4; ++q) xr[c * 4 + q] = *(const f32x4v*)(X + (size_t)t * D + c * 1024 + lane * 16 + q * 4);
        float acc[2][16];
#pragma unroll
        for (int c = 0; c < 2; ++c)
#pragma unroll
            for (int e = 0; e < 16; ++e) acc[c][e] = 0.f;
        EXP_SB();
#pragma unroll 1
        for (int i = 0; i < 16; i += 2) {
            EXP_LOAD(RB, V, widx, i * 8 + 8); EXP_SB(); EXP_FMA(RA, i * 8); EXP_PIN(); EXP_SB();
            { const unsigned char* tb_ = (i < 14) ? V : U; const int* wi_ = (i < 14) ? widx : widxn; const int sn_ = (i < 14) ? i * 8 + 16 : 0; EXP_LOAD(RA, tb_, wi_, sn_); }
            EXP_SB(); EXP_FMA(RB, i * 8 + 8); EXP_PIN(); EXP_SB();
        }
        { const int b = (t < TL) ? (t / L) : 2; const float* vb = vec + 4096 + b * 6144;
          float s = 0.f;
#pragma unroll
          for (int c = 0; c < 2; ++c)
#pragma unroll
              for (int q = 0; q < 4; ++q) { const int col = c * 1024 + lane * 16 + q * 4; const f32x4v g = *(const f32x4v*)(vb + col);
#pragma unroll
                  for (int j = 0; j < 4; ++j) { const float z = xr[c * 4 + q][j] * ALPHA + g[j] * (acc[c][4 * q + j] * (1.f / V_SCALE)); acc[c][4 * q + j] = z; s += z; } }
          const float mean = wave_sum(s) * (1.f / D); float qq = 0.f;
#pragma unroll
          for (int c = 0; c < 2; ++c)
#pragma unroll
              for (int j = 0; j < 16; ++j) { const float d = acc[c][j] - mean; qq += d * d; }
          const float rstd = rsqrtf(wave_sum(qq) * (1.f / D) + 1e-5f);
          float* xo = XO + (size_t)t * D;
#pragma unroll
          for (int c = 0; c < 2; ++c)
#pragma unroll
              for (int q = 0; q < 4; ++q) { const int col = c * 1024 + lane * 16 + q * 4; const f32x4v g = *(const f32x4v*)(vec + col), bb = *(const f32x4v*)(vec + 2048 + col); f32x4v o;
#pragma unroll
                  for (int j = 0; j < 4; ++j) o[j] = (acc[c][4 * q + j] - mean) * rstd * g[j] + bb[j];
                  *(f32x4v*)(xo + col) = o;
                  if (HO) { const f32x4v sh = *(const f32x4v*)(vb + 2048 + col), sc = *(const f32x4v*)(vb + 4096 + col); const f32x4v hh = o * (1.f + sc) + sh;
                      uint2 w; w.x = pk2(hh[0], hh[1]); w.y = pk2(hh[2], hh[3]); *(uint2*)(HO + (size_t)t * D + col) = w; } } }
        asm volatile("s_waitcnt lgkmcnt(0)" ::: "memory");
        if (!hasn) break;
        t = tn; pb ^= 1;
    }
    asm volatile("s_waitcnt vmcnt(0)" ::: "memory");
}

template <bool VPASS>
__device__ __forceinline__ void phase_exp_sliced(const unsigned char* __restrict__ TAB, const int* __restrict__ IDX, const bf16* __restrict__ H, const float* __restrict__ W,
                                                 bf16* __restrict__ PART, bf16* __restrict__ YB, int ntok, unsigned char* lds_raw) {
    const int tid = mk_ltid(), wave = __builtin_amdgcn_readfirstlane(tid >> 6), lane = tid & 63, r = lane >> 3, cq = lane & 7;
    const int xg = blockIdx.x & 7, rank = blockIdx.x >> 3, nrank = (gridDim.x + 7 - xg) >> 3, tstep = nrank * 8;
    const bool b5 = lane & 32, b4 = lane & 16, b3 = lane & 8, b2 = lane & 4, b1 = lane & 2, b0 = lane & 1;
    int* idl = (int*)lds_raw + wave * 256; float* wl = (float*)lds_raw + wave * 256 + 128;
#define XS_IDS(IR, tt) do { IR[0] = IDX[(size_t)(tt) * 128 + lane]; IR[1] = IDX[(size_t)(tt) * 128 + 64 + lane]; } while (0)
#define XS_ROWS(R, IR, kk) do { const unsigned char* tb_ = TAB + XS_SL(kk) * 128 + cq * 16; idl[lane] = IR[0]; idl[64 + lane] = IR[1]; \
        _Pragma("unroll") for (int i_ = 0; i_ < 16; ++i_) { const int id_ = idl[16 * r + i_]; R[i_] = *(const u32x4v*)(tb_ + (size_t)id_ * D); } } while (0)
#define XS_AUX(A, tt, kk) do { const int s = XS_SL(kk); if constexpr (VPASS) { A[0] = __float_as_uint(W[(size_t)(tt) * 128 + lane]); A[1] = __float_as_uint(W[(size_t)(tt) * 128 + 64 + lane]); } \
        else { const u32x4v a0_ = *(const u32x4v*)(H + (size_t)(tt) * D + s * 128 + cq * 16), a1_ = *(const u32x4v*)(H + (size_t)(tt) * D + s * 128 + cq * 16 + 8); \
               _Pragma("unroll") for (int i_ = 0; i_ < 4; ++i_) { A[i_] = a0_[i_]; A[4 + i_] = a1_[i_]; } } } while (0)
#define XS_COMPUTE(R, A, tt, kk) do { const int s = XS_SL(kk); if constexpr (VPASS) { \
        wl[lane] = __uint_as_float(A[0]); wl[64 + lane] = __uint_as_float(A[1]); \
        f32x2v ac_[8]; _Pragma("unroll") for (int j_ = 0; j_ < 8; ++j_) ac_[j_] = (f32x2v){0.f, 0.f}; \
        _Pragma("unroll") for (int i_ = 0; i_ < 16; ++i_) { const float w_ = wl[16 * r + i_]; const f32x2v w2_ = {w_, w_}; \
            _Pragma("unroll") for (int q_ = 0; q_ < 4; ++q_) { const int x_ = (int)R[i_][q_]; \
                ac_[2 * q_] += w2_ * __builtin_amdgcn_cvt_pk_f32_fp8(x_, false); ac_[2 * q_ + 1] += w2_ * __builtin_amdgcn_cvt_pk_f32_fp8(x_, true); } } \
        float a_[16]; _Pragma("unroll") for (int j_ = 0; j_ < 8; ++j_) { a_[2 * j_] = ac_[j_][0]; a_[2 * j_ + 1] = ac_[j_][1]; } \
        float q8_[8], q4_[4], q2_[2]; \
        _Pragma("unroll") for (int k_ = 0; k_ < 8; ++k_) q8_[k_] = (b5 ? a_[k_ + 8] : a_[k_]) + __shfl_xor(b5 ? a_[k_] : a_[k_ + 8], 32); \
        _Pragma("unroll") for (int k_ = 0; k_ < 4; ++k_) q4_[k_] = (b4 ? q8_[k_ + 4] : q8_[k_]) + __shfl_xor(b4 ? q8_[k_] : q8_[k_ + 4], 16); \
        _Pragma("unroll") for (int k_ = 0; k_ < 2; ++k_) q2_[k_] = (b3 ? q4_[k_ + 2] : q4_[k_]) + __shfl_xor(b3 ? q4_[k_] : q4_[k_ + 2], 8); \
        *(unsigned*)(YB + (size_t)(tt) * D + s * 128 + cq * 16 + r * 2) = pk2(q2_[0] * (1.f / V_SCALE), q2_[1] * (1.f / V_SCALE)); \
    } else { \
        f32x2v h2_[8]; _Pragma("unroll") for (int j_ = 0; j_ < 8; ++j_) h2_[j_] = (f32x2v){bflo(A[j_]), bfhi(A[j_])}; \
        float p_[16]; \
        _Pragma("unroll") for (int i_ = 0; i_ < 16; ++i_) { f32x2v d_ = {0.f, 0.f}; \
            _Pragma("unroll") for (int q_ = 0; q_ < 4; ++q_) { const int x_ = (int)R[i_][q_]; \
                d_ += h2_[2 * q_] * __builtin_amdgcn_cvt_pk_f32_fp8(x_, false); d_ += h2_[2 * q_ + 1] * __builtin_amdgcn_cvt_pk_f32_fp8(x_, true); } \
            p_[i_] = d_[0] + d_[1]; } \
        float q8_[8], q4_[4], q2_[2]; \
        _Pragma("unroll") for (int k_ = 0; k_ < 8; ++k_) q8_[k_] = (b2 ? p_[k_ + 8] : p_[k_]) + __shfl_xor(b2 ? p_[k_] : p_[k_ + 8], 4); \
        _Pragma("unroll") for (int k_ = 0; k_ < 4; ++k_) q4_[k_] = (b1 ? q8_[k_ + 4] : q8_[k_]) + __shfl_xor(b1 ? q8_[k_] : q8_[k_ + 4], 2); \
        _Pragma("unroll") for (int k_ = 0; k_ < 2; ++k_) q2_[k_] = (b0 ? q4_[k_ + 2] : q4_[k_]) + __shfl_xor(b0 ? q4_[k_] : q4_[k_ + 2], 1); \
        *(unsigned*)(PART + ((size_t)s * T + (tt)) * 128 + 16 * r + 2 * cq) = pk2(q2_[0] * (1.f / U_SCALE), q2_[1] * (1.f / U_SCALE)); \
    } } while (0)
    constexpr int NAUX = VPASS ? 2 : 8;
    const int t0 = rank * 8 + wave;
    if (t0 < ntok) {
        const int nj = (ntok - t0 + tstep - 1) / tstep, ntask = 2 * nj;
#define XS_SL(kk) (xg + (((kk) >= nj) ? 8 : 0))
#define XS_TOK(kk) (t0 + (((kk) >= nj) ? (kk) - nj : (kk)) * tstep)
        int idn[2]; u32x4v RA[16], RB[16]; unsigned auxP[NAUX], auxQ[NAUX];
        int k = 0;
        XS_IDS(idn, XS_TOK(0)); XS_AUX(auxP, XS_TOK(0), 0);
        XS_ROWS(RA, idn, 0);
        { const int k1 = (1 < ntask) ? 1 : 0; XS_IDS(idn, XS_TOK(k1)); }
        EXP_SB();
        for (;;) {
            { const int k1 = (k + 1 < ntask) ? k + 1 : k, k2 = (k + 2 < ntask) ? k + 2 : k1;
              XS_ROWS(RB, idn, k1); XS_IDS(idn, XS_TOK(k2)); XS_AUX(auxQ, XS_TOK(k1), k1); EXP_SB();
              XS_COMPUTE(RA, auxP, XS_TOK(k), k); EXP_SB();
              if (++k >= ntask) break; }
            { const int k1 = (k + 1 < ntask) ? k + 1 : k, k2 = (k + 2 < ntask) ? k + 2 : k1;
              XS_ROWS(RA, idn, k1); XS_IDS(idn, XS_TOK(k2)); XS_AUX(auxP, XS_TOK(k1), k1); EXP_SB();
              XS_COMPUTE(RB, auxQ, XS_TOK(k), k); EXP_SB();
              if (++k >= ntask) break; }
        }
        asm volatile("s_waitcnt vmcnt(0)" ::: "memory");
#undef XS_SL
#undef XS_TOK
    }
#undef XS_IDS
#undef XS_ROWS
#undef XS_AUX
#undef XS_COMPUTE
}
__device__ __forceinline__ void phase_exp_u4(const unsigned char* __restrict__ TAB, const int* __restrict__ IDX, const unsigned char* __restrict__ HQ,
                                             bf16* __restrict__ PART, int ntok, unsigned char* lds_raw) {
    const int tid = mk_ltid(), wave = __builtin_amdgcn_readfirstlane(tid >> 6), lane = tid & 63, r = lane >> 3, cq = lane & 7;
    const int s = blockIdx.x & 7, rank = blockIdx.x >> 3, nrank = (gridDim.x + 7 - s) >> 3, tstep = nrank * 8;
    const bool b2 = lane & 4, b1 = lane & 2, b0 = lane & 1;
    int* idl = (int*)lds_raw + wave * 256;
    const unsigned char* tbs = TAB + (size_t)s * NE * 128; const unsigned cq16 = cq * 16; const unsigned char* hb = HQ + s * 256 + cq * 32;
#define U4_IDS(IR, tt) do { IR[0] = IDX[(size_t)(tt) * 128 + lane]; IR[1] = IDX[(size_t)(tt) * 128 + 64 + lane]; } while (0)
#define U4_ROWS(R, IR) do { idl[lane] = IR[0]; idl[64 + lane] = IR[1]; \
        _Pragma("unroll") for (int i_ = 0; i_ < 16; ++i_) { const unsigned off_ = (unsigned)idl[16 * r + i_] * 128u + cq16; R[i_] = *(const u32x4v*)(tbs + off_); } } while (0)
#define U4_AUX(A, tt) do { const u32x4v a0_ = *(const u32x4v*)(hb + (size_t)(tt) * D), a1_ = *(const u32x4v*)(hb + (size_t)(tt) * D + 16); \
        _Pragma("unroll") for (int i_ = 0; i_ < 4; ++i_) { A[i_] = a0_[i_]; A[4 + i_] = a1_[i_]; } } while (0)
#define U4_COMPUTE(R, A, tt) do { int hs_ = 0; _Pragma("unroll") for (int j_ = 0; j_ < 8; ++j_) hs_ = __builtin_amdgcn_sdot4(0x01010101, (int)A[j_], hs_, false); \
        float p_[16]; \
        _Pragma("unroll") for (int i_ = 0; i_ < 16; ++i_) { int acc_ = 0; \
            _Pragma("unroll") for (int k_ = 0; k_ < 4; ++k_) { const unsigned x_ = R[i_][k_]; \
                acc_ = __builtin_amdgcn_sdot4((int)(x_ & 0x0F0F0F0Fu), (int)A[2 * k_], acc_, false); acc_ = __builtin_amdgcn_sdot4((int)((x_ >> 4) & 0x0F0F0F0Fu), (int)A[2 * k_ + 1], acc_, false); } \
            p_[i_] = (float)(acc_ - 8 * hs_); } \
        float q8_[8], q4_[4], q2_[2]; \
        _Pragma("unroll") for (int k_ = 0; k_ < 8; ++k_) q8_[k_] = (b2 ? p_[k_ + 8] : p_[k_]) + __shfl_xor(b2 ? p_[k_] : p_[k_ + 8], 4); \
        _Pragma("unroll") for (int k_ = 0; k_ < 4; ++k_) q4_[k_] = (b1 ? q8_[k_ + 4] : q8_[k_]) + __shfl_xor(b1 ? q8_[k_] : q8_[k_ + 4], 2); \
        _Pragma("unroll") for (int k_ = 0; k_ < 2; ++k_) q2_[k_] = (b0 ? q4_[k_ + 2] : q4_[k_]) + __shfl_xor(b0 ? q4_[k_] : q4_[k_ + 2], 1); \
        *(unsigned*)(PART + ((size_t)s * T + (tt)) * 128 + 16 * r + 2 * cq) = pk2(q2_[0], q2_[1]); } while (0)
    const int t0 = rank * 8 + wave;
    if (t0 < ntok) {
        const int ntask = (ntok - t0 + tstep - 1) / tstep;
#define U4_TOK(kk) (t0 + (kk) * tstep)
        int idn[2]; u32x4v RA[16], RB[16]; unsigned auxP[8], auxQ[8];
        int k = 0;
        U4_IDS(idn, U4_TOK(0)); U4_AUX(auxP, U4_TOK(0));
        U4_ROWS(RA, idn);
        { const int k1 = (1 < ntask) ? 1 : 0; U4_IDS(idn, U4_TOK(k1)); }
        EXP_SB();
        for (;;) {
            { const int k1 = (k + 1 < ntask) ? k + 1 : k, k2 = (k + 2 < ntask) ? k + 2 : k1;
              U4_ROWS(RB, idn); U4_IDS(idn, U4_TOK(k2)); U4_AUX(auxQ, U4_TOK(k1)); EXP_SB();
              U4_COMPUTE(RA, auxP, U4_TOK(k)); EXP_SB();
              if (++k >= ntask) break; }
            { const int k1 = (k + 1 < ntask) ? k + 1 : k, k2 = (k + 2 < ntask) ? k + 2 : k1;
              U4_ROWS(RA, idn); U4_IDS(idn, U4_TOK(k2)); U4_AUX(auxP, U4_TOK(k1)); EXP_SB();
              U4_COMPUTE(RB, auxQ, U4_TOK(k)); EXP_SB();
              if (++k >= ntask) break; }
        }
        asm volatile("s_waitcnt vmcnt(0)" ::: "memory");
#undef U4_TOK
    }
#undef U4_IDS
#undef U4_ROWS
#undef U4_AUX
#undef U4_COMPUTE
}
__device__ __forceinline__ void phase_exp_v4(const unsigned char* __restrict__ TAB, const int* __restrict__ IDX, const unsigned char* __restrict__ WQ, const float* __restrict__ WSC,
                                             bf16* __restrict__ YB, int ntok) {
    typedef int i32x4w __attribute__((ext_vector_type(4)));
    const int tid = mk_ltid(), wave = __builtin_amdgcn_readfirstlane(tid >> 6), lane = tid & 63, tk = lane >> 3, cq = lane & 7;
    const int s = blockIdx.x & 7, rank = blockIdx.x >> 3, nrank = (gridDim.x + 7 - s) >> 3, gstride = nrank * 8, ngroups = ntok >> 3;
    const unsigned char* tbs = TAB + (size_t)s * NE * 128; const unsigned cq16 = cq * 16;
    const int g0 = wave * nrank + rank;
#define V4_TT(kk) ((g0 + ((kk) >> 3) * gstride) * 8 + tk)
#define V4_IDS(ID, kk) do { const int* ip_ = IDX + (size_t)V4_TT(kk) * 128 + 16 * ((kk) & 7); _Pragma("unroll") for (int g_ = 0; g_ < 4; ++g_) ID[g_] = *(const i32x4w*)(ip_ + 4 * g_); } while (0)
#define V4_ROWS(R, ID) do { _Pragma("unroll") for (int i_ = 0; i_ < 16; ++i_) R[i_] = *(const u32x4v*)(tbs + ((unsigned)ID[i_ >> 2][i_ & 3] * 128u + cq16)); } while (0)
#define V4_AUX(A, kk) do { A = *(const u32x4v*)(WQ + (size_t)V4_TT(kk) * 128 + 16 * ((kk) & 7)); } while (0)
#define V4_COMPUTE(R, A, kk) do { \
        _Pragma("unroll") for (int g_ = 0; g_ < 4; ++g_) wsum = __builtin_amdgcn_sdot4(0x01010101, (int)A[g_], wsum, false); \
        _Pragma("unroll") for (int g_ = 0; g_ < 4; ++g_) { const int w4_ = (int)A[g_]; \
            _Pragma("unroll") for (int k_ = 0; k_ < 4; ++k_) { \
                const unsigned x0_ = R[4 * g_][k_], x1_ = R[4 * g_ + 1][k_], x2_ = R[4 * g_ + 2][k_], x3_ = R[4 * g_ + 3][k_]; \
                  \
                const unsigned u0_ = __builtin_amdgcn_perm(x1_, x0_, 0x05010400u), u1_ = __builtin_amdgcn_perm(x1_, x0_, 0x07030602u), u2_ = __builtin_amdgcn_perm(x3_, x2_, 0x05010400u), u3_ = __builtin_amdgcn_perm(x3_, x2_, 0x07030602u); \
                const unsigned t0_ = __builtin_amdgcn_perm(u2_, u0_, 0x05040100u), t1_ = __builtin_amdgcn_perm(u2_, u0_, 0x07060302u), t2_ = __builtin_amdgcn_perm(u3_, u1_, 0x05040100u), t3_ = __builtin_amdgcn_perm(u3_, u1_, 0x07060302u); \
                acc[8 * k_ + 0] = __builtin_amdgcn_sdot4((int)(t0_ & 0x0F0F0F0Fu), w4_, acc[8 * k_ + 0], false); acc[8 * k_ + 4] = __builtin_amdgcn_sdot4((int)t0_, w4_, acc[8 * k_ + 4], false); \
                acc[8 * k_ + 1] = __builtin_amdgcn_sdot4((int)(t1_ & 0x0F0F0F0Fu), w4_, acc[8 * k_ + 1], false); acc[8 * k_ + 5] = __builtin_amdgcn_sdot4((int)t1_, w4_, acc[8 * k_ + 5], false); \
                acc[8 * k_ + 2] = __builtin_amdgcn_sdot4((int)(t2_ & 0x0F0F0F0Fu), w4_, acc[8 * k_ + 2], false); acc[8 * k_ + 6] = __builtin_amdgcn_sdot4((int)t2_, w4_, acc[8 * k_ + 6], false); \
                acc[8 * k_ + 3] = __builtin_amdgcn_sdot4((int)(t3_ & 0x0F0F0F0Fu), w4_, acc[8 * k_ + 3], false); acc[8 * k_ + 7] = __builtin_amdgcn_sdot4((int)t3_, w4_, acc[8 * k_ + 7], false); } } \
        if (((kk) & 7) == 7) {            \
            const int tt_ = V4_TT(kk); const float sc_ = WSC[tt_]; bf16* yo_ = YB + (size_t)tt_ * D + s * 256 + cq * 32; \
            _Pragma("unroll") for (int k_ = 0; k_ < 4; ++k_) { float lo_[4], hi_[4]; \
                _Pragma("unroll") for (int c_ = 0; c_ < 4; ++c_) { lo_[c_] = (float)(acc[8 * k_ + c_] - 8 * wsum) * sc_; hi_[c_] = (float)((acc[8 * k_ + 4 + c_] - acc[8 * k_ + c_]) >> 4) * sc_; } \
                u32x4v o_; o_[0] = pk2(lo_[0], lo_[1]); o_[1] = pk2(lo_[2], lo_[3]); o_[2] = pk2(hi_[0], hi_[1]); o_[3] = pk2(hi_[2], hi_[3]); \
                *(u32x4v*)(yo_ + 8 * k_) = o_; } \
            _Pragma("unroll") for (int c_ = 0; c_ < 32; ++c_) acc[c_] = 0; \
            wsum = 0; } } while (0)
    if (g0 < ngroups) {
        const int ntask = ((ngroups - g0 + gstride - 1) / gstride) * 8;
        i32x4w idn[4]; u32x4v RA[16], RB[16]; u32x4v auxP, auxQ;
        int acc[32], wsum = 0;
#pragma unroll
        for (int c = 0; c < 32; ++c) acc[c] = 0;
        int k = 0;
        V4_IDS(idn, 0); V4_AUX(auxP, 0);
        V4_ROWS(RA, idn);
        V4_IDS(idn, 1);
        EXP_SB();
        for (;;) {
            { const int k1 = (k + 1 < ntask) ? k + 1 : k, k2 = (k + 2 < ntask) ? k + 2 : k1;
              V4_ROWS(RB, idn); V4_IDS(idn, k2); V4_AUX(auxQ, k1); EXP_SB();
              V4_COMPUTE(RA, auxP, k); EXP_SB();
              if (++k >= ntask) break; }
            { const int k1 = (k + 1 < ntask) ? k + 1 : k, k2 = (k + 2 < ntask) ? k + 2 : k1;
              V4_ROWS(RA, idn); V4_IDS(idn, k2); V4_AUX(auxP, k1); EXP_SB();
              V4_COMPUTE(RB, auxQ, k); EXP_SB();
              if (++k >= ntask) break; }
        }
        asm volatile("s_waitcnt vmcnt(0)" ::: "memory");
    }
#undef V4_TT
#undef V4_IDS
#undef V4_ROWS
#undef V4_AUX
#undef V4_COMPUTE
}
__device__ __forceinline__ void phase_exp_w(const bf16* __restrict__ PART, const float* __restrict__ GATE, const int* __restrict__ IDX, const float* __restrict__ usteps, const float* __restrict__ hsteps,
                                            const float* __restrict__ vsteps, unsigned char* __restrict__ WQ, float* __restrict__ WSC, int ntok) {
    const size_t n8 = (size_t)ntok * 16, stride = (size_t)gridDim.x * 512;
    for (size_t i = (size_t)blockIdx.x * 512 + mk_ltid(); i < n8; i += stride) {
        float a[8];
#pragma unroll
        for (int q = 0; q < 8; ++q) a[q] = 0.f;
#pragma unroll
        for (int s = 0; s < 8; ++s) { const u32x4v w = *(const u32x4v*)(PART + (size_t)s * T * 128 + i * 8);
#pragma unroll
            for (int q = 0; q < 4; ++q) { a[2 * q] += bflo(w[q]); a[2 * q + 1] += bfhi(w[q]); } }
        typedef int i32x4w __attribute__((ext_vector_type(4)));
        const i32x4w e0 = *(const i32x4w*)(IDX + i * 8), e1 = *(const i32x4w*)(IDX + i * 8 + 4); const float hs = hsteps[i >> 4];
#pragma unroll
        for (int q = 0; q < 4; ++q) { a[q] *= usteps[e0[q]] * hs; a[4 + q] *= usteps[e1[q]] * hs; }
        const f32x4v g0 = *(const f32x4v*)(GATE + i * 8), g1 = *(const f32x4v*)(GATE + i * 8 + 4); float o[8]; float amax = 0.f;
#pragma unroll
        for (int q = 0; q < 4; ++q) { o[q] = g0[q] * 0.5f * a[q] * (1.f + erff(a[q] * 0.70710678118654752f)) * vsteps[e0[q]]; o[4 + q] = g1[q] * 0.5f * a[4 + q] * (1.f + erff(a[4 + q] * 0.70710678118654752f)) * vsteps[e1[q]]; }
#pragma unroll
        for (int q = 0; q < 8; ++q) amax = fmaxf(amax, fabsf(o[q]));
        amax = fmaxf(amax, __shfl_xor(amax, 1)); amax = fmaxf(amax, __shfl_xor(amax, 2)); amax = fmaxf(amax, __shfl_xor(amax, 4)); amax = fmaxf(amax, __shfl_xor(amax, 8));
        const float stp = (amax > 0.f) ? amax * (1.f / 127.f) : 1.f, inv = 1.f / stp; unsigned w0 = 0u, w1 = 0u;
#pragma unroll
        for (int q = 0; q < 4; ++q) { w0 |= ((unsigned)((int)rintf(o[q] * inv)) & 255u) << (8 * q); w1 |= ((unsigned)((int)rintf(o[4 + q] * inv)) & 255u) << (8 * q); }
        uint2 ww; ww.x = w0; ww.y = w1; *(uint2*)(WQ + i * 8) = ww;
        if ((i & 15) == 0) WSC[i >> 4] = stp; }
}

template <bool SHI>
__device__ __forceinline__ void tail_convert(const float* __restrict__ src, unsigned char* __restrict__ dst, float scale, int l, int mrows, float* usteps) {
    if (l >= DEPTH - 1) return;
    const int nunits = (mrows / 256) * (D / 256), G = (int)gridDim.x, busy = nunits % G;
    if ((int)blockIdx.x < busy || busy == 0) { if (busy != 0) return; }
    const int part = (busy == 0) ? (int)blockIdx.x : (int)blockIdx.x - busy, nparts = (busy == 0) ? G : G - busy;
    if (usteps) cvt_rows_u4<SHI>(src + (size_t)(l + 1) * NE * D, dst + (size_t)(l + 1) * NE * (D / 2), usteps + (size_t)(l + 1) * NE, NE, part, nparts);
    else cvt_stream_fp8(src + (size_t)(l + 1) * NE * D, dst + (size_t)(l + 1) * NE * D, (size_t)NE * D / 16, scale, part, nparts);
}

enum { K_PRO = 0, K_MOD0, K_GEMM_IN, K_PREP, K_ATT_AB, K_ATT_C, K_ATT_CCTX, K_GEMM_OUT, K_LN1, K_GEMM_PQ, K_SEL1, K_SEL2, K_EXP, K_LN2, K_EXPU, K_EXPW, K_EXPV, K_COUNT };

#ifndef MK_PHASE_INLINE
#define MK_PHASE_INLINE __forceinline__
#endif
template <int KIND>
__device__ MK_PHASE_INLINE void run_phase(const Params& p, const int l, unsigned char* lds) {
#ifdef MK_SKIP
    if constexpr (((MK_SKIP) >> KIND) & 1) return;
#endif
    unsigned char* ws = p.ws;
    bf16* const Hb = (bf16*)(ws + WS_H); bf16* const QKV = (bf16*)(ws + WS_QKV); bf16* const ATT = (bf16*)(ws + WS_ATT); bf16* const PQ = (bf16*)(ws + WS_PQ);
    bf16* const X = (bf16*)(ws + WS_X); float* const Y = (float*)(ws + WS_Y); const float* const MOD = (const float*)(ws + WS_MOD);
    const bool odd = l & 1, last = (l == DEPTH - 1); const int i2 = l >> 1;
    const int NQ = odd ? NQ_C : NQ_AB; const int MR = last ? TL : T;
    const float* modl = MOD + (size_t)l * 3 * NMOD;
    if constexpr (KIND == K_PRO) phase_prologue(p, lds);
    if constexpr (KIND == K_MOD0) phase_mod0(p);
    if constexpr (KIND == K_GEMM_IN) {
        const unsigned char* Wt = odd ? ws + WS_WIN_C + (size_t)i2 * NQ_C * D : ws + WS_WIN_AB + (size_t)i2 * NQ_AB * D;
        pg8::Gemm g{(const bf16*)(ws + WS_H8), (const bf16*)Wt, T, NQ, D / 2, SC_ONE, SC_W8}; pg8::StaticOrder S; S.init(T, NQ, (int)gridDim.x, (int)blockIdx.x);
        pg8::EpiBf16<0> E{QKV, NQ, nullptr, 0, 0};
        pg8::gemm_phase<pg8::EpiBf16<0>, pg8::StaticOrder, false, 1>((PG8_LAS unsigned char*)lds, g, S, E, nullptr);
    }
    if constexpr (KIND == K_PREP) {
        if (odd) { phase_prep(QKV, NQ_C, 2048, 4, 0, true, p.c_q_gain + i2 * HD, p.c_k_gain + i2 * HD, (const float*)(ws + WS_ROPE), T, ws + WS_K8);
                   phase_vt8(QKV, ws + WS_VT8); }
        else     phase_prep(QKV, NQ_AB, 1024, 2, 0, false, nullptr, nullptr, (const float*)(ws + WS_ROPE), TL, nullptr);
    }
    #if MK_NAIVE_AB
    if constexpr (KIND == K_ATT_AB) phase_attn_ab_naive(QKV, ATT, p.a_sink + i2 * 8, p.b_rpb + (size_t)i2 * 8 * 15 * 31, !last);
#else
    if constexpr (KIND == K_ATT_AB) phase_attn_ab(QKV, ATT, p.a_sink + i2 * 8, p.b_rpb + (size_t)i2 * 8 * 15 * 31, (char*)lds, !last, (const float*)(ws + WS_ROPE));
#endif
    if constexpr (KIND == K_ATT_C) phase_attn_c_dense(QKV, ATT, (char*)lds, !last, p.c_q_gain + i2 * HD, (const float*)(ws + WS_ROPE), ws + WS_K8, ws + WS_VT8);
    if constexpr (KIND == K_GEMM_OUT) {
        const unsigned char* Wt = odd ? ws + WS_WOUT_C + (size_t)i2 * D * D : ws + WS_WOUT_AB + (size_t)i2 * D * D;
        pg8::Gemm g{(const bf16*)ATT, (const bf16*)Wt, MR, D, D / 2, SC_ATT8, SC_W8}; pg8::StaticOrder S; S.init(MR, D, (int)gridDim.x, (int)blockIdx.x);
        pg8::EpiBf16<0> E{(bf16*)Y, D, nullptr, 0, 0};
        pg8::gemm_phase<pg8::EpiBf16<0>, pg8::StaticOrder, false, 1>((PG8_LAS unsigned char*)lds, g, S, E, nullptr);
        tail_convert<false>(p.peer_u, ws + WS_U, U_SCALE, l, MR, (float*)(ws + WS_USC));
    }
    if constexpr (KIND == K_LN1) {
        const float* lg = p.ln_g + (size_t)(l * 2 + 0) * D; const float* lb = p.ln_b + (size_t)(l * 2 + 0) * D;
        if (l == 0) phase_ln<true, false>(p.x, p.ctx, (const bf16*)Y, modl, 2, lg, lb, X, X + (size_t)TL * D, nullptr, nullptr, modl, 3, 4, MR, lds, ws + WS_HQ, (float*)(ws + WS_HSC));
        else        phase_ln<false, false>(X, X + (size_t)TL * D, (const bf16*)Y, modl, 2, lg, lb, X, X + (size_t)TL * D, nullptr, nullptr, modl, 3, 4, MR, lds, ws + WS_HQ, (float*)(ws + WS_HSC));
    }
    if constexpr (KIND == K_GEMM_PQ) {
        pg8::Gemm g{(const bf16*)(ws + WS_HQ), (const bf16*)(ws + WS_WPQ + (size_t)l * D * D), MR, D, D / 2, 0, 0}; pg8::StaticOrder S; S.init(MR, D, (int)gridDim.x, (int)blockIdx.x);
        pg8::EpiI8Bf16 E{PQ, D, (const float*)(ws + WS_HSC), (const float*)(ws + WS_PQSC) + (size_t)l * D};
        pg8::gemm_phase<pg8::EpiI8Bf16, pg8::StaticOrder, false, 2>((PG8_LAS unsigned char*)lds, g, S, E, nullptr);
        tail_convert<true>(p.peer_v, ws + WS_V, V_SCALE, l, MR, (float*)(ws + WS_VSC));
    }
#if MK_NAIVE_SEL
    if constexpr (KIND == K_SEL1) phase_sel1_naive(PQ, (const bf16*)(ws + WS_SK) + (size_t)l * 16 * 128 * 128, (float*)(ws + WS_TOPV), (int*)(ws + WS_TOPI), MR);
    if constexpr (KIND == K_SEL2) phase_sel2_naive((const float*)(ws + WS_TOPV), (const int*)(ws + WS_TOPI), (int*)(ws + WS_IDX), (float*)(ws + WS_GATE), MR);
#else
    if constexpr (KIND == K_SEL1) phase_select(PQ, (const bf16*)(ws + WS_SK) + (size_t)l * 16 * 128 * 128, (int*)(ws + WS_IDX), (float*)(ws + WS_GATE), MR, lds);
#endif
    if constexpr (KIND == K_EXPU) phase_exp_u4(ws + WS_U + (size_t)l * NE * (D / 2), (const int*)(ws + WS_IDX), ws + WS_HQ, (bf16*)Y, MR, lds);
    if constexpr (KIND == K_EXPW) phase_exp_w((const bf16*)Y, (const float*)(ws + WS_GATE), (const int*)(ws + WS_IDX), (const float*)(ws + WS_USC) + (size_t)l * NE, (const float*)(ws + WS_HSC),
                                               (const float*)(ws + WS_VSC) + (size_t)l * NE, ws + WS_WQ, (float*)(ws + WS_WSC), MR);
    if constexpr (KIND == K_EXPV) phase_exp_v4(ws + WS_V + (size_t)l * NE * (D / 2), (const int*)(ws + WS_IDX), ws + WS_WQ, (const float*)(ws + WS_WSC), ATT, MR);
    if constexpr (KIND == K_LN2) {
        const float* modn = MOD + (size_t)(last ? l : l + 1) * 3 * NMOD; const float* lg = p.ln_g + (size_t)(l * 2 + 1) * D; const float* lb = p.ln_b + (size_t)(l * 2 + 1) * D;
        if (last) phase_ln<false, true>(X, X + (size_t)TL * D, ATT, modl, 5, lg, lb, p.out, p.out, nullptr, nullptr, modn, 0, 1, MR, lds);
        else      phase_ln<false, false>(X, X + (size_t)TL * D, ATT, modl, 5, lg, lb, X, X + (size_t)TL * D, nullptr, ws + WS_H8, modn, 0, 1, MR, lds);
    }
    if constexpr (KIND == K_EXP) {
        const float* modn = MOD + (size_t)(last ? l : l + 1) * 3 * NMOD;
        phase_experts(Hb, ws + WS_U + (size_t)l * NE * D, ws + WS_V + (size_t)l * NE * D, (const int*)(ws + WS_IDX), (const float*)(ws + WS_GATE), MR, lds,
                      (const float*)X, modl, p.ln_g + (size_t)(l * 2 + 1) * D, p.ln_b + (size_t)(l * 2 + 1) * D, last ? p.out : (float*)X, last ? nullptr : Hb, modn);
    }
}

template <int KIND>
__global__ void __launch_bounds__(512, 2) mk_phase(Params p, int l) {
    extern __shared__ __attribute__((aligned(16))) unsigned char lds[];
    run_phase<KIND>(p, l, lds);
}
typedef const __attribute__((address_space(4))) Params* KParams;
__device__ __forceinline__ Params load_params() {
#if defined(__HIP_DEVICE_COMPILE__)
    KParams q = (KParams)__builtin_amdgcn_kernarg_segment_ptr();
    asm volatile("" : "+s"(q));
    return *q;
#else
    return Params{};
#endif
}
#ifndef MK_DOUBLE
#define MK_DOUBLE 0
#endif
#define RUN(K, l) do { { const Params P_ = load_params(); run_phase<K>(P_, (l), lds); } if constexpr (((MK_DOUBLE) >> K) & 1) { xcd_barrier(bar); const Params P2_ = load_params(); run_phase<K>(P2_, (l), lds); } } while (0)
__global__ void __launch_bounds__(512, 2) mk_fwd(Params p) {
    extern __shared__ __attribute__((aligned(16))) unsigned char lds[];
    volatile LAS unsigned* misc = (volatile LAS unsigned*)((LAS unsigned char*)lds + LDS_MISC);
    if (threadIdx.x < 4) misc[threadIdx.x] = 0u;
    __syncthreads();
    const XcdBarrier bar = xcd_barrier_post((unsigned*)(p.ws + WS_CTL), misc);
    RUN(K_PRO, 0); xcd_barrier(bar);
    RUN(K_MOD0, 0); xcd_barrier(bar);
#pragma unroll 1
    for (int l = 0; l < DEPTH; ++l) {
        const bool odd = l & 1, last = (l == DEPTH - 1);
        RUN(K_GEMM_IN, l); xcd_barrier(bar);
        RUN(K_PREP, l); xcd_barrier(bar);
        if (odd) RUN(K_ATT_C, l); else RUN(K_ATT_AB, l);
        xcd_barrier(bar);
        RUN(K_GEMM_OUT, l); xcd_barrier(bar);
        RUN(K_LN1, l); xcd_barrier(bar);
        RUN(K_GEMM_PQ, l); xcd_barrier(bar);
        RUN(K_SEL1, l); xcd_barrier(bar);
#if MK_NAIVE_SEL
        RUN(K_SEL2, l); xcd_barrier(bar);
#endif
#if MK_SLICED
        RUN(K_EXPU, l); xcd_barrier(bar);
        RUN(K_EXPW, l); xcd_barrier(bar);
        RUN(K_EXPV, l); xcd_barrier(bar);
        RUN(K_LN2, l);
#else
        RUN(K_EXP, l);
#endif
        if (!last) xcd_barrier(bar);
    }
}
#undef RUN
}

template <int KIND> static void launch_phase(const mk::Params& p, int l, int grid, hipStream_t stream) {
    static bool attr = false;
    if (!attr) { (void)hipFuncSetAttribute((const void*)mk::mk_phase<KIND>, hipFuncAttributeMaxDynamicSharedMemorySize, mk::LDS_BYTES); attr = true; }
    hipLaunchKernelGGL(mk::mk_phase<KIND>, dim3(grid), dim3(512), mk::LDS_BYTES, stream, p, l);
}
extern "C" void kernel_launch(void* const* d_in, const int* in_sizes, int n_in, void* d_out, int out_size, void* d_ws, size_t ws_size, hipStream_t stream) {
    using namespace mk;
    static int grid = 0;
    if (grid == 0) {
        if (n_in != 20 || in_sizes[0] != TL * D || out_size != TL * D || ws_size < WS_END) {
            fprintf(stderr, "kernel_launch: unexpected shapes: n_in %d in0 %d out %d ws %zu (need %zu)\n", n_in, n_in > 0 ? in_sizes[0] : -1, out_size, ws_size, (size_t)WS_END); grid = -1; return; }
        int dev = 0, cus = 0;
        if (hipGetDevice(&dev) != hipSuccess || hipDeviceGetAttribute(&cus, hipDeviceAttributeMultiprocessorCount, dev) != hipSuccess) { grid = -1; return; }
        grid = cus;
    }
    if (grid < 0) return;
    (void)hipMemsetAsync((char*)d_ws + WS_CTL, 0, 16384, stream);
    Params p{};
    const float** pp = (const float**)&p;
    for (int i = 0; i < 20; ++i) pp[i] = (const float*)d_in[i];
    p.out = (float*)d_out; p.ws = (unsigned char*)d_ws; p.ph_lo = 0; p.ph_hi = 0;
#if MK_ONE_LAUNCH
    { static bool attr = false;
      if (!attr) { int per_cu = 0;
          if (hipFuncSetAttribute((const void*)mk_fwd, hipFuncAttributeMaxDynamicSharedMemorySize, LDS_BYTES) != hipSuccess) fprintf(stderr, "kernel_launch: hipFuncSetAttribute failed\n");
          if (hipOccupancyMaxActiveBlocksPerMultiprocessor(&per_cu, (const void*)mk_fwd, 512, LDS_BYTES) != hipSuccess || per_cu < 1) fprintf(stderr, "kernel_launch: occupancy query reports %d workgroups per CU\n", per_cu);
          (void)hipGetLastError(); attr = true; }
      hipLaunchKernelGGL(mk_fwd, dim3(grid), dim3(512), LDS_BYTES, stream, p); }
#else
    launch_phase<K_PRO>(p, 0, grid, stream);
    launch_phase<K_MOD0>(p, 0, grid, stream);
    for (int l = 0; l < DEPTH; ++l) {
        const bool odd = l & 1, last = (l == DEPTH - 1);
        launch_phase<K_GEMM_IN>(p, l, grid, stream);
        launch_phase<K_PREP>(p, l, grid, stream);
        if (odd) launch_phase<K_ATT_C>(p, l, grid, stream);
        else launch_phase<K_ATT_AB>(p, l, grid, stream);
        launch_phase<K_GEMM_OUT>(p, l, grid, stream);
        launch_phase<K_LN1>(p, l, grid, stream);
        launch_phase<K_GEMM_PQ>(p, l, grid, stream);
        launch_phase<K_SEL1>(p, l, grid, stream);
#if MK_NAIVE_SEL
        launch_phase<K_SEL2>(p, l, grid, stream);
#endif
#if MK_SLICED
        launch_phase<K_EXPU>(p, l, grid, stream); launch_phase<K_EXPW>(p, l, grid, stream); launch_phase<K_EXPV>(p, l, grid, stream); launch_phase<K_LN2>(p, l, grid, stream);
#else
        launch_phase<K_EXP>(p, l, grid, stream);
#endif
    }
#endif
    const hipError_t le = hipPeekAtLastError();
    if (le != hipSuccess) fprintf(stderr, "kernel_launch: launch failed: %s\n", hipGetErrorName(le));
}
```
